# Optimizing an MI355X kernel written in HIP

```python
import math
import jax
import jax.numpy as jnp
from jax import lax
import numpy as np

D_MODEL = 2048
BATCH = 16
SEQ = 2048
DEPTH = 2

HEAD_DIM = 128
MIX_WIDTH = D_MODEL
A_GROUPS = MIX_WIDTH // (2 * HEAD_DIM)
A_WIDTH = A_GROUPS * HEAD_DIM
CONV_WIDTH = 3
B_HEADS = MIX_WIDTH // (2 * HEAD_DIM)
B_WIDTH = B_HEADS * HEAD_DIM
Q_RANK = 512
KV_RANK = 256
IDX_HEADS = 16
IDX_DIM = 64
IDX_SCALE = (IDX_DIM ** -0.5) * (IDX_HEADS ** -0.5)
TOPK_MAX = 256
C_GROUPS = MIX_WIDTH // (2 * HEAD_DIM)
C_WIDTH = C_GROUPS * HEAD_DIM
CHUNK = 128
D_HEADS = MIX_WIDTH // (2 * HEAD_DIM)
D_WIDTH = D_HEADS * HEAD_DIM
REL_BUCKETS = 32
REL_MAX_DIST = 128
D_FF = 5632
N_EXPERTS = 8
TOP_K = 2
D_FF_EXPERT = 7168
Q_BLOCK = 128
EPS = 1e-6

EVEN_SPLITS = (A_WIDTH, 2 * A_WIDTH, 3 * A_WIDTH, 3 * A_WIDTH + Q_RANK,
               3 * A_WIDTH + Q_RANK + KV_RANK, 3 * A_WIDTH + Q_RANK + KV_RANK + IDX_DIM)
EVEN_IN = 3 * A_WIDTH + Q_RANK + KV_RANK + IDX_DIM + IDX_HEADS
ODD_SPLITS = (C_WIDTH, 2 * C_WIDTH, 2 * C_WIDTH + D_WIDTH, 2 * C_WIDTH + 2 * D_WIDTH)
ODD_IN = 2 * C_WIDTH + 3 * D_WIDTH
N_EVEN = (DEPTH + 1) // 2
N_ODD = DEPTH // 2

kernel_name = 'hybrid_conv_dsa_gmlp_stickbreak_moe'


def rmsnorm(x, g):
    xf = x.astype(jnp.float32)
    y = xf * lax.rsqrt(jnp.mean(xf * xf, axis=-1, keepdims=True) + EPS)
    return (y * g.astype(jnp.float32)).astype(x.dtype)


def swiglu(h, w_gate, w_up, w_down):
    return (jax.nn.silu(h @ w_gate) * (h @ w_up)) @ w_down


def rel_bucket(dist):
    n = jnp.maximum(dist, 0)
    max_exact = REL_BUCKETS // 2
    nf = jnp.maximum(n, max_exact).astype(jnp.float32)
    large = max_exact + (jnp.log(nf / max_exact) / math.log(REL_MAX_DIST / max_exact)
                         * (REL_BUCKETS - max_exact)).astype(jnp.int32)
    large = jnp.minimum(large, REL_BUCKETS - 1)
    return jnp.where(n < max_exact, n, large)


def short_conv_mixer(b_gate, c_gate, xv, conv_w):
    seq = xv.shape[1]
    z = c_gate * xv
    zp = jnp.pad(z, ((0, 0), (CONV_WIDTH - 1, 0), (0, 0)))
    y = conv_w[0] * zp[:, 0:seq]
    for j in range(1, CONV_WIDTH):
        y = y + conv_w[j] * zp[:, j:j + seq]
    return b_gate * y


def dsa_mixer(c_q, c_kv, k_idx, w_idx, g_cq, g_ckv, w_uq, w_uk, w_uv, w_qidx, rel_bias):
    bsz, seq, _ = c_q.shape
    c_q = rmsnorm(c_q, g_cq)
    c_kv = rmsnorm(c_kv, g_ckv)
    q = jnp.einsum('bsr,rhd->bshd', c_q, w_uq)
    q_lat = jnp.einsum('bshd,chd->bshc', q, w_uk)
    q_idx = jnp.einsum('bsr,rgd->bsgd', c_q, w_qidx)
    topk = min(TOPK_MAX, seq // 4)
    scale = HEAD_DIM ** -0.5
    outs = []
    for blk in range(seq // Q_BLOCK):
        t0 = blk * Q_BLOCK
        t1 = t0 + Q_BLOCK
        kk = min(topk, t1)
        tpos = t0 + jnp.arange(Q_BLOCK, dtype=jnp.int32)
        spos = jnp.arange(t1, dtype=jnp.int32)
        s_idx = jax.nn.relu(jnp.einsum('btgd,bsd->btgs', q_idx[:, t0:t1],
                                       k_idx[:, :t1]).astype(jnp.float32))
        score_raw = jnp.einsum('btgs,btg->bts', s_idx,
                               w_idx[:, t0:t1].astype(jnp.float32)) * IDX_SCALE
        score = jnp.where((spos[None, :] <= tpos[:, None])[None], score_raw, -jnp.inf)
        _, sel = lax.top_k(score, kk)
        valid = sel <= tpos[None, :, None]
        idx_sel = jnp.take_along_axis(score_raw, sel, axis=-1)
        ckv_sel = jax.vmap(lambda c, i: c[i])(c_kv[:, :t1], sel)
        logits = jnp.einsum('bthc,btkc->bhtk', q_lat[:, t0:t1], ckv_sel).astype(jnp.float32) * scale
        bias = rel_bias[rel_bucket(tpos[None, :, None] - sel)].astype(jnp.float32)
        logits = logits + jnp.transpose(bias, (0, 3, 1, 2)) + idx_sel[:, None]
        logits = jnp.where(valid[:, None], logits, -jnp.inf)
        p = jax.nn.softmax(logits, axis=-1).astype(ckv_sel.dtype)
        o_lat = jnp.einsum('bhtk,btkc->bthc', p, ckv_sel)
        outs.append(jnp.einsum('bthc,chd->bthd', o_lat, w_uv))
    return jnp.concatenate(outs, axis=1).reshape(bsz, seq, B_WIDTH)


def chunked_spatial_gating(u, v, g_v, w_s, b_s):
    bsz, seq, _ = v.shape
    v = rmsnorm(v, g_v)
    vc = v.reshape(bsz, seq // CHUNK, CHUNK, C_GROUPS, C_WIDTH // C_GROUPS)
    tril = jnp.tril(jnp.ones((CHUNK, CHUNK), dtype=bool))
    ws = jnp.where(tril[None], w_s, 0.0).astype(v.dtype)
    mixed = jnp.einsum('gts,bnsgc->bntgc', ws, vc) + jnp.transpose(b_s)[None, None, :, :, None]
    return u * mixed.reshape(bsz, seq, C_WIDTH)


def stick_breaking(q, k, v):
    bsz, seq, nh, hd = q.shape
    scale = hd ** -0.5
    outs = []
    for blk in range(seq // Q_BLOCK):
        t0 = blk * Q_BLOCK
        t1 = t0 + Q_BLOCK
        tpos = t0 + jnp.arange(Q_BLOCK, dtype=jnp.int32)
        spos = jnp.arange(t1, dtype=jnp.int32)
        past = (spos[None, :] < tpos[:, None])[None, None]
        z = jnp.einsum('bthd,bshd->bhts', q[:, t0:t1], k[:, :t1]).astype(jnp.float32) * scale
        log_keep = jnp.where(past, -jax.nn.softplus(z), 0.0)
        suffix = lax.cumsum(log_keep, axis=3, reverse=True)
        excl = jnp.concatenate([suffix[..., 1:], jnp.zeros_like(suffix[..., :1])], axis=-1)
        weights = jnp.where(past, jnp.exp(jax.nn.log_sigmoid(z) + excl), 0.0)
        outs.append(jnp.einsum('bhts,bshd->bthd', weights.astype(v.dtype), v[:, :t1]))
    return jnp.concatenate(outs, axis=1).reshape(bsz, seq, nh * hd)


def moe_swiglu(h, w_router, w_gate, w_up, w_down):
    logits = jnp.einsum('bsd,de->bse', h, w_router).astype(jnp.float32)
    top_val, top_idx = lax.top_k(logits, TOP_K)
    gates = jax.nn.softmax(top_val, axis=-1)
    combine = jnp.sum(jax.nn.one_hot(top_idx, N_EXPERTS, dtype=jnp.float32) * gates[..., None], axis=-2)
    combine = combine.astype(h.dtype)
    out = jnp.zeros_like(h)
    for e in range(N_EXPERTS):
        out = out + combine[..., e:e + 1] * swiglu(h, w_gate[e], w_up[e], w_down[e])
    return out


def even_layer(x, rel_bias, norm_mix, w_in, conv_w, norm_cq, norm_ckv, w_uq, w_uk, w_uv, w_qidx,
               w_out, norm_ffn, ffn_gate, ffn_up, ffn_down):
    h = rmsnorm(x, norm_mix)
    proj = h @ w_in
    a_b, a_c, a_x, c_q, c_kv, k_idx, w_idx = jnp.split(proj, EVEN_SPLITS, axis=-1)
    y_a = short_conv_mixer(a_b, a_c, a_x, conv_w)
    y_b = dsa_mixer(c_q, c_kv, k_idx, w_idx, norm_cq, norm_ckv, w_uq, w_uk, w_uv, w_qidx, rel_bias)
    x = x + jnp.concatenate([y_a, y_b], axis=-1) @ w_out
    h = rmsnorm(x, norm_ffn)
    return x + swiglu(h, ffn_gate, ffn_up, ffn_down)


def odd_layer(x, norm_mix, w_in, norm_v, w_s, b_s, w_out, norm_ffn, router, exp_gate, exp_up, exp_down):
    bsz, seq, _ = x.shape
    h = rmsnorm(x, norm_mix)
    proj = h @ w_in
    c_u, c_v, d_q, d_k, d_v = jnp.split(proj, ODD_SPLITS, axis=-1)
    y_c = chunked_spatial_gating(jax.nn.gelu(c_u), jax.nn.gelu(c_v), norm_v, w_s, b_s)
    y_d = stick_breaking(d_q.reshape(bsz, seq, D_HEADS, HEAD_DIM),
                         d_k.reshape(bsz, seq, D_HEADS, HEAD_DIM),
                         d_v.reshape(bsz, seq, D_HEADS, HEAD_DIM))
    x = x + jnp.concatenate([y_c, y_d], axis=-1) @ w_out
    h = rmsnorm(x, norm_ffn)
    return x + moe_swiglu(h, router, exp_gate, exp_up, exp_down)


def setup_inputs(seed: int = 0) -> dict:
    key = jax.random.key(seed)
    keys = jax.random.split(key, 32)
    counter = [0]

    def nxt():
        k = keys[counter[0]]
        counter[0] += 1
        return k

    def nrm(shape, fan_in):
        return jax.random.normal(nxt(), shape, jnp.float32) * (fan_in ** -0.5)

    def gain(shape):
        return 1.0 + 0.1 * jax.random.normal(nxt(), shape, jnp.float32)

    ne, no = N_EVEN, N_ODD
    return {
        'x': jax.random.normal(nxt(), (BATCH, SEQ, D_MODEL), jnp.float32),
        'rel_bias': 0.5 * jax.random.normal(nxt(), (REL_BUCKETS, B_HEADS), jnp.float32),
        'final_norm': gain((D_MODEL,)),
        'e_norm_mix': gain((ne, D_MODEL)),
        'e_w_in': nrm((ne, D_MODEL, EVEN_IN), D_MODEL),
        'e_conv_w': nrm((ne, CONV_WIDTH, A_WIDTH), CONV_WIDTH),
        'e_norm_cq': gain((ne, Q_RANK)),
        'e_norm_ckv': gain((ne, KV_RANK)),
        'e_w_uq': nrm((ne, Q_RANK, B_HEADS, HEAD_DIM), Q_RANK),
        'e_w_uk': nrm((ne, KV_RANK, B_HEADS, HEAD_DIM), KV_RANK),
        'e_w_uv': nrm((ne, KV_RANK, B_HEADS, HEAD_DIM), KV_RANK),
        'e_w_qidx': nrm((ne, Q_RANK, IDX_HEADS, IDX_DIM), Q_RANK),
        'e_w_out': nrm((ne, A_WIDTH + B_WIDTH, D_MODEL), A_WIDTH + B_WIDTH),
        'e_norm_ffn': gain((ne, D_MODEL)),
        'e_ffn_gate': nrm((ne, D_MODEL, D_FF), D_MODEL),
        'e_ffn_up': nrm((ne, D_MODEL, D_FF), D_MODEL),
        'e_ffn_down': nrm((ne, D_FF, D_MODEL), D_FF),
        'o_norm_mix': gain((no, D_MODEL)),
        'o_w_in': nrm((no, D_MODEL, ODD_IN), D_MODEL),
        'o_norm_v': gain((no, C_WIDTH)),
        'o_w_s': nrm((no, C_GROUPS, CHUNK, CHUNK), CHUNK),
        'o_b_s': gain((no, C_GROUPS, CHUNK)),
        'o_w_out': nrm((no, C_WIDTH + D_WIDTH, D_MODEL), C_WIDTH + D_WIDTH),
        'o_norm_ffn': gain((no, D_MODEL)),
        'o_router': nrm((no, D_MODEL, N_EXPERTS), D_MODEL),
        'o_exp_gate': nrm((no, N_EXPERTS, D_MODEL, D_FF_EXPERT), D_MODEL),
        'o_exp_up': nrm((no, N_EXPERTS, D_MODEL, D_FF_EXPERT), D_MODEL),
        'o_exp_down': nrm((no, N_EXPERTS, D_FF_EXPERT, D_MODEL), D_FF_EXPERT),
    }


def reference(x, rel_bias, final_norm,
              e_norm_mix, e_w_in, e_conv_w, e_norm_cq, e_norm_ckv, e_w_uq, e_w_uk, e_w_uv, e_w_qidx,
              e_w_out, e_norm_ffn, e_ffn_gate, e_ffn_up, e_ffn_down,
              o_norm_mix, o_w_in, o_norm_v, o_w_s, o_b_s, o_w_out, o_norm_ffn, o_router,
              o_exp_gate, o_exp_up, o_exp_down):
    for layer in range(DEPTH):
        i = layer // 2
        if layer % 2 == 0:
            x = even_layer(x, rel_bias, e_norm_mix[i], e_w_in[i], e_conv_w[i], e_norm_cq[i], e_norm_ckv[i],
                           e_w_uq[i], e_w_uk[i], e_w_uv[i], e_w_qidx[i], e_w_out[i], e_norm_ffn[i],
                           e_ffn_gate[i], e_ffn_up[i], e_ffn_down[i])
        else:
            x = odd_layer(x, o_norm_mix[i], o_w_in[i], o_norm_v[i], o_w_s[i], o_b_s[i], o_w_out[i],
                          o_norm_ffn[i], o_router[i], o_exp_gate[i], o_exp_up[i], o_exp_down[i])
    return rmsnorm(x, final_norm)
```

```cpp
#include <hip/hip_runtime.h>
#include <cstdio>
#include <cstdint>

#ifndef MK_ONE_LAUNCH
#define MK_ONE_LAUNCH 0
#endif

#define LAS __attribute__((address_space(3)))
#define GAS __attribute__((address_space(1)))
typedef unsigned short bf16_t;
typedef short bf16x8 __attribute__((ext_vector_type(8)));
typedef short s16x4 __attribute__((ext_vector_type(4)));
typedef float f32x2 __attribute__((ext_vector_type(2)));
typedef float f32x4 __attribute__((ext_vector_type(4)));
typedef float f32x16 __attribute__((ext_vector_type(16)));
typedef unsigned u32x2 __attribute__((ext_vector_type(2)));
typedef unsigned u32x4 __attribute__((ext_vector_type(4)));
typedef __bf16 bf16x2_t __attribute__((ext_vector_type(2)));
typedef GAS unsigned gu32;

#define DI __device__ __forceinline__

constexpr int DM = 2048, NB = 16, SEQ = 2048, MT = NB * SEQ;
constexpr int EVEN_IN = 3920, EVEN_INP = 4096, ODD_IN = 5120;
constexpr int DFF = 5632, NEXP = 8, DFFE = 7168;
constexpr float EPS = 1e-6f;
constexpr int QQ_N = 3072;
constexpr int CAT0_K = 3072;
constexpr int MOE_ROWS = 65536 + 2048;
constexpr int MOE_CHUNK_TILES = 88;

DI unsigned pk2(float a, float b) { bf16x2_t v = __builtin_convertvector((f32x2){a, b}, bf16x2_t); return __builtin_bit_cast(unsigned, v); }
DI float bf2f(bf16_t v) { return __builtin_bit_cast(float, (unsigned)v << 16); }
DI float bflo(unsigned w) { return __builtin_bit_cast(float, w << 16); }
DI float bfhi(unsigned w) { return __builtin_bit_cast(float, w & 0xffff0000u); }
DI float wave_sum(float v) {
#pragma unroll
    for (int o = 1; o < 64; o <<= 1) v += __shfl_xor(v, o);
    return v;
}
DI float fast_exp2(float x) { return __builtin_amdgcn_exp2f(x); }
DI float fast_log2(float x) { return __builtin_amdgcn_logf(x); }
DI float fast_rcp(float x) { return __builtin_amdgcn_rcpf(x); }

namespace pg8 {
constexpr int BM = 256, BK = 64, HALF = 128, HTB = HALF * BK * 2, STAGE_BYTES = 8 * HTB, NXCD = 8, WGM = 8;
__host__ __device__ __forceinline__ int lds_byte(int r, int c) { const int st = (r >> 4) * 2 + (c >> 5), rr = r & 15, cc = c & 31, ob = rr * 64 + cc * 2; return st * 1024 + (ob ^ (((ob >> 9) & 1) << 5)); }
__host__ __device__ __forceinline__ void stage_rc(int b, int& R, int& C) { const int st = b / 1024, sb = b % 1024, swz = sb ^ (((sb >> 9) & 1) << 5); R = (st >> 1) * 16 + swz / 64; C = (st & 1) * 32 + (swz % 64) / 2; }
__host__ __device__ __forceinline__ int perm32(int rho) { const int n = rho >> 4, i = rho & 15; return 8 * (i >> 2) + 4 * n + (i & 3); }

struct Unit { int pm, pn, bt; };
struct Gemm { const bf16_t* A; const bf16_t* Bt; int lda, ldb, K; };

struct Sched {
    int nM, nN, nwg, G, c, pm0, grouped; int ts[7];
    __device__ void init(int nM_, int nN_, int G_, int c_, int pm0_) { nM = nM_; nN = nN_; nwg = nM * nN; G = G_; c = c_; pm0 = pm0_; grouped = 0; for (int j = 0; j < 7; ++j) ts[j] = 0x7fffffff; }
    __device__ __forceinline__ bool next(int i, Unit& u) const {
        const long L = (long)i * G + c; if (L >= nwg) return false;
        int wgid = (int)L; { const int q = nwg / NXCD, r = nwg % NXCD, xcd = wgid % NXCD, off = wgid / NXCD; wgid = (xcd < r ? xcd * (q + 1) : r * (q + 1) + (xcd - r) * q) + off; }
        const int nig = WGM * nN, gid = wgid / nig, fm = gid * WGM, gsz = (nM - fm) < WGM ? (nM - fm) : WGM;
        u.pm = pm0 + fm + ((wgid % nig) % gsz); u.pn = (wgid % nig) / gsz;
        int e = 0;
#pragma unroll
        for (int j = 0; j < 7; ++j) e += (u.pm >= ts[j]) ? 1 : 0;
        u.bt = e * nN + u.pn; return true;
    }
};

DI f32x4 gelu_tanh4(f32x4 v) {
    f32x4 o;
#pragma unroll
    for (int j = 0; j < 4; ++j) { const float x = v[j]; const float t = x * (1.0f + 0.044715f * x * x) * (-2.0f * 0.7978845608f * 1.44269504f); o[j] = x * fast_rcp(1.0f + fast_exp2(t)); }
    return o;
}
struct EpiStore {
    static constexpr bool PERM = true;
    bf16_t* O; int ldc, row_sub, gelu_tiles;
    DI void operator()(const f32x4 (&acc)[2][2][4][2], const Unit& u, int wr, int wc, int fr, int fq) const {
        const int row0 = u.pm * BM - row_sub + wr * 64 + fr, col0 = u.pn * BM + wc * 32 + 8 * fq; const bool g = u.pn < gelu_tiles;
#pragma unroll
        for (int ai = 0; ai < 2; ++ai)
#pragma unroll
            for (int m = 0; m < 4; ++m) { bf16_t* rowp = O + (size_t)(row0 + ai * HALF + m * 16) * ldc + col0;
#pragma unroll
                for (int bj = 0; bj < 2; ++bj) { f32x4 v0 = acc[ai][bj][m][0], v1 = acc[ai][bj][m][1];
                    if (g) { v0 = gelu_tanh4(v0); v1 = gelu_tanh4(v1); }
                    u32x4 w; w.x = pk2(v0[0], v0[1]); w.y = pk2(v0[2], v0[3]); w.z = pk2(v1[0], v1[1]); w.w = pk2(v1[2], v1[3]);
                    *(u32x4*)(rowp + bj * HALF) = w; } }
    }
};
struct EpiRes {
    static constexpr bool PERM = false;
    const float* base; float* out; int ldc;
    DI void operator()(const f32x4 (&acc)[2][2][4][2], const Unit& u, int wr, int wc, int fr, int fq) const {
        const int row0 = u.pm * BM + wr * 64 + fr, col0 = u.pn * BM + wc * 32 + 4 * fq;
#pragma unroll
        for (int ai = 0; ai < 2; ++ai)
#pragma unroll
            for (int m = 0; m < 4; ++m) { const size_t off = (size_t)(row0 + ai * HALF + m * 16) * ldc + col0;
#pragma unroll
                for (int bj = 0; bj < 2; ++bj)
#pragma unroll
                    for (int n = 0; n < 2; ++n) { const f32x4 b = *(const f32x4*)(base + off + bj * HALF + n * 16); *(f32x4*)(out + off + bj * HALF + n * 16) = b + acc[ai][bj][m][n]; } }
    }
};
struct EpiSwiglu {
    static constexpr bool PERM = true;
    bf16_t* O; int ldc, row_sub;
    DI void operator()(const f32x4 (&acc)[2][2][4][2], const Unit& u, int wr, int wc, int fr, int fq) const {
        const int row0 = u.pm * BM - row_sub + wr * 64 + fr, col0 = u.pn * HALF + wc * 32 + 8 * fq;
#pragma unroll
        for (int ai = 0; ai < 2; ++ai)
#pragma unroll
            for (int m = 0; m < 4; ++m) { float o[8];
#pragma unroll
                for (int n = 0; n < 2; ++n)
#pragma unroll
                    for (int j = 0; j < 4; ++j) { const float g = acc[ai][0][m][n][j], up = acc[ai][1][m][n][j]; o[4 * n + j] = g * fast_rcp(1.0f + fast_exp2(-1.44269504f * g)) * up; }
                u32x4 w; w.x = pk2(o[0], o[1]); w.y = pk2(o[2], o[3]); w.z = pk2(o[4], o[5]); w.w = pk2(o[6], o[7]);
                *(u32x4*)(O + (size_t)(row0 + ai * HALF + m * 16) * ldc + col0) = w; }
    }
};

template <class Epi>
DI void gemm_phase(LAS unsigned char* lds, const Gemm g, const Sched& S, const Epi& E) {
    const int tid = threadIdx.x, wid = __builtin_amdgcn_readfirstlane(tid >> 6), lane = tid & 63, wr = wid >> 2, wc = wid & 3, fr = lane & 15, fq = lane >> 4;
    const int K = g.K, nt = K / BK;
    unsigned voffA[2], voffB[2];
#pragma unroll
    for (int i = 0; i < 2; ++i) { int R, C; stage_rc(tid * 16 + i * 8192, R, C); const int Rb = Epi::PERM ? ((R & ~31) + perm32(R & 31)) : R;
        voffA[i] = (unsigned)(R * g.lda + C) * 2u; voffB[i] = (unsigned)(Rb * g.ldb + C) * 2u; }
    const size_t kstep = (size_t)(BK * 2);
    const size_t hstepA = (size_t)HALF * g.lda * 2, hstepB = (size_t)HALF * g.ldb * 2;
    const size_t tstepA = 2 * hstepA, tstepB = 2 * hstepB;
    const unsigned ldsw = (unsigned)wid * 1024u;
    const int aoff = lds_byte(wr * 64 + fr, fq * 8), boff = lds_byte(wc * 32 + fr, fq * 8);
#define PG8_SA(b, h) (((b) * 2 + (h)) * HTB)
#define PG8_SB(b, h) ((4 + (b) * 2 + (h)) * HTB)
#define PG8_STAGE(bufoff, gbase, voff) do { _Pragma("unroll") for (int _i = 0; _i < 2; ++_i) \
        __builtin_amdgcn_global_load_lds((const unsigned*)((const char*)(gbase) + (voff)[_i]), (LAS unsigned*)(lds + (bufoff) + ldsw + _i * 8192), 16, 0, 0); } while (0)
#define PG8_LDA(dst, b, h) do { _Pragma("unroll") for (int m = 0; m < 4; ++m) _Pragma("unroll") for (int k = 0; k < 2; ++k) dst[m][k] = *(const LAS bf16x8*)(lds + PG8_SA(b, h) + aoff + m * 2048 + k * 1024); } while (0)
#define PG8_LDB(dst, b, h) do { _Pragma("unroll") for (int n = 0; n < 2; ++n) _Pragma("unroll") for (int k = 0; k < 2; ++k) dst[n][k] = *(const LAS bf16x8*)(lds + PG8_SB(b, h) + boff + n * 2048 + k * 1024); } while (0)
#define PG8_MMA(ai, bj, At, Bt) do { __builtin_amdgcn_s_setprio(1); _Pragma("unroll") for (int m = 0; m < 4; ++m) _Pragma("unroll") for (int n = 0; n < 2; ++n) _Pragma("unroll") for (int k = 0; k < 2; ++k) \
        acc[ai][bj][m][n] = __builtin_amdgcn_mfma_f32_16x16x32_bf16(Bt[n][k], At[m][k], acc[ai][bj][m][n], 0, 0, 0); __builtin_amdgcn_s_setprio(0); } while (0)
#define PG8_WAIT_V(n) asm volatile("s_waitcnt vmcnt(" #n ")" ::: "memory")
#define PG8_WAIT_L(n) asm volatile("s_waitcnt lgkmcnt(" #n ")" ::: "memory")
#define PG8_BAR __builtin_amdgcn_s_barrier()
#define PG8_SCHED __builtin_amdgcn_sched_barrier(0)
    Unit cur, nxt; int ui = 0;
    if (!S.next(0, cur)) return;
    f32x4 acc[2][2][4][2];
#pragma unroll
    for (int a = 0; a < 2; ++a)
#pragma unroll
        for (int b = 0; b < 2; ++b)
#pragma unroll
            for (int m = 0; m < 4; ++m)
#pragma unroll
                for (int n = 0; n < 2; ++n) acc[a][b][m][n] = (f32x4){0.f, 0.f, 0.f, 0.f};
    bf16x8 At[4][2], B0[2][2], B1[2][2];
    const char* cA = (const char*)g.A + (size_t)cur.pm * tstepA; const char* cB = (const char*)g.Bt + (size_t)cur.bt * tstepB;
    PG8_STAGE(PG8_SB(0, 0), cB, voffB); PG8_STAGE(PG8_SB(0, 1), cB + hstepB, voffB); PG8_STAGE(PG8_SA(0, 0), cA, voffA); PG8_STAGE(PG8_SA(0, 1), cA + hstepA, voffA);
    if (wr == 1) PG8_BAR;
    PG8_WAIT_V(2); PG8_BAR;
    PG8_STAGE(PG8_SB(1, 0), cB + kstep, voffB); PG8_STAGE(PG8_SA(1, 0), cA + kstep, voffA); PG8_STAGE(PG8_SB(1, 1), cB + hstepB + kstep, voffB);
    PG8_WAIT_V(6); PG8_BAR;
    for (;;) {
        const bool has_next = S.next(ui + 1, nxt);
        const char* nA = has_next ? (const char*)g.A + (size_t)nxt.pm * tstepA : cA; const char* nB = has_next ? (const char*)g.Bt + (size_t)nxt.bt * tstepB : cB;
        for (int t = 0; t < nt; t += 2) {
            const bool last = (t == nt - 2);
            const char* a1 = cA + (size_t)(t + 1) * kstep;
            const char* a2 = last ? nA : cA + (size_t)(t + 2) * kstep; const char* b2 = last ? nB : cB + (size_t)(t + 2) * kstep;
            const char* a3 = a2 + kstep; const char* b3 = b2 + kstep;
            PG8_LDB(B0, 0, 0); PG8_LDB(B1, 0, 1); PG8_SCHED; PG8_LDA(At, 0, 0); PG8_STAGE(PG8_SA(1, 1), a1 + hstepA, voffA);
            PG8_WAIT_V(8); PG8_WAIT_L(0); PG8_BAR; PG8_MMA(0, 0, At, B0); PG8_MMA(0, 1, At, B1); PG8_BAR; PG8_SCHED;
            PG8_LDA(At, 0, 1); PG8_STAGE(PG8_SB(0, 0), b2, voffB); PG8_STAGE(PG8_SB(0, 1), b2 + hstepB, voffB); PG8_STAGE(PG8_SA(0, 0), a2, voffA);
            PG8_WAIT_V(8); PG8_WAIT_L(0); PG8_BAR; PG8_MMA(1, 0, At, B0); PG8_MMA(1, 1, At, B1); PG8_BAR; PG8_SCHED;
            PG8_LDB(B0, 1, 0); PG8_LDB(B1, 1, 1); PG8_SCHED; PG8_LDA(At, 1, 0); PG8_STAGE(PG8_SA(0, 1), a2 + hstepA, voffA);
            PG8_WAIT_V(8); PG8_WAIT_L(0); PG8_BAR; PG8_MMA(0, 0, At, B0); PG8_MMA(0, 1, At, B1); PG8_BAR; PG8_SCHED;
            PG8_LDA(At, 1, 1); PG8_STAGE(PG8_SB(1, 0), b3, voffB); PG8_STAGE(PG8_SB(1, 1), b3 + hstepB, voffB); PG8_STAGE(PG8_SA(1, 0), a3, voffA);
            PG8_WAIT_V(8); PG8_WAIT_L(0); PG8_BAR; PG8_MMA(1, 0, At, B0); PG8_MMA(1, 1, At, B1); PG8_BAR; PG8_SCHED;
        }
        if (wr == 0) PG8_BAR;
        E(acc, cur, wr, wc, fr, fq);
        if (!has_next) break;
#pragma unroll
        for (int a = 0; a < 2; ++a)
#pragma unroll
            for (int b = 0; b < 2; ++b)
#pragma unroll
                for (int m = 0; m < 4; ++m)
#pragma unroll
                    for (int n = 0; n < 2; ++n) acc[a][b][m][n] = (f32x4){0.f, 0.f, 0.f, 0.f};
        cur = nxt; cA = nA; cB = nB; ++ui;
        if (wr == 1) PG8_BAR;
    }
    PG8_WAIT_V(0);
    PG8_BAR;
#undef PG8_SA
#undef PG8_SB
#undef PG8_STAGE
#undef PG8_LDA
#undef PG8_LDB
#undef PG8_MMA
#undef PG8_WAIT_V
#undef PG8_WAIT_L
#undef PG8_BAR
#undef PG8_SCHED
}
}

#define XB_TMO      128
#define XB_XCNT(j)  (256  + 64 * (j))
#define XB_XSUB(j)  (1280 + 64 * (j))
#define XB_XGEN(j)  (2304 + 64 * (j))
#define XB_TOP      3328
#define XB_TOPGEN   3392
#define XCD_BAR_WORDS 3456
#define XB_SPIN_CAP (1u << 22)

DI unsigned xb_ld(unsigned* p)              { return __hip_atomic_load(p, __ATOMIC_RELAXED, __HIP_MEMORY_SCOPE_AGENT); }
DI unsigned xb_add(unsigned* p, unsigned v) { return __hip_atomic_fetch_add(p, v, __ATOMIC_RELAXED, __HIP_MEMORY_SCOPE_AGENT); }
DI unsigned xb_xcc_id() { return (unsigned)__builtin_amdgcn_s_getreg((3 << 11) | 20) & 0xFu; }
#define XB_SPIN(cond, bar) do { unsigned _sp = 0; while (cond) { __builtin_amdgcn_s_sleep(1); \
    if ((++_sp & 255u) == 0u) { if (xb_ld(&(bar)[XB_TMO])) break; if (_sp > XB_SPIN_CAP) { atomicAdd(&(bar)[XB_TMO], 1u); break; } } } } while (0)

struct XcdBarrier { unsigned* bar; unsigned x; volatile LAS unsigned* st; };

DI XcdBarrier xcd_barrier_post(unsigned* bar, volatile LAS unsigned* st) {
    XcdBarrier b; b.bar = bar; b.x = xb_xcc_id(); b.st = st;
    if (threadIdx.x == 0) (void)xb_add(&bar[XB_XCNT(b.x)], 1u);
    return b;
}
DI void xcd_barrier_complete(unsigned* bar, unsigned x, unsigned& nloc, unsigned& nx) {
    const unsigned G = gridDim.x * gridDim.y * gridDim.z;
    unsigned sum, cnt, mine, sp = 0u;
    for (;;) {
        sum = 0u; cnt = 0u; mine = 0u;
#pragma unroll
        for (unsigned j = 0; j < 16; ++j) { const unsigned c = xb_ld(&bar[XB_XCNT(j)]); sum += c; cnt += (c > 0u) ? 1u : 0u; mine = (j == x) ? c : mine; }
        if (sum == G) break;
        __builtin_amdgcn_s_sleep(1);
        if ((++sp & 255u) == 0u) { if (xb_ld(&bar[XB_TMO])) break; if (sp > XB_SPIN_CAP) { atomicAdd(&bar[XB_TMO], 1u); break; } }
    }
    nloc = mine > 0u ? mine : 1u; nx = cnt > 0u ? cnt : 1u;
}
DI void xcd_barrier(const XcdBarrier& b) {
    asm volatile("s_waitcnt vmcnt(0)" ::: "memory");
    __syncthreads();
    if (threadIdx.x == 0) {
        unsigned* bar = b.bar;
        __builtin_amdgcn_s_waitcnt(0);
        unsigned nloc = b.st[0], nx = b.st[1];
        if (nloc == 0u) { xcd_barrier_complete(bar, b.x, nloc, nx); b.st[0] = nloc; b.st[1] = nx; }
        const unsigned old = xb_add(&bar[XB_XSUB(b.x)], 1u);
        const unsigned gen = old / nloc;
        if (old + 1u == (gen + 1u) * nloc) {
            __builtin_amdgcn_fence(__ATOMIC_RELEASE, "agent");
            asm volatile("s_waitcnt vmcnt(0)" ::: "memory");
            const unsigned og = xb_add(&bar[XB_TOP], 1u);
            const unsigned tg = og / nx;
            if (og + 1u == (tg + 1u) * nx) xb_add(&bar[XB_TOPGEN], 1u);
            else XB_SPIN(xb_ld(&bar[XB_TOPGEN]) == tg, bar);
            __builtin_amdgcn_fence(__ATOMIC_ACQUIRE, "agent");
            xb_add(&bar[XB_XGEN(b.x)], 1u);
            asm volatile("s_waitcnt vmcnt(0)" ::: "memory");
        } else {
            XB_SPIN(xb_ld(&bar[XB_XGEN(b.x)]) == gen, bar);
            __builtin_amdgcn_fence(__ATOMIC_ACQUIRE, "agent");
            asm volatile("s_waitcnt vmcnt(0)" ::: "memory");
        }
    }
    __syncthreads();
}

constexpr size_t MiB = 1u << 20;
constexpr size_t WS_CTL = 0, CTL_ZERO_BYTES = 1 * MiB;
constexpr size_t WS_TAB = 1 * MiB;
constexpr size_t WS_WIN1 = 5 * MiB;
constexpr size_t WS_WOUT1 = 25 * MiB;
constexpr size_t WS_WS = 33 * MiB;
constexpr size_t WS_WGU1 = 34 * MiB;
constexpr size_t WS_WDN1 = 482 * MiB;
constexpr size_t WS_L0 = 706 * MiB;
constexpr size_t WS_WIN0 = WS_L0;
constexpr size_t WS_WQQ = WS_L0 + 16 * MiB;
constexpr size_t WS_WOUT0 = WS_L0 + 19 * MiB;
constexpr size_t WS_WGU0 = WS_L0 + 31 * MiB;
constexpr size_t WS_WDN0 = WS_L0 + 75 * MiB;
constexpr size_t WS_CQN = WS_L0 + 97 * MiB;
constexpr size_t WS_CKV = WS_L0 + 129 * MiB;
constexpr size_t WS_KX = WS_L0 + 145 * MiB;
constexpr size_t WS_WIDX = WS_L0 + 149 * MiB;
constexpr size_t WS_ACT = WS_L0 + 152 * MiB;
constexpr size_t WS_PROJ0 = WS_ACT;
constexpr size_t WS_CAT0 = WS_ACT + 256 * MiB;
constexpr size_t WS_QQ = WS_ACT + 448 * MiB;
constexpr size_t WS_H0 = WS_QQ;
constexpr size_t WS_SC = WS_ACT + 640 * MiB;
constexpr size_t WS_H1 = WS_SC;
constexpr size_t WS_ACT0 = WS_ACT;
constexpr size_t WS_H2 = WS_ACT;
constexpr size_t WS_PROJ1 = WS_ACT + 128 * MiB;
constexpr size_t WS_CAT1 = WS_ACT + 448 * MiB;
constexpr size_t WS_HS = WS_L0;
constexpr size_t WS_Y = WS_L0 + 264 * MiB;
constexpr size_t WS_ACT1 = WS_L0 + 528 * MiB;
constexpr size_t WS_H3 = WS_L0 + 840 * MiB;
constexpr size_t WS_END = WS_L0 + 968 * MiB;
static_assert(WS_SC + 128 * MiB <= WS_END && WS_CAT1 + 128 * MiB <= WS_H3 && WS_ACT1 + (size_t)MOE_CHUNK_TILES * 256 * DFFE * 2 <= WS_H3, "ws map");
constexpr size_t TAB_ER = 0;
constexpr size_t TAB_GATE = 512 * 1024;
constexpr size_t TAB_SLOT = 1024 * 1024;
constexpr int CW_BAR = 1024;
constexpr int CW_CNT = 8192;
constexpr int RING_BYTES = 131072, MISC_OFF = RING_BYTES, LDS_BYTES = 147456;

struct Args { const float* in[28]; float* out; unsigned char* ws; int ph_lo, ph_hi; };
enum { I_X = 0, I_RELB, I_FNORM, I_ENMIX, I_EWIN, I_ECONV, I_ENCQ, I_ENCKV, I_EWUQ, I_EWUK, I_EWUV, I_EWQIDX, I_EWOUT, I_ENFFN, I_EGATE, I_EUP, I_EDOWN,
       I_ONMIX, I_OWIN, I_ONV, I_OWS, I_OBS, I_OWOUT, I_ONFFN, I_OROUTER, I_OGATE, I_OUP, I_ODOWN };

struct Frame {
    LAS unsigned char* lds;
    int tid, lane, wave, gw, NGW, G, bid;
    unsigned char* ws;
};

DI void tr_item(const float* W, int ldsrc, int N, bf16_t* WT, int ldd, int koff, int row_off, int mode, int nblk, LAS float* scr, int item, int lane) {
    const int kb = item / nblk, nb = item % nblk, k0 = 64 * kb, n0 = 32 * nb;
    const int nn = n0 + (lane & 31); const bool ok = nn < N;
#pragma unroll 8
    for (int i = 0; i < 32; ++i) { const int kk = 2 * i + (lane >> 5); scr[kk * 33 + (lane & 31)] = ok ? W[(size_t)(k0 + kk) * ldsrc + nn] : 0.f; }
    asm volatile("s_waitcnt lgkmcnt(0)" ::: "memory");
    const int c = lane & 7;
    const int drow0 = (mode == 1) ? ((n0 >> 7) * 256 + (n0 & 127) + row_off) : (row_off + n0);
#pragma unroll
    for (int j = 0; j < 4; ++j) { const int n = (lane >> 3) + 8 * j; const LAS float* s = scr + (8 * c) * 33 + n;
        u32x4 o; o.x = pk2(s[0 * 33], s[1 * 33]); o.y = pk2(s[2 * 33], s[3 * 33]); o.z = pk2(s[4 * 33], s[5 * 33]); o.w = pk2(s[6 * 33], s[7 * 33]);
        *(u32x4*)(WT + (size_t)(drow0 + n) * ldd + koff + k0 + 8 * c) = o; }
    asm volatile("s_waitcnt lgkmcnt(0)" ::: "memory");
}
DI void tr_job(const Frame& F, const float* W, int K, int ldsrc, int N, int Npad, bf16_t* WT, int ldd, int koff, int row_off, int mode) {
    LAS float* scr = (LAS float*)(F.lds + F.wave * 16384);
    const int nblk = Npad / 32, nitems = (K / 64) * nblk;
    for (int it = F.gw; it < nitems; it += F.NGW) tr_item(W, ldsrc, N, WT, ldd, koff, row_off, mode, nblk, scr, it, F.lane);
}

DI void rms_row_to_bf16(const float* xrow, const float* g, bf16_t* orow, int lane) {
    const f32x4* xr = (const f32x4*)xrow + lane; const f32x4* gr = (const f32x4*)g + lane;
    f32x4 v[8]; float s = 0.f;
#pragma unroll
    for (int j = 0; j < 8; ++j) { v[j] = xr[64 * j]; s += (v[j].x * v[j].x + v[j].y * v[j].y) + (v[j].z * v[j].z + v[j].w * v[j].w); }
    const float rstd = 1.0f / sqrtf(wave_sum(s) * (1.f / DM) + EPS);
    u32x2* o8 = (u32x2*)orow + lane;
#pragma unroll
    for (int j = 0; j < 8; ++j) { const f32x4 gg = gr[64 * j]; u32x2 w; w.x = pk2(v[j].x * rstd * gg.x, v[j].y * rstd * gg.y); w.y = pk2(v[j].z * rstd * gg.z, v[j].w * rstd * gg.w); o8[64 * j] = w; }
}
DI void rms_phase(const Frame& F, const float* x, const float* g, bf16_t* out) {
    for (int m = F.gw; m < MT; m += F.NGW) rms_row_to_bf16(x + (size_t)m * DM, g, out + (size_t)m * DM, F.lane);
}

DI void p0_prologue(const Frame& F, const Args& a) {
    unsigned char* ws = F.ws;
    tr_job(F, a.in[I_EWIN], 2048, EVEN_IN, EVEN_IN, EVEN_INP, (bf16_t*)(ws + WS_WIN0), 2048, 0, 0, 0);
    tr_job(F, a.in[I_EWQIDX], 512, 1024, 1024, 1024, (bf16_t*)(ws + WS_WQQ), 512, 0, 2048, 0);
    tr_job(F, a.in[I_EWOUT], 1024, 2048, 2048, 2048, (bf16_t*)(ws + WS_WOUT0), CAT0_K, 0, 0, 0);
    tr_job(F, a.in[I_EGATE], 2048, DFF, DFF, DFF, (bf16_t*)(ws + WS_WGU0), 2048, 0, 0, 1);
    tr_job(F, a.in[I_EUP], 2048, DFF, DFF, DFF, (bf16_t*)(ws + WS_WGU0), 2048, 0, 128, 1);
    tr_job(F, a.in[I_EDOWN], DFF, 2048, 2048, 2048, (bf16_t*)(ws + WS_WDN0), DFF, 0, 0, 0);
    tr_job(F, a.in[I_OWIN], 2048, ODD_IN, ODD_IN, ODD_IN, (bf16_t*)(ws + WS_WIN1), 2048, 0, 0, 0);
    tr_job(F, a.in[I_OWOUT], 2048, 2048, 2048, 2048, (bf16_t*)(ws + WS_WOUT1), 2048, 0, 0, 0);
    for (int e = 0; e < NEXP; ++e) {
        tr_job(F, a.in[I_OGATE] + (size_t)e * 2048 * DFFE, 2048, DFFE, DFFE, DFFE, (bf16_t*)(ws + WS_WGU1) + (size_t)e * 2 * DFFE * 2048, 2048, 0, 0, 1);
        tr_job(F, a.in[I_OUP] + (size_t)e * 2048 * DFFE, 2048, DFFE, DFFE, DFFE, (bf16_t*)(ws + WS_WGU1) + (size_t)e * 2 * DFFE * 2048, 2048, 0, 128, 1);
        tr_job(F, a.in[I_ODOWN] + (size_t)e * DFFE * 2048, DFFE, 2048, 2048, 2048, (bf16_t*)(ws + WS_WDN1) + (size_t)e * 2048 * DFFE, DFFE, 0, 0, 0);
    }
    const int gt = F.bid * 512 + F.tid, NT = F.G * 512;
    { const float* uq = a.in[I_EWUQ]; const float* uk = a.in[I_EWUK]; bf16_t* o = (bf16_t*)(ws + WS_WQQ);
      for (int i = gt; i < 2048 * 512; i += NT) { const int n = i >> 9, r = i & 511, h = n >> 8, c = n & 255;
          const f32x4* pa = (const f32x4*)(uq + (size_t)r * 1024 + h * 128); const f32x4* pb = (const f32x4*)(uk + (size_t)c * 1024 + h * 128); float s = 0.f;
#pragma unroll 8
          for (int d = 0; d < 32; ++d) { const f32x4 x = pa[d], y = pb[d]; s += (x.x * y.x + x.y * y.y) + (x.z * y.z + x.w * y.w); }
          o[i] = (bf16_t)(pk2(s, 0.f) & 0xffffu); } }
    { const float* uv = a.in[I_EWUV]; const float* wo = a.in[I_EWOUT]; bf16_t* o = (bf16_t*)(ws + WS_WOUT0);
      for (int i = gt; i < 2048 * 2048; i += NT) { const int n = i >> 11, hc = i & 2047, h = hc >> 8, c = hc & 255;
          const f32x4* pa = (const f32x4*)(uv + (size_t)c * 1024 + h * 128); const float* pb = wo + (size_t)(1024 + h * 128) * 2048 + n; float s = 0.f;
#pragma unroll 4
          for (int d = 0; d < 32; ++d) { const f32x4 x = pa[d]; s += (x.x * pb[(size_t)(4 * d) * 2048] + x.y * pb[(size_t)(4 * d + 1) * 2048]) + (x.z * pb[(size_t)(4 * d + 2) * 2048] + x.w * pb[(size_t)(4 * d + 3) * 2048]); }
          o[(size_t)n * CAT0_K + 1024 + hc] = (bf16_t)(pk2(s, 0.f) & 0xffffu); } }
    { const float* w = a.in[I_OWS]; bf16_t* o = (bf16_t*)(ws + WS_WS);
      for (int i = gt; i < 8 * 128 * 128; i += NT) { const int t = (i >> 7) & 127, s = i & 127; o[i] = (bf16_t)(pk2(s <= t ? w[i] : 0.f, 0.f) & 0xffffu); } }
    rms_phase(F, a.in[I_X], a.in[I_ENMIX], (bf16_t*)(ws + WS_H0));
}

DI void p2_rows(const Frame& F, const Args& a) {
    const bf16_t* proj = (const bf16_t*)(F.ws + WS_PROJ0);
    bf16_t* cqn = (bf16_t*)(F.ws + WS_CQN); bf16_t* ckv = (bf16_t*)(F.ws + WS_CKV); bf16_t* kx = (bf16_t*)(F.ws + WS_KX); float* widx = (float*)(F.ws + WS_WIDX);
    bf16_t* cat = (bf16_t*)(F.ws + WS_CAT0);
    const float* gcq = a.in[I_ENCQ]; const float* gckv = a.in[I_ENCKV]; const float* cw = a.in[I_ECONV];
    const int lane = F.lane;
    float w0[2][8], w1[2][8], w2[2][8];
#pragma unroll
    for (int j = 0; j < 2; ++j)
#pragma unroll
        for (int e = 0; e < 8; ++e) { const int c = 512 * j + 8 * lane + e; w0[j][e] = cw[c]; w1[j][e] = cw[1024 + c]; w2[j][e] = cw[2048 + c]; }
    float gq[8], gk[8];
#pragma unroll
    for (int e = 0; e < 8; ++e) { gq[e] = gcq[8 * lane + e]; gk[e] = gckv[8 * (lane & 31) + e]; }
    for (int m = F.gw; m < MT; m += F.NGW) {
        const bf16_t* row = proj + (size_t)m * EVEN_INP;
        const int s = m & (SEQ - 1);
        { const u32x4 v = *(const u32x4*)(row + 3072 + 8 * lane); float f[8] = {bflo(v.x), bfhi(v.x), bflo(v.y), bfhi(v.y), bflo(v.z), bfhi(v.z), bflo(v.w), bfhi(v.w)}; float ss = 0.f;
#pragma unroll
          for (int e = 0; e < 8; ++e) ss += f[e] * f[e];
          const float rstd = 1.0f / sqrtf(wave_sum(ss) * (1.f / 512.f) + EPS);
          u32x4 o; o.x = pk2(f[0] * rstd * gq[0], f[1] * rstd * gq[1]); o.y = pk2(f[2] * rstd * gq[2], f[3] * rstd * gq[3]); o.z = pk2(f[4] * rstd * gq[4], f[5] * rstd * gq[5]); o.w = pk2(f[6] * rstd * gq[6], f[7] * rstd * gq[7]);
          *(u32x4*)(cqn + (size_t)m * 512 + 8 * lane) = o; }
        { const u32x4 v = *(const u32x4*)(row + 3584 + 8 * (lane & 31)); float f[8] = {bflo(v.x), bfhi(v.x), bflo(v.y), bfhi(v.y), bflo(v.z), bfhi(v.z), bflo(v.w), bfhi(v.w)}; float ss = 0.f;
#pragma unroll
          for (int e = 0; e < 8; ++e) ss += f[e] * f[e];
          const float rstd = 1.0f / sqrtf(wave_sum(ss) * (0.5f / 256.f) + EPS);
          u32x4 o; o.x = pk2(f[0] * rstd * gk[0], f[1] * rstd * gk[1]); o.y = pk2(f[2] * rstd * gk[2], f[3] * rstd * gk[3]); o.z = pk2(f[4] * rstd * gk[4], f[5] * rstd * gk[5]); o.w = pk2(f[6] * rstd * gk[6], f[7] * rstd * gk[7]);
          if (lane < 32) *(u32x4*)(ckv + (size_t)m * 256 + 8 * lane) = o; }
        if (lane < 8) *(u32x4*)(kx + (size_t)m * 64 + 8 * lane) = *(const u32x4*)(row + 3840 + 8 * lane);
        if (lane < 16) widx[(size_t)m * 16 + lane] = bf2f(row[3904 + lane]) * (0.125f * 0.25f);
#pragma unroll
        for (int j = 0; j < 2; ++j) { const int c0 = 512 * j + 8 * lane; float acc[8];
            { const u32x4 vc = *(const u32x4*)(row + 1024 + c0), vx = *(const u32x4*)(row + 2048 + c0);
              const float fc[8] = {bflo(vc.x), bfhi(vc.x), bflo(vc.y), bfhi(vc.y), bflo(vc.z), bfhi(vc.z), bflo(vc.w), bfhi(vc.w)}, fx[8] = {bflo(vx.x), bfhi(vx.x), bflo(vx.y), bfhi(vx.y), bflo(vx.z), bfhi(vx.z), bflo(vx.w), bfhi(vx.w)};
#pragma unroll
              for (int e = 0; e < 8; ++e) acc[e] = w2[j][e] * (fc[e] * fx[e]); }
            if (s >= 1) { const bf16_t* r1 = row - EVEN_INP; const u32x4 vc = *(const u32x4*)(r1 + 1024 + c0), vx = *(const u32x4*)(r1 + 2048 + c0);
              const float fc[8] = {bflo(vc.x), bfhi(vc.x), bflo(vc.y), bfhi(vc.y), bflo(vc.z), bfhi(vc.z), bflo(vc.w), bfhi(vc.w)}, fx[8] = {bflo(vx.x), bfhi(vx.x), bflo(vx.y), bfhi(vx.y), bflo(vx.z), bfhi(vx.z), bflo(vx.w), bfhi(vx.w)};
#pragma unroll
              for (int e = 0; e < 8; ++e) acc[e] += w1[j][e] * (fc[e] * fx[e]); }
            if (s >= 2) { const bf16_t* r2 = row - 2 * EVEN_INP; const u32x4 vc = *(const u32x4*)(r2 + 1024 + c0), vx = *(const u32x4*)(r2 + 2048 + c0);
              const float fc[8] = {bflo(vc.x), bfhi(vc.x), bflo(vc.y), bfhi(vc.y), bflo(vc.z), bfhi(vc.z), bflo(vc.w), bfhi(vc.w)}, fx[8] = {bflo(vx.x), bfhi(vx.x), bflo(vx.y), bfhi(vx.y), bflo(vx.z), bfhi(vx.z), bflo(vx.w), bfhi(vx.w)};
#pragma unroll
              for (int e = 0; e < 8; ++e) acc[e] += w0[j][e] * (fc[e] * fx[e]); }
            const u32x4 vb = *(const u32x4*)(row + c0); const float fb[8] = {bflo(vb.x), bfhi(vb.x), bflo(vb.y), bfhi(vb.y), bflo(vb.z), bfhi(vb.z), bflo(vb.w), bfhi(vb.w)};
            u32x4 o; o.x = pk2(fb[0] * acc[0], fb[1] * acc[1]); o.y = pk2(fb[2] * acc[2], fb[3] * acc[3]); o.z = pk2(fb[4] * acc[4], fb[5] * acc[5]); o.w = pk2(fb[6] * acc[6], fb[7] * acc[7]);
            *(u32x4*)(cat + (size_t)m * CAT0_K + c0) = o; }
    }
}

DI unsigned kx_lds_off(int key_local, int ch) { const int R = key_local >> 1, C = ((key_local & 1) << 3) | ch; return (unsigned)(R * 256 + ((C ^ (R & 15)) << 4)); }
DI void p4_indexer(const Frame& F) {
    const bf16_t* qq = (const bf16_t*)(F.ws + WS_QQ); const bf16_t* kx = (const bf16_t*)(F.ws + WS_KX); const float* widx = (const float*)(F.ws + WS_WIDX);
    _Float16* sc = (_Float16*)(F.ws + WS_SC);
    const int lane = F.lane, r = lane & 31, h = lane >> 5, w = F.wave, tid = F.tid;
    LAS unsigned char* kb = F.lds;
    const int nunits = NB * (SEQ / 16);
    for (int rd = 0; rd * F.G < nunits; ++rd) {
        const int j = (rd & 1) ? (F.G - 1 - F.bid) : F.bid; const int u = rd * F.G + j; if (u >= nunits) continue;
        const int qg = (SEQ / 16 - 1) - u / NB, b = u % NB;
        const int t0 = qg * 16, t1 = ((t0 >> 7) + 1) << 7;
        const int tq = t0 + 2 * w + (r >> 4), g = r & 15;
        bf16x8 aq[4];
#pragma unroll
        for (int s = 0; s < 4; ++s) aq[s] = *(const bf16x8*)(qq + (size_t)(b * SEQ + tq) * QQ_N + 2048 + g * 64 + 16 * s + 8 * h);
        float wts[16];
#pragma unroll
        for (int i = 0; i < 16; ++i) wts[i] = widx[(size_t)(b * SEQ + t0 + 2 * w + (i >> 3)) * 16 + ((i & 3) + 8 * ((i >> 2) & 1) + 4 * h)];
        const int tme = t0 + 2 * w + h;
        unsigned kv[64];
#pragma unroll
        for (int c = 0; c < 4; ++c) {
            if (512 * c < t1) {
                __syncthreads();
#pragma unroll
                for (int i = 0; i < 8; ++i) { const int p = tid + 512 * i, kl = p >> 3, ch = p & 7;
                    if (512 * c + kl < t1) *(LAS u32x4*)(kb + kx_lds_off(kl, ch)) = *(const u32x4*)(kx + (size_t)(b * SEQ + 512 * c + kl) * 64 + 8 * ch); }
                __syncthreads();
            }
#pragma unroll
            for (int jn = 0; jn < 16; ++jn) { const int n = 16 * c + jn;
                if (32 * n < t1) {
                    f32x16 acc;
#pragma unroll
                    for (int i = 0; i < 16; ++i) acc[i] = 0.f;
#pragma unroll
                    for (int s = 0; s < 4; ++s) { const bf16x8 bk = *(const LAS bf16x8*)(kb + kx_lds_off(32 * jn + r, 2 * s + h)); acc = __builtin_amdgcn_mfma_f32_32x32x16_bf16(aq[s], bk, acc, 0, 0, 0); }
                    float p0 = 0.f, p1 = 0.f;
#pragma unroll
                    for (int i = 0; i < 8; ++i) { p0 += wts[i] * fmaxf(acc[i], 0.f); p1 += wts[8 + i] * fmaxf(acc[8 + i], 0.f); }
                    const float mine = h ? p1 : p0, send = h ? p0 : p1;
                    float tot = mine + __shfl_xor(send, 32);
                    if (32 * n + r > tme) tot = -__builtin_inff();
                    const unsigned ub = __builtin_bit_cast(unsigned, tot);
                    kv[n] = (ub & 0x80000000u) ? ~ub : (ub | 0x80000000u);
                    __builtin_amdgcn_sched_barrier(0);
                } else kv[n] = 0u;
            }
        }
        unsigned T = 0u;
        if (t1 > 256) {
            for (int bit = 31; bit >= 0; --bit) { const unsigned cand = T | (1u << bit); int cnt = 0;
#pragma unroll
                for (int n = 0; n < 64; ++n) cnt += (kv[n] >= cand) ? 1 : 0;
                cnt += __shfl_xor(cnt, 1); cnt += __shfl_xor(cnt, 2); cnt += __shfl_xor(cnt, 4); cnt += __shfl_xor(cnt, 8); cnt += __shfl_xor(cnt, 16);
                T = (cnt >= 256) ? cand : T; }
        }
        _Float16* orow = sc + (size_t)(b * SEQ + tme) * SEQ;
#pragma unroll
        for (int n = 0; n < 64; ++n) if (32 * n < t1) { const unsigned k = kv[n]; const bool sel = (k >= T) && (k > 0x007fffffu);
            const unsigned ub = (k & 0x80000000u) ? (k ^ 0x80000000u) : ~k; const float v = sel ? __builtin_bit_cast(float, ub) : -__builtin_inff();
            orow[32 * n + r] = (_Float16)v; }
    }
    __syncthreads();
}

DI unsigned kv_off(int row, int ch) { return (unsigned)(512 * row + 16 * (ch ^ (((row & 3) << 2) | ((row >> 2) & 3)))); }
DI s16x4 tr_read4(const LAS unsigned char* p) { return __builtin_amdgcn_ds_read_tr16_b64_v4i16((LAS s16x4*)p); }
DI bf16x8 cat8(s16x4 a, s16x4 b) { bf16x8 v; v[0] = a[0]; v[1] = a[1]; v[2] = a[2]; v[3] = a[3]; v[4] = b[0]; v[5] = b[1]; v[6] = b[2]; v[7] = b[3]; return v; }
DI bf16x8 pack8(float a0, float a1, float a2, float a3, float a4, float a5, float a6, float a7) { u32x4 w; w.x = pk2(a0, a1); w.y = pk2(a2, a3); w.z = pk2(a4, a5); w.w = pk2(a6, a7); return __builtin_bit_cast(bf16x8, w); }
DI void p5_dsa(const Frame& F, const Args& a) {
    const bf16_t* qq = (const bf16_t*)(F.ws + WS_QQ); const bf16_t* ckv = (const bf16_t*)(F.ws + WS_CKV); const _Float16* sc = (const _Float16*)(F.ws + WS_SC);
    bf16_t* cat = (bf16_t*)(F.ws + WS_CAT0);
    const int lane = F.lane, r = lane & 31, h = lane >> 5, tid = F.tid, dh = F.wave & 1;
    const int q4 = (lane & 15) >> 2, p4 = lane & 3, blk = (lane >> 4) & 1;
    LAS unsigned char* kvb = F.lds;
    LAS unsigned char* scb = F.lds + 32768;
    LAS float* lut = (LAS float*)(F.lds + 40960);
    __syncthreads();
    for (int i = tid; i < 8 * 129; i += 512) { const int hd = i / 129, d = i % 129; int bk = d;
        if (d >= 16) { bk = 16 + (int)(logf((float)d / 16.0f) / 2.0794415416798357f * 16.0f); bk = bk > 31 ? 31 : bk; }
        lut[hd * 132 + d] = a.in[I_RELB][bk * 8 + hd] * 1.44269504f; }
    __syncthreads();
    const float SC2 = 0.08838834764831845f * 1.44269504f;
    const int nunits = NB * (SEQ / 32) * 2;
    for (int rd = 0; rd * F.G < nunits; ++rd) {
        const int j = (rd & 1) ? (F.G - 1 - F.bid) : F.bid; const int u = rd * F.G + j; if (u >= nunits) continue;
        const int hg = u & 1, u2 = u >> 1, head = 4 * hg + (F.wave >> 1);
        const int qt = (SEQ / 32 - 1) - u2 / NB, b = u2 % NB, q0 = qt * 32, nkt = qt + 1, tq = q0 + r;
        bf16x8 qf[16];
#pragma unroll
        for (int s = 0; s < 16; ++s) qf[s] = *(const bf16x8*)(qq + (size_t)(b * SEQ + tq) * QQ_N + head * 256 + 16 * s + 8 * h);
        f32x16 O[4];
#pragma unroll
        for (int c = 0; c < 4; ++c)
#pragma unroll
            for (int i = 0; i < 16; ++i) O[c][i] = 0.f;
        float m_run = -__builtin_inff(), l_run = 0.f;
        u32x4 st0, st1; u32x2 st2 = {0u, 0u};
        const int skey0 = tid >> 5, sch = tid & 31, sq = tid >> 3, spc = tid & 7;
#define DSA_LOAD(kt) do { const bf16_t* src = ckv + (size_t)(b * SEQ + 32 * (kt)) * 256; st0 = *(const u32x4*)(src + (size_t)skey0 * 256 + 8 * sch); st1 = *(const u32x4*)(src + (size_t)(skey0 + 16) * 256 + 8 * sch); \
        if (tid < 256) st2 = *(const u32x2*)(sc + (size_t)(b * SEQ + q0 + sq) * SEQ + 32 * (kt) + 4 * spc); } while (0)
#define DSA_WRITE(bufi) do { LAS unsigned char* kd_ = kvb + (bufi) * 16384; *(LAS u32x4*)(kd_ + kv_off(skey0, sch)) = st0; *(LAS u32x4*)(kd_ + kv_off(skey0 + 16, sch)) = st1; \
        if (tid < 256) *(LAS u32x2*)(scb + (bufi) * 2304 + sq * 72 + spc * 8) = st2; } while (0)
        __syncthreads();
        DSA_LOAD(0); DSA_WRITE(0);
        __syncthreads();
        for (int kt = 0; kt < nkt; ++kt) {
            const int cur = kt & 1;
            if (kt + 1 < nkt) DSA_LOAD(kt + 1);
            const LAS unsigned char* kd = kvb + cur * 16384; const LAS unsigned char* sd = scb + cur * 2304;
            f32x16 S;
#pragma unroll
            for (int i = 0; i < 16; ++i) S[i] = 0.f;
#pragma unroll
            for (int s = 0; s < 16; ++s) { const bf16x8 kf = *(const LAS bf16x8*)(kd + kv_off(r, 2 * s + h)); S = __builtin_amdgcn_mfma_f32_32x32x16_bf16(kf, qf[s], S, 0, 0, 0); if ((s & 3) == 3) __builtin_amdgcn_sched_barrier(0); }
            float mx = -__builtin_inff();
#pragma unroll
            for (int gq = 0; gq < 4; ++gq) { const u32x2 iw = *(const LAS u32x2*)(sd + r * 72 + (2 * gq + h) * 8);
                const _Float16 h0 = __builtin_bit_cast(_Float16, (unsigned short)(iw.x & 0xffffu)), h1 = __builtin_bit_cast(_Float16, (unsigned short)(iw.x >> 16)), h2 = __builtin_bit_cast(_Float16, (unsigned short)(iw.y & 0xffffu)), h3 = __builtin_bit_cast(_Float16, (unsigned short)(iw.y >> 16));
                const float idx[4] = {(float)h0, (float)h1, (float)h2, (float)h3};
#pragma unroll
                for (int e = 0; e < 4; ++e) { const int i = 4 * gq + e, key = 32 * kt + 8 * gq + 4 * h + e; int dist = tq - key; dist = dist < 0 ? 0 : (dist > 128 ? 128 : dist);
                    const float x = S[i] * SC2 + lut[head * 132 + dist] + idx[e] * 1.44269504f; S[i] = x; mx = fmaxf(mx, x); } }
            mx = fmaxf(mx, __shfl_xor(mx, 32));
            const float m_new = fmaxf(m_run, mx), msafe = (m_new == -__builtin_inff()) ? 0.f : m_new, alpha = fast_exp2(m_run - msafe);
            float rs = 0.f;
#pragma unroll
            for (int i = 0; i < 16; ++i) { S[i] = fast_exp2(S[i] - msafe); rs += S[i]; }
            rs += __shfl_xor(rs, 32);
            l_run = l_run * alpha + rs; m_run = m_new;
#pragma unroll
            for (int c = 0; c < 4; ++c)
#pragma unroll
                for (int i = 0; i < 16; ++i) O[c][i] *= alpha;
            const bf16x8 pf0 = pack8(S[0], S[1], S[2], S[3], S[4], S[5], S[6], S[7]), pf1 = pack8(S[8], S[9], S[10], S[11], S[12], S[13], S[14], S[15]);
#pragma unroll
            for (int c = 0; c < 4; ++c) {
                const int chn = 4 * (4 * dh + c) + 2 * blk + (p4 >> 1), bo = 8 * (p4 & 1);
                const bf16x8 v0 = cat8(tr_read4(kd + kv_off(0 + 4 * h + q4, chn) + bo), tr_read4(kd + kv_off(8 + 4 * h + q4, chn) + bo));
                const bf16x8 v1 = cat8(tr_read4(kd + kv_off(16 + 4 * h + q4, chn) + bo), tr_read4(kd + kv_off(24 + 4 * h + q4, chn) + bo));
                O[c] = __builtin_amdgcn_mfma_f32_32x32x16_bf16(v0, pf0, O[c], 0, 0, 0);
                O[c] = __builtin_amdgcn_mfma_f32_32x32x16_bf16(v1, pf1, O[c], 0, 0, 0);
                __builtin_amdgcn_sched_barrier(0);
            }
            if (kt + 1 < nkt) DSA_WRITE(cur ^ 1);
            __syncthreads();
        }
#undef DSA_LOAD
#undef DSA_WRITE
        const float inv = 1.0f / l_run;
        bf16_t* orow = cat + (size_t)(b * SEQ + tq) * CAT0_K + 1024 + head * 256 + 128 * dh;
#pragma unroll
        for (int c = 0; c < 4; ++c)
#pragma unroll
            for (int gq = 0; gq < 4; ++gq) { u32x2 w; w.x = pk2(O[c][4 * gq] * inv, O[c][4 * gq + 1] * inv); w.y = pk2(O[c][4 * gq + 2] * inv, O[c][4 * gq + 3] * inv);
                *(u32x2*)(orow + 32 * c + 8 * gq + 4 * h) = w; }
    }
    __syncthreads();
}

DI unsigned img_off(int row, int ch) { return (unsigned)(256 * row + 16 * (ch ^ (((row & 3) << 2) | ((row >> 2) & 3)))); }
DI void p12_gmlp(const Frame& F, const Args& a) {
    const bf16_t* proj = (const bf16_t*)(F.ws + WS_PROJ1); const bf16_t* wsm = (const bf16_t*)(F.ws + WS_WS); bf16_t* cat = (bf16_t*)(F.ws + WS_CAT1);
    const float* gv = a.in[I_ONV]; const float* bs = a.in[I_OBS];
    const int lane = F.lane, r = lane & 31, h = lane >> 5, w = F.wave, tid = F.tid;
    const int q4 = (lane & 15) >> 2, p4 = lane & 3, blk = (lane >> 4) & 1;
    LAS unsigned char* img = F.lds;
    LAS float* rs = (LAS float*)(F.lds + 32768);
    for (int u = F.bid; u < NB * (SEQ / 128); u += F.G) {
        const int b = u / (SEQ / 128), ch0 = u % (SEQ / 128); const size_t row0 = (size_t)b * SEQ + (size_t)ch0 * 128;
        __syncthreads();
        for (int i = 0; i < 16; ++i) { const int s = 16 * w + i; const bf16_t* vr = proj + (row0 + s) * ODD_IN + 1024; float ss = 0.f;
#pragma unroll
            for (int jj = 0; jj < 2; ++jj) { const u32x4 v = *(const u32x4*)(vr + 512 * jj + 8 * lane); const float f[8] = {bflo(v.x), bfhi(v.x), bflo(v.y), bfhi(v.y), bflo(v.z), bfhi(v.z), bflo(v.w), bfhi(v.w)};
#pragma unroll
                for (int e = 0; e < 8; ++e) ss += f[e] * f[e]; }
            ss = wave_sum(ss); if (lane == 0) rs[s] = 1.0f / sqrtf(ss * (1.f / 1024.f) + EPS); }
        __syncthreads();
        for (int g = 0; g < 8; ++g) {
#pragma unroll
            for (int i = 0; i < 4; ++i) { const int p = tid + 512 * i, s = p >> 4, chk = p & 15;
                const u32x4 v = *(const u32x4*)(proj + (row0 + s) * ODD_IN + 1024 + g * 128 + 8 * chk); const float rr = rs[s];
                const f32x4 g0 = *(const f32x4*)(gv + g * 128 + 8 * chk), g1 = *(const f32x4*)(gv + g * 128 + 8 * chk + 4);
                u32x4 o; o.x = pk2(bflo(v.x) * rr * g0.x, bfhi(v.x) * rr * g0.y); o.y = pk2(bflo(v.y) * rr * g0.z, bfhi(v.y) * rr * g0.w); o.z = pk2(bflo(v.z) * rr * g1.x, bfhi(v.z) * rr * g1.y); o.w = pk2(bflo(v.w) * rr * g1.z, bfhi(v.w) * rr * g1.w);
                *(LAS u32x4*)(img + (s >> 5) * 8192 + img_off(s & 31, chk)) = o; }
            __syncthreads();
            const int tb = w & 3, t = 32 * tb + r;
#pragma unroll
            for (int cc = 0; cc < 2; ++cc) { const int cb = 2 * (w >> 2) + cc;
                f32x16 D;
#pragma unroll
                for (int i = 0; i < 16; ++i) D[i] = 0.f;
                for (int ks = 0; ks <= 2 * tb + 1; ++ks) {
                    const LAS unsigned char* im = img + (ks >> 1) * 8192; const int k2 = ks & 1;
                    const int chn = 4 * cb + 2 * blk + (p4 >> 1), bo = 8 * (p4 & 1);
                    const bf16x8 af = cat8(tr_read4(im + img_off(16 * k2 + 8 * h + 0 + q4, chn) + bo), tr_read4(im + img_off(16 * k2 + 8 * h + 4 + q4, chn) + bo));
                    const bf16x8 bf = *(const bf16x8*)(wsm + (size_t)g * 16384 + (size_t)t * 128 + 16 * ks + 8 * h);
                    D = __builtin_amdgcn_mfma_f32_32x32x16_bf16(af, bf, D, 0, 0, 0);
                }
                const float bias = bs[g * 128 + t];
                const bf16_t* urow = proj + (row0 + t) * ODD_IN + g * 128 + 32 * cb; bf16_t* orow = cat + (row0 + t) * 2048 + g * 128 + 32 * cb;
#pragma unroll
                for (int gq = 0; gq < 4; ++gq) { const u32x2 uu = *(const u32x2*)(urow + 8 * gq + 4 * h);
                    u32x2 o; o.x = pk2(bflo(uu.x) * (D[4 * gq] + bias), bfhi(uu.x) * (D[4 * gq + 1] + bias)); o.y = pk2(bflo(uu.y) * (D[4 * gq + 2] + bias), bfhi(uu.y) * (D[4 * gq + 3] + bias));
                    *(u32x2*)(orow + 8 * gq + 4 * h) = o; }
            }
            __syncthreads();
        }
    }
    __syncthreads();
}

DI void p12_stick(const Frame& F) {
    const bf16_t* proj = (const bf16_t*)(F.ws + WS_PROJ1); bf16_t* cat = (bf16_t*)(F.ws + WS_CAT1);
    const int lane = F.lane, r = lane & 31, h = lane >> 5, w = F.wave, tid = F.tid;
    const int q4 = (lane & 15) >> 2, p4 = lane & 3, blk = (lane >> 4) & 1;
    LAS unsigned char* kb = F.lds;
    LAS unsigned char* vb = F.lds + 16384;
    const float SC2 = 0.08838834764831845f * 1.44269504f;
    const int nunits = NB * 8 * (SEQ / 256);
    for (int rd = 0; rd * F.G < nunits; ++rd) {
        const int j = (rd & 1) ? (F.G - 1 - F.bid) : F.bid; const int u = rd * F.G + j; if (u >= nunits) continue;
        const int qb = (SEQ / 256 - 1) - u / (NB * 8), bh = u % (NB * 8), b = bh >> 3, head = bh & 7;
        const int Q0 = qb * 256, tq = Q0 + 32 * w + r, ktd = (Q0 >> 5) + w, kt_hi = (Q0 >> 5) + 7;
        const bf16_t* base = proj + (size_t)b * SEQ * ODD_IN + head * 128;
        bf16x8 qf[8];
#pragma unroll
        for (int s = 0; s < 8; ++s) qf[s] = *(const bf16x8*)(base + (size_t)tq * ODD_IN + 2048 + 16 * s + 8 * h);
        f32x16 O[4];
#pragma unroll
        for (int c = 0; c < 4; ++c)
#pragma unroll
            for (int i = 0; i < 16; ++i) O[c][i] = 0.f;
        float R = 0.f;
        u32x4 st0, st1; const int skey = tid >> 4, sch = tid & 15;
#define SB_LOAD(kt) do { const bf16_t* src = base + (size_t)(32 * (kt) + skey) * ODD_IN + 8 * sch; st0 = *(const u32x4*)(src + 3072); st1 = *(const u32x4*)(src + 4096); } while (0)
#define SB_WRITE(bufi) do { *(LAS u32x4*)(kb + (bufi) * 8192 + img_off(skey, sch)) = st0; *(LAS u32x4*)(vb + (bufi) * 8192 + img_off(skey, sch)) = st1; } while (0)
        __syncthreads();
        SB_LOAD(kt_hi); SB_WRITE(0);
        __syncthreads();
        int cur = 0;
        for (int kt = kt_hi; kt >= 0; --kt) {
            if (kt > 0) SB_LOAD(kt - 1);
            if (kt <= ktd) {
                const LAS unsigned char* kd = kb + cur * 8192; const LAS unsigned char* vd = vb + cur * 8192;
                f32x16 S;
#pragma unroll
                for (int i = 0; i < 16; ++i) S[i] = 0.f;
#pragma unroll
                for (int s = 0; s < 8; ++s) { const bf16x8 kf = *(const LAS bf16x8*)(kd + img_off(r, 2 * s + h)); S = __builtin_amdgcn_mfma_f32_32x32x16_bf16(kf, qf[s], S, 0, 0, 0); }
                float lk[16], G[4];
#pragma unroll
                for (int gq = 0; gq < 4; ++gq) { G[gq] = 0.f;
#pragma unroll
                    for (int e = 0; e < 4; ++e) { const int i = 4 * gq + e, key = 32 * kt + 8 * gq + 4 * h + e; const bool past = key < tq;
                        const float z = S[i] * SC2, az = fabsf(z), sp = fmaxf(z, 0.f) + fast_log2(1.0f + fast_exp2(-az));
                        lk[i] = past ? -sp : 0.f; S[i] = past ? (z - sp) : -__builtin_inff(); G[gq] += lk[i]; } }
                float PG[4];
#pragma unroll
                for (int gq = 0; gq < 4; ++gq) PG[gq] = __shfl_xor(G[gq], 32);
                float hi = 0.f;
                float wv[16];
#pragma unroll
                for (int gq = 3; gq >= 0; --gq) { const float above = hi + (h ? 0.f : PG[gq]);
                    float run = R + above;
#pragma unroll
                    for (int e = 3; e >= 0; --e) { const int i = 4 * gq + e; wv[i] = fast_exp2(S[i] + run); run += lk[i]; }
                    hi += G[gq] + PG[gq]; }
                R += hi;
                const bf16x8 pf0 = pack8(wv[0], wv[1], wv[2], wv[3], wv[4], wv[5], wv[6], wv[7]), pf1 = pack8(wv[8], wv[9], wv[10], wv[11], wv[12], wv[13], wv[14], wv[15]);
#pragma unroll
                for (int c = 0; c < 4; ++c) {
                    const int chn = 4 * c + 2 * blk + (p4 >> 1), bo = 8 * (p4 & 1);
                    const bf16x8 v0 = cat8(tr_read4(vd + img_off(0 + 4 * h + q4, chn) + bo), tr_read4(vd + img_off(8 + 4 * h + q4, chn) + bo));
                    const bf16x8 v1 = cat8(tr_read4(vd + img_off(16 + 4 * h + q4, chn) + bo), tr_read4(vd + img_off(24 + 4 * h + q4, chn) + bo));
                    O[c] = __builtin_amdgcn_mfma_f32_32x32x16_bf16(v0, pf0, O[c], 0, 0, 0);
                    O[c] = __builtin_amdgcn_mfma_f32_32x32x16_bf16(v1, pf1, O[c], 0, 0, 0);
                }
            }
            if (kt > 0) SB_WRITE(cur ^ 1);
            __syncthreads();
            cur ^= 1;
        }
#undef SB_LOAD
#undef SB_WRITE
        bf16_t* orow = cat + (size_t)(b * SEQ + tq) * 2048 + 1024 + head * 128;
#pragma unroll
        for (int c = 0; c < 4; ++c)
#pragma unroll
            for (int gq = 0; gq < 4; ++gq) { u32x2 o; o.x = pk2(O[c][4 * gq], O[c][4 * gq + 1]); o.y = pk2(O[c][4 * gq + 2], O[c][4 * gq + 3]);
                *(u32x2*)(orow + 32 * c + 8 * gq + 4 * h) = o; }
    }
    __syncthreads();
}

DI void p14_router(const Frame& F, const Args& a, const float* x3) {
    bf16_t* h3 = (bf16_t*)(F.ws + WS_H3); const float* gn = a.in[I_ONFFN]; const float* wr = a.in[I_OROUTER];
    int* tab_er = (int*)(F.ws + WS_TAB + TAB_ER); float* tab_gate = (float*)(F.ws + WS_TAB + TAB_GATE); unsigned* gcnt = (unsigned*)(F.ws + WS_CTL) + CW_CNT;
    const int lane = F.lane, w = F.wave, tid = F.tid;
    LAS float* wrT = (LAS float*)F.lds;
    LAS int* lcnt = (LAS int*)(F.lds + 65536);
    LAS int* lbase = lcnt + 8;
    LAS int* tokE = lcnt + 16;
    LAS int* tokR = tokE + 256;
    __syncthreads();
    for (int i = tid; i < 2048 * 8; i += 512) wrT[(i & 7) * 2048 + (i >> 3)] = wr[i];
    if (tid < 8) lcnt[tid] = 0;
    __syncthreads();
    for (int grp = F.bid; grp < MT / 128; grp += F.G) {
        for (int i = 0; i < 16; ++i) {
            const int tl = 16 * w + i, m = grp * 128 + tl;
            const f32x4* xr = (const f32x4*)(x3 + (size_t)m * DM) + lane; const f32x4* gr = (const f32x4*)gn + lane;
            f32x4 v[8]; float s = 0.f;
#pragma unroll
            for (int j = 0; j < 8; ++j) { v[j] = xr[64 * j]; s += (v[j].x * v[j].x + v[j].y * v[j].y) + (v[j].z * v[j].z + v[j].w * v[j].w); }
            const float rstd = 1.0f / sqrtf(wave_sum(s) * (1.f / DM) + EPS);
            u32x2* o8 = (u32x2*)(h3 + (size_t)m * DM) + lane;
#pragma unroll
            for (int j = 0; j < 8; ++j) { const f32x4 gg = gr[64 * j]; v[j].x *= rstd * gg.x; v[j].y *= rstd * gg.y; v[j].z *= rstd * gg.z; v[j].w *= rstd * gg.w;
                u32x2 ww; ww.x = pk2(v[j].x, v[j].y); ww.y = pk2(v[j].z, v[j].w); o8[64 * j] = ww; }
            float lg[8];
#pragma unroll
            for (int e = 0; e < 8; ++e) { float acc = 0.f;
#pragma unroll
                for (int j = 0; j < 8; ++j) { const f32x4 ww = *(const LAS f32x4*)(wrT + e * 2048 + 4 * (lane + 64 * j)); acc += (v[j].x * ww.x + v[j].y * ww.y) + (v[j].z * ww.z + v[j].w * ww.w); }
                lg[e] = wave_sum(acc); }
            int i1 = 0; float v1 = lg[0];
#pragma unroll
            for (int e = 1; e < 8; ++e) if (lg[e] > v1) { v1 = lg[e]; i1 = e; }
            int i2 = -1; float v2 = -__builtin_inff();
#pragma unroll
            for (int e = 0; e < 8; ++e) if (e != i1 && lg[e] > v2) { v2 = lg[e]; i2 = e; }
            if (lane == 0) {
                const float g1 = 1.0f / (1.0f + __expf(v2 - v1));
                tab_gate[(size_t)m * 2] = g1; tab_gate[(size_t)m * 2 + 1] = 1.0f - g1;
                tokE[tl * 2] = i1; tokE[tl * 2 + 1] = i2;
                tokR[tl * 2] = __hip_atomic_fetch_add(lcnt + i1, 1, __ATOMIC_RELAXED, __HIP_MEMORY_SCOPE_WORKGROUP);
                tokR[tl * 2 + 1] = __hip_atomic_fetch_add(lcnt + i2, 1, __ATOMIC_RELAXED, __HIP_MEMORY_SCOPE_WORKGROUP);
            }
        }
        __syncthreads();
        if (tid < 8) lbase[tid] = (int)__hip_atomic_fetch_add(gcnt + 64 * tid, (unsigned)lcnt[tid], __ATOMIC_RELAXED, __HIP_MEMORY_SCOPE_AGENT);
        __syncthreads();
        if (tid < 256) { const int e = tokE[tid]; tab_er[((size_t)grp * 128) * 4 + tid * 2] = e; tab_er[((size_t)grp * 128) * 4 + tid * 2 + 1] = lbase[e] + tokR[tid]; }
        __syncthreads();
        if (tid < 8) lcnt[tid] = 0;
        __syncthreads();
    }
}

DI void moe_tiles(const Frame& F, int (&ts)[9], int (&cnt)[8]) {
    const unsigned* gcnt = (const unsigned*)(F.ws + WS_CTL) + CW_CNT;
    ts[0] = 0;
#pragma unroll
    for (int e = 0; e < 8; ++e) { cnt[e] = (int)__builtin_amdgcn_readfirstlane(__hip_atomic_load(gcnt + 64 * e, __ATOMIC_RELAXED, __HIP_MEMORY_SCOPE_AGENT)); ts[e + 1] = ts[e] + ((cnt[e] + 255) >> 8); }
}

DI void p15_gather(const Frame& F) {
    const bf16_t* h3 = (const bf16_t*)(F.ws + WS_H3); bf16_t* hs = (bf16_t*)(F.ws + WS_HS);
    const int* tab_er = (const int*)(F.ws + WS_TAB + TAB_ER); int* tab_slot = (int*)(F.ws + WS_TAB + TAB_SLOT);
    int ts[9], cnt[8]; moe_tiles(F, ts, cnt);
    const int lane = F.lane;
    for (int m = F.gw; m < MT; m += F.NGW) {
        const u32x4* src = (const u32x4*)(h3 + (size_t)m * DM) + lane;
        const u32x4 v0 = src[0], v1 = src[64], v2 = src[128], v3 = src[192];
#pragma unroll
        for (int k = 0; k < 2; ++k) { const int e = tab_er[(size_t)m * 4 + 2 * k], rk = tab_er[(size_t)m * 4 + 2 * k + 1];
            int t0 = 0;
#pragma unroll
            for (int q = 0; q < 8; ++q) t0 = (e == q) ? ts[q] : t0;
            const int slot = t0 * 256 + rk;
            u32x4* dst = (u32x4*)(hs + (size_t)slot * DM) + lane; dst[0] = v0; dst[64] = v1; dst[128] = v2; dst[192] = v3;
            if (lane == 0) tab_slot[(size_t)m * 2 + k] = slot; }
    }
    for (int idx = F.gw; idx < 8 * 256; idx += F.NGW) { const int e = idx >> 8, rr = idx & 255; int t0 = 0, t1 = 0, c = 0;
#pragma unroll
        for (int q = 0; q < 8; ++q) { t0 = (e == q) ? ts[q] : t0; t1 = (e == q) ? ts[q + 1] : t1; c = (e == q) ? cnt[q] : c; }
        const int row = t0 * 256 + c + rr;
        if (row < t1 * 256) { u32x4* dst = (u32x4*)(hs + (size_t)row * DM) + lane; const u32x4 z = {0u, 0u, 0u, 0u}; dst[0] = z; dst[64] = z; dst[128] = z; dst[192] = z; } }
}

DI void p22_final(const Frame& F, const Args& a, float* out) {
    const bf16_t* Y = (const bf16_t*)(F.ws + WS_Y); const float* tab_gate = (const float*)(F.ws + WS_TAB + TAB_GATE); const int* tab_slot = (const int*)(F.ws + WS_TAB + TAB_SLOT);
    const float* gn = a.in[I_FNORM]; const int lane = F.lane;
    for (int m = F.gw; m < MT; m += F.NGW) {
        const float g1 = tab_gate[(size_t)m * 2], g2 = tab_gate[(size_t)m * 2 + 1]; const int s1 = tab_slot[(size_t)m * 2], s2 = tab_slot[(size_t)m * 2 + 1];
        f32x4* xr = (f32x4*)(out + (size_t)m * DM) + lane; const u32x2* y1 = (const u32x2*)(Y + (size_t)s1 * DM) + lane; const u32x2* y2 = (const u32x2*)(Y + (size_t)s2 * DM) + lane;
        const f32x4* gr = (const f32x4*)gn + lane;
        f32x4 v[8]; float s = 0.f;
#pragma unroll
        for (int j = 0; j < 8; ++j) { v[j] = xr[64 * j]; const u32x2 a1 = y1[64 * j], a2 = y2[64 * j];
            v[j].x += g1 * bflo(a1.x) + g2 * bflo(a2.x); v[j].y += g1 * bfhi(a1.x) + g2 * bfhi(a2.x); v[j].z += g1 * bflo(a1.y) + g2 * bflo(a2.y); v[j].w += g1 * bfhi(a1.y) + g2 * bfhi(a2.y);
            s += (v[j].x * v[j].x + v[j].y * v[j].y) + (v[j].z * v[j].z + v[j].w * v[j].w); }
        const float rstd = 1.0f / sqrtf(wave_sum(s) * (1.f / DM) + EPS);
#pragma unroll
        for (int j = 0; j < 8; ++j) { const f32x4 gg = gr[64 * j]; f32x4 o; o.x = v[j].x * rstd * gg.x; o.y = v[j].y * rstd * gg.y; o.z = v[j].z * rstd * gg.z; o.w = v[j].w * rstd * gg.w; xr[64 * j] = o; }
    }
}

constexpr int N_PHASES = 23;
__global__ void __launch_bounds__(512, 2) fwd(Args args) {
    extern __shared__ __attribute__((aligned(16))) unsigned char lds_raw[];
    Frame F;
    F.lds = (LAS unsigned char*)lds_raw; F.tid = threadIdx.x; F.lane = F.tid & 63; F.wave = __builtin_amdgcn_readfirstlane(F.tid >> 6);
    F.G = gridDim.x; F.bid = blockIdx.x; F.gw = F.bid * 8 + F.wave; F.NGW = F.G * 8; F.ws = args.ws;
    volatile LAS unsigned* MISC = (volatile LAS unsigned*)(F.lds + MISC_OFF);
    if (F.tid < 64) MISC[F.tid] = 0u;
    __syncthreads();
    const int lo = args.ph_lo, hi = args.ph_hi;
    XcdBarrier bar; bar.bar = (unsigned*)(F.ws + WS_CTL) + CW_BAR; bar.x = 0; bar.st = MISC + 8;
    if (hi - lo > 1) bar = xcd_barrier_post((unsigned*)(F.ws + WS_CTL) + CW_BAR, MISC + 8);
#ifdef ONLY_PHASE
#define IN(k) ((k) == ONLY_PHASE && lo <= (k) && (k) < hi)
#else
#define IN(k) (lo <= (k) && (k) < hi)
#endif
#define SEAM(k) do { if (IN(k) && IN((k) + 1)) xcd_barrier(bar); } while (0)
    unsigned char* ws = F.ws; float* out = args.out;
    LAS unsigned char* ring = F.lds;

    if (IN(0)) { p0_prologue(F, args); } SEAM(0);
    if (IN(1)) { pg8::Gemm g{(const bf16_t*)(ws + WS_H0), (const bf16_t*)(ws + WS_WIN0), 2048, 2048, 2048}; pg8::Sched S; S.init(MT / 256, EVEN_INP / 256, F.G, F.bid, 0);
        pg8::EpiStore E{(bf16_t*)(ws + WS_PROJ0), EVEN_INP, 0, 0}; pg8::gemm_phase(ring, g, S, E); } SEAM(1);
    if (IN(2)) { p2_rows(F, args); } SEAM(2);
    if (IN(3)) { pg8::Gemm g{(const bf16_t*)(ws + WS_CQN), (const bf16_t*)(ws + WS_WQQ), 512, 512, 512}; pg8::Sched S; S.init(MT / 256, QQ_N / 256, F.G, F.bid, 0);
        pg8::EpiStore E{(bf16_t*)(ws + WS_QQ), QQ_N, 0, 0}; pg8::gemm_phase(ring, g, S, E); } SEAM(3);
    #ifndef NO_P4
    if (IN(4)) { p4_indexer(F); } SEAM(4);
#endif
    #ifndef NO_P5
    if (IN(5)) { p5_dsa(F, args); } SEAM(5);
#endif
    if (IN(6)) { pg8::Gemm g{(const bf16_t*)(ws + WS_CAT0), (const bf16_t*)(ws + WS_WOUT0), CAT0_K, CAT0_K, CAT0_K}; pg8::Sched S; S.init(MT / 256, DM / 256, F.G, F.bid, 0);
        pg8::EpiRes E{args.in[I_X], out, DM}; pg8::gemm_phase(ring, g, S, E); } SEAM(6);
    if (IN(7)) { rms_phase(F, out, args.in[I_ENFFN], (bf16_t*)(ws + WS_H1)); } SEAM(7);
    if (IN(8)) { pg8::Gemm g{(const bf16_t*)(ws + WS_H1), (const bf16_t*)(ws + WS_WGU0), 2048, 2048, 2048}; pg8::Sched S; S.init(MT / 256, 2 * DFF / 256, F.G, F.bid, 0);
        pg8::EpiSwiglu E{(bf16_t*)(ws + WS_ACT0), DFF, 0}; pg8::gemm_phase(ring, g, S, E); } SEAM(8);
    if (IN(9)) { pg8::Gemm g{(const bf16_t*)(ws + WS_ACT0), (const bf16_t*)(ws + WS_WDN0), DFF, DFF, DFF}; pg8::Sched S; S.init(MT / 256, DM / 256, F.G, F.bid, 0);
        pg8::EpiRes E{out, out, DM}; pg8::gemm_phase(ring, g, S, E); } SEAM(9);
    if (IN(10)) { rms_phase(F, out, args.in[I_ONMIX], (bf16_t*)(ws + WS_H2)); } SEAM(10);
    if (IN(11)) { pg8::Gemm g{(const bf16_t*)(ws + WS_H2), (const bf16_t*)(ws + WS_WIN1), 2048, 2048, 2048}; pg8::Sched S; S.init(MT / 256, ODD_IN / 256, F.G, F.bid, 0);
        pg8::EpiStore E{(bf16_t*)(ws + WS_PROJ1), ODD_IN, 0, 8}; pg8::gemm_phase(ring, g, S, E); } SEAM(11);
        if (IN(12)) {
#ifndef NO_P12A
        p12_gmlp(F, args);
#endif
#ifndef NO_P12B
        p12_stick(F);
#endif
    } SEAM(12);
    if (IN(13)) { pg8::Gemm g{(const bf16_t*)(ws + WS_CAT1), (const bf16_t*)(ws + WS_WOUT1), 2048, 2048, 2048}; pg8::Sched S; S.init(MT / 256, DM / 256, F.G, F.bid, 0);
        pg8::EpiRes E{out, out, DM}; pg8::gemm_phase(ring, g, S, E); } SEAM(13);
    if (IN(14)) { p14_router(F, args, out); } SEAM(14);
    if (IN(15)) { p15_gather(F); } SEAM(15);
#define MOE_CHUNK(c, pgu, pdn) \
    if (IN(pgu)) { int ts[9], cnt[8]; moe_tiles(F, ts, cnt); int nM = ts[8] - (c) * MOE_CHUNK_TILES; nM = nM > MOE_CHUNK_TILES ? MOE_CHUNK_TILES : (nM < 0 ? 0 : nM); \
        pg8::Gemm g{(const bf16_t*)(ws + WS_HS), (const bf16_t*)(ws + WS_WGU1), 2048, 2048, 2048}; pg8::Sched S; S.init(nM, 2 * DFFE / 256, F.G, F.bid, (c) * MOE_CHUNK_TILES); \
        for (int j = 0; j < 7; ++j) S.ts[j] = ts[j + 1]; \
        pg8::EpiSwiglu E{(bf16_t*)(ws + WS_ACT1), DFFE, (c) * MOE_CHUNK_TILES * 256}; pg8::gemm_phase(ring, g, S, E); } SEAM(pgu); \
    if (IN(pdn)) { int ts[9], cnt[8]; moe_tiles(F, ts, cnt); int nM = ts[8] - (c) * MOE_CHUNK_TILES; nM = nM > MOE_CHUNK_TILES ? MOE_CHUNK_TILES : (nM < 0 ? 0 : nM); \
        pg8::Gemm g{(const bf16_t*)(ws + WS_ACT1) - (size_t)(c) * MOE_CHUNK_TILES * 256 * DFFE, (const bf16_t*)(ws + WS_WDN1), DFFE, DFFE, DFFE}; pg8::Sched S; S.init(nM, DM / 256, F.G, F.bid, (c) * MOE_CHUNK_TILES); \
        for (int j = 0; j < 7; ++j) S.ts[j] = ts[j + 1]; \
        pg8::EpiStore E{(bf16_t*)(ws + WS_Y), DM, 0, 0}; pg8::gemm_phase(ring, g, S, E); } SEAM(pdn);
    MOE_CHUNK(0, 16, 17)
    MOE_CHUNK(1, 18, 19)
    MOE_CHUNK(2, 20, 21)
    if (IN(22)) { p22_final(F, args, out); }
#undef IN
#undef SEAM
}

extern "C" void kernel_launch(void* const* d_in, const int* in_sizes, int n_in, void* d_out, int out_size, void* d_ws, size_t ws_size, hipStream_t stream) {
    static int grid = 0;
    if (grid == 0) {
        if (n_in != 28 || out_size != MT * DM || ws_size < WS_END) { fprintf(stderr, "kernel_launch: unexpected shapes (n_in %d out %d ws %zu need %zu)\n", n_in, out_size, ws_size, (size_t)WS_END); grid = -1; return; }
        int dev = 0, cus = 0, per_cu = 0;
        if (hipGetDevice(&dev) != hipSuccess || hipDeviceGetAttribute(&cus, hipDeviceAttributeMultiprocessorCount, dev) != hipSuccess) { grid = -1; return; }
        if (hipFuncSetAttribute((const void*)fwd, hipFuncAttributeMaxDynamicSharedMemorySize, LDS_BYTES) != hipSuccess) { fprintf(stderr, "kernel_launch: hipFuncSetAttribute failed\n"); grid = -1; return; }
        if (hipOccupancyMaxActiveBlocksPerMultiprocessor(&per_cu, (const void*)fwd, 512, LDS_BYTES) != hipSuccess || per_cu < 1) { fprintf(stderr, "kernel_launch: occupancy query says %d\n", per_cu); }
        (void)hipGetLastError();
        grid = cus;
    }
    if (grid < 0) return;
    (void)hipMemsetAsync((char*)d_ws + WS_CTL, 0, CTL_ZERO_BYTES, stream);
    Args a{};
    for (int i = 0; i < 28; ++i) a.in[i] = (const float*)d_in[i];
    a.out = (float*)d_out; a.ws = (unsigned char*)d_ws;
#if MK_ONE_LAUNCH
    a.ph_lo = 0; a.ph_hi = N_PHASES;
    hipLaunchKernelGGL(fwd, dim3(grid), dim3(512), LDS_BYTES, stream, a);
#else
    for (int p = 0; p < N_PHASES; ++p) { a.ph_lo = p; a.ph_hi = p + 1; hipLaunchKernelGGL(fwd, dim3(grid), dim3(512), LDS_BYTES, stream, a); }
#endif
}
```

```cpp
#include <hip/hip_runtime.h>
#include <cstdio>
#include <cstdint>

#ifndef MK_ONE_LAUNCH
#define MK_ONE_LAUNCH 1
#endif

#define LAS __attribute__((address_space(3)))
#define GAS __attribute__((address_space(1)))
typedef unsigned short bf16_t;
typedef short bf16x8 __attribute__((ext_vector_type(8)));
typedef short s16x4 __attribute__((ext_vector_type(4)));
typedef float f32x2 __attribute__((ext_vector_type(2)));
typedef float f32x4 __attribute__((ext_vector_type(4)));
typedef float f32x16 __attribute__((ext_vector_type(16)));
typedef unsigned u32x2 __attribute__((ext_vector_type(2)));
typedef unsigned u32x4 __attribute__((ext_vector_type(4)));
typedef __bf16 bf16x2_t __attribute__((ext_vector_type(2)));
typedef GAS unsigned gu32;

#define DI __device__ __forceinline__

constexpr int DM = 2048, NB = 16, SEQ = 2048, MT = NB * SEQ;
constexpr int EVEN_IN = 3920, EVEN_INP = 4096, ODD_IN = 5120;
constexpr int DFF = 5632, NEXP = 8, DFFE = 7168;
constexpr float EPS = 1e-6f;
constexpr int QQ_N = 3072;
constexpr int CAT0_K = 3072;
constexpr int MOE_ROWS = 65536 + 2048;
constexpr int MOE_CHUNK_TILES = 88;

DI unsigned pk2(float a, float b) { bf16x2_t v = __builtin_convertvector((f32x2){a, b}, bf16x2_t); return __builtin_bit_cast(unsigned, v); }
DI float bf2f(bf16_t v) { return __builtin_bit_cast(float, (unsigned)v << 16); }
DI float bflo(unsigned w) { return __builtin_bit_cast(float, w << 16); }
DI float bfhi(unsigned w) { return __builtin_bit_cast(float, w & 0xffff0000u); }
DI float wave_sum(float v) {
#pragma unroll
    for (int o = 1; o < 64; o <<= 1) v += __shfl_xor(v, o);
    return v;
}
DI float fast_exp2(float x) { return __builtin_amdgcn_exp2f(x); }
DI float fast_log2(float x) { return __builtin_amdgcn_logf(x); }
DI float fast_rcp(float x) { return __builtin_amdgcn_rcpf(x); }

namespace pg8 {
constexpr int BM = 256, BK = 64, HALF = 128, HTB = HALF * BK * 2, STAGE_BYTES = 8 * HTB, NXCD = 8, WGM = 8;
__host__ __device__ __forceinline__ int lds_byte(int r, int c) { const int st = (r >> 4) * 2 + (c >> 5), rr = r & 15, cc = c & 31, ob = rr * 64 + cc * 2; return st * 1024 + (ob ^ (((ob >> 9) & 1) << 5)); }
__host__ __device__ __forceinline__ void stage_rc(int b, int& R, int& C) { const int st = b / 1024, sb = b % 1024, swz = sb ^ (((sb >> 9) & 1) << 5); R = (st >> 1) * 16 + swz / 64; C = (st & 1) * 32 + (swz % 64) / 2; }
__host__ __device__ __forceinline__ int perm32(int rho) { const int n = rho >> 4, i = rho & 15; return 8 * (i >> 2) + 4 * n + (i & 3); }

struct Unit { int pm, pn, bt; };
struct Gemm { const bf16_t* A; const bf16_t* Bt; int lda, ldb, K; };

struct Sched {
    int nM, nN, nwg, G, c, pm0, grouped; int ts[7];
    __device__ void init(int nM_, int nN_, int G_, int c_, int pm0_) { nM = nM_; nN = nN_; nwg = nM * nN; G = G_; c = c_; pm0 = pm0_; grouped = 0; for (int j = 0; j < 7; ++j) ts[j] = 0x7fffffff; }
    __device__ __forceinline__ bool next(int i, Unit& u) const {
        const long L = (long)i * G + c; if (L >= nwg) return false;
        int wgid = (int)L; { const int q = nwg / NXCD, r = nwg % NXCD, xcd = wgid % NXCD, off = wgid / NXCD; wgid = (xcd < r ? xcd * (q + 1) : r * (q + 1) + (xcd - r) * q) + off; }
        const int nig = WGM * nN, gid = wgid / nig, fm = gid * WGM, gsz = (nM - fm) < WGM ? (nM - fm) : WGM;
        u.pm = pm0 + fm + ((wgid % nig) % gsz); u.pn = (wgid % nig) / gsz;
        int e = 0;
#pragma unroll
        for (int j = 0; j < 7; ++j) e += (u.pm >= ts[j]) ? 1 : 0;
        u.bt = e * nN + u.pn; return true;
    }
};

DI f32x4 gelu_tanh4(f32x4 v) {
    f32x4 o;
#pragma unroll
    for (int j = 0; j < 4; ++j) { const float x = v[j]; const float t = x * (1.0f + 0.044715f * x * x) * (-2.0f * 0.7978845608f * 1.44269504f); o[j] = x * fast_rcp(1.0f + fast_exp2(t)); }
    return o;
}
struct EpiStore {
    static constexpr bool PERM = true;
    bf16_t* O; int ldc, row_sub, gelu_tiles;
    DI void operator()(const f32x4 (&acc)[2][2][4][2], const Unit& u, int wr, int wc, int fr, int fq) const {
        const int row0 = u.pm * BM - row_sub + wr * 64 + fr, col0 = u.pn * BM + wc * 32 + 8 * fq; const bool g = u.pn < gelu_tiles;
#pragma unroll
        for (int ai = 0; ai < 2; ++ai)
#pragma unroll
            for (int m = 0; m < 4; ++m) { bf16_t* rowp = O + (size_t)(row0 + ai * HALF + m * 16) * ldc + col0;
#pragma unroll
                for (int bj = 0; bj < 2; ++bj) { f32x4 v0 = acc[ai][bj][m][0], v1 = acc[ai][bj][m][1];
                    if (g) { v0 = gelu_tanh4(v0); v1 = gelu_tanh4(v1); }
                    u32x4 w; w.x = pk2(v0[0], v0[1]); w.y = pk2(v0[2], v0[3]); w.z = pk2(v1[0], v1[1]); w.w = pk2(v1[2], v1[3]);
                    *(u32x4*)(rowp + bj * HALF) = w; } }
    }
};
struct EpiRes {
    static constexpr bool PERM = false;
    const float* base; float* out; int ldc;
    DI void operator()(const f32x4 (&acc)[2][2][4][2], const Unit& u, int wr, int wc, int fr, int fq) const {
        const int row0 = u.pm * BM + wr * 64 + fr, col0 = u.pn * BM + wc * 32 + 4 * fq;
#pragma unroll
        for (int ai = 0; ai < 2; ++ai)
#pragma unroll
            for (int m = 0; m < 4; ++m) { const size_t off = (size_t)(row0 + ai * HALF + m * 16) * ldc + col0;
#pragma unroll
                for (int bj = 0; bj < 2; ++bj)
#pragma unroll
                    for (int n = 0; n < 2; ++n) { const f32x4 b = *(const f32x4*)(base + off + bj * HALF + n * 16); *(f32x4*)(out + off + bj * HALF + n * 16) = b + acc[ai][bj][m][n]; } }
    }
};
struct EpiSwiglu {
    static constexpr bool PERM = true;
    bf16_t* O; int ldc, row_sub;
    DI void operator()(const f32x4 (&acc)[2][2][4][2], const Unit& u, int wr, int wc, int fr, int fq) const {
        const int row0 = u.pm * BM - row_sub + wr * 64 + fr, col0 = u.pn * HALF + wc * 32 + 8 * fq;
#pragma unroll
        for (int ai = 0; ai < 2; ++ai)
#pragma unroll
            for (int m = 0; m < 4; ++m) { float o[8];
#pragma unroll
                for (int n = 0; n < 2; ++n)
#pragma unroll
                    for (int j = 0; j < 4; ++j) { const float g = acc[ai][0][m][n][j], up = acc[ai][1][m][n][j]; o[4 * n + j] = g * fast_rcp(1.0f + fast_exp2(-1.44269504f * g)) * up; }
                u32x4 w; w.x = pk2(o[0], o[1]); w.y = pk2(o[2], o[3]); w.z = pk2(o[4], o[5]); w.w = pk2(o[6], o[7]);
                *(u32x4*)(O + (size_t)(row0 + ai * HALF + m * 16) * ldc + col0) = w; }
    }
};

template <class Epi>
DI void gemm_phase(LAS unsigned char* lds, const Gemm g, const Sched& S, const Epi& E) {
    const int tid = threadIdx.x, wid = __builtin_amdgcn_readfirstlane(tid >> 6), lane = tid & 63, wr = wid >> 2, wc = wid & 3, fr = lane & 15, fq = lane >> 4;
    const int K = g.K, nt = K / BK;
    unsigned voffA[2], voffB[2];
#pragma unroll
    for (int i = 0; i < 2; ++i) { int R, C; stage_rc(tid * 16 + i * 8192, R, C); const int Rb = Epi::PERM ? ((R & ~31) + perm32(R & 31)) : R;
        voffA[i] = (unsigned)(R * g.lda + C) * 2u; voffB[i] = (unsigned)(Rb * g.ldb + C) * 2u; }
    const size_t kstep = (size_t)(BK * 2);
    const size_t hstepA = (size_t)HALF * g.lda * 2, hstepB = (size_t)HALF * g.ldb * 2;
    const size_t tstepA = 2 * hstepA, tstepB = 2 * hstepB;
    const unsigned ldsw = (unsigned)wid * 1024u;
    const int aoff = lds_byte(wr * 64 + fr, fq * 8), boff = lds_byte(wc * 32 + fr, fq * 8);
#define PG8_SA(b, h) (((b) * 2 + (h)) * HTB)
#define PG8_SB(b, h) ((4 + (b) * 2 + (h)) * HTB)
#define PG8_STAGE(bufoff, gbase, voff) do { _Pragma("unroll") for (int _i = 0; _i < 2; ++_i) \
        __builtin_amdgcn_global_load_lds((const unsigned*)((const char*)(gbase) + (voff)[_i]), (LAS unsigned*)(lds + (bufoff) + ldsw + _i * 8192), 16, 0, 0); } while (0)
#define PG8_LDA(dst, b, h) do { _Pragma("unroll") for (int m = 0; m < 4; ++m) _Pragma("unroll") for (int k = 0; k < 2; ++k) dst[m][k] = *(const LAS bf16x8*)(lds + PG8_SA(b, h) + aoff + m * 2048 + k * 1024); } while (0)
#define PG8_LDB(dst, b, h) do { _Pragma("unroll") for (int n = 0; n < 2; ++n) _Pragma("unroll") for (int k = 0; k < 2; ++k) dst[n][k] = *(const LAS bf16x8*)(lds + PG8_SB(b, h) + boff + n * 2048 + k * 1024); } while (0)
#define PG8_MMA(ai, bj, At, Bt) do { __builtin_amdgcn_s_setprio(1); _Pragma("unroll") for (int m = 0; m < 4; ++m) _Pragma("unroll") for (int n = 0; n < 2; ++n) _Pragma("unroll") for (int k = 0; k < 2; ++k) \
        acc[ai][bj][m][n] = __builtin_amdgcn_mfma_f32_16x16x32_bf16(Bt[n][k], At[m][k], acc[ai][bj][m][n], 0, 0, 0); __builtin_amdgcn_s_setprio(0); } while (0)
#define PG8_WAIT_V(n) asm volatile("s_waitcnt vmcnt(" #n ")" ::: "memory")
#define PG8_WAIT_L(n) asm volatile("s_waitcnt lgkmcnt(" #n ")" ::: "memory")
#define PG8_BAR __builtin_amdgcn_s_barrier()
#define PG8_SCHED __builtin_amdgcn_sched_barrier(0)
    Unit cur, nxt; int ui = 0;
    if (!S.next(0, cur)) return;
    f32x4 acc[2][2][4][2];
#pragma unroll
    for (int a = 0; a < 2; ++a)
#pragma unroll
        for (int b = 0; b < 2; ++b)
#pragma unroll
            for (int m = 0; m < 4; ++m)
#pragma unroll
                for (int n = 0; n < 2; ++n) acc[a][b][m][n] = (f32x4){0.f, 0.f, 0.f, 0.f};
    bf16x8 At[4][2], B0[2][2], B1[2][2];
    const char* cA = (const char*)g.A + (size_t)cur.pm * tstepA; const char* cB = (const char*)g.Bt + (size_t)cur.bt * tstepB;
    PG8_STAGE(PG8_SB(0, 0), cB, voffB); PG8_STAGE(PG8_SB(0, 1), cB + hstepB, voffB); PG8_STAGE(PG8_SA(0, 0), cA, voffA); PG8_STAGE(PG8_SA(0, 1), cA + hstepA, voffA);
    if (wr == 1) PG8_BAR;
    PG8_WAIT_V(2); PG8_BAR;
    PG8_STAGE(PG8_SB(1, 0), cB + kstep, voffB); PG8_STAGE(PG8_SA(1, 0), cA + kstep, voffA); PG8_STAGE(PG8_SB(1, 1), cB + hstepB + kstep, voffB);
    PG8_WAIT_V(6); PG8_BAR;
    for (;;) {
        const bool has_next = S.next(ui + 1, nxt);
        const char* nA = has_next ? (const char*)g.A + (size_t)nxt.pm * tstepA : cA; const char* nB = has_next ? (const char*)g.Bt + (size_t)nxt.bt * tstepB : cB;
        for (int t = 0; t < nt; t += 2) {
            const bool last = (t == nt - 2);
            const char* a1 = cA + (size_t)(t + 1) * kstep;
            const char* a2 = last ? nA : cA + (size_t)(t + 2) * kstep; const char* b2 = last ? nB : cB + (size_t)(t + 2) * kstep;
            const char* a3 = a2 + kstep; const char* b3 = b2 + kstep;
            PG8_LDB(B0, 0, 0); PG8_LDB(B1, 0, 1); PG8_SCHED; PG8_LDA(At, 0, 0); PG8_STAGE(PG8_SA(1, 1), a1 + hstepA, voffA);
            PG8_WAIT_V(8); PG8_WAIT_L(0); PG8_BAR; PG8_MMA(0, 0, At, B0); PG8_MMA(0, 1, At, B1); PG8_BAR; PG8_SCHED;
            PG8_LDA(At, 0, 1); PG8_STAGE(PG8_SB(0, 0), b2, voffB); PG8_STAGE(PG8_SB(0, 1), b2 + hstepB, voffB); PG8_STAGE(PG8_SA(0, 0), a2, voffA);
            PG8_WAIT_V(8); PG8_WAIT_L(0); PG8_BAR; PG8_MMA(1, 0, At, B0); PG8_MMA(1, 1, At, B1); PG8_BAR; PG8_SCHED;
            PG8_LDB(B0, 1, 0); PG8_LDB(B1, 1, 1); PG8_SCHED; PG8_LDA(At, 1, 0); PG8_STAGE(PG8_SA(0, 1), a2 + hstepA, voffA);
            PG8_WAIT_V(8); PG8_WAIT_L(0); PG8_BAR; PG8_MMA(0, 0, At, B0); PG8_MMA(0, 1, At, B1); PG8_BAR; PG8_SCHED;
            PG8_LDA(At, 1, 1); PG8_STAGE(PG8_SB(1, 0), b3, voffB); PG8_STAGE(PG8_SB(1, 1), b3 + hstepB, voffB); PG8_STAGE(PG8_SA(1, 0), a3, voffA);
            PG8_WAIT_V(8); PG8_WAIT_L(0); PG8_BAR; PG8_MMA(1, 0, At, B0); PG8_MMA(1, 1, At, B1); PG8_BAR; PG8_SCHED;
        }
        if (wr == 0) PG8_BAR;
        E(acc, cur, wr, wc, fr, fq);
        if (!has_next) break;
#pragma unroll
        for (int a = 0; a < 2; ++a)
#pragma unroll
            for (int b = 0; b < 2; ++b)
#pragma unroll
                for (int m = 0; m < 4; ++m)
#pragma unroll
                    for (int n = 0; n < 2; ++n) acc[a][b][m][n] = (f32x4){0.f, 0.f, 0.f, 0.f};
        cur = nxt; cA = nA; cB = nB; ++ui;
        if (wr == 1) PG8_BAR;
    }
    PG8_WAIT_V(0);
    PG8_BAR;
#undef PG8_SA
#undef PG8_SB
#undef PG8_STAGE
#undef PG8_LDA
#undef PG8_LDB
#undef PG8_MMA
#undef PG8_WAIT_V
#undef PG8_WAIT_L
#undef PG8_BAR
#undef PG8_SCHED
}
}

#define XB_TMO      128
#define XB_XCNT(j)  (256  + 64 * (j))
#define XB_XSUB(j)  (1280 + 64 * (j))
#define XB_XGEN(j)  (2304 + 64 * (j))
#define XB_TOP      3328
#define XB_TOPGEN   3392
#define XCD_BAR_WORDS 3456
#define XB_SPIN_CAP (1u << 22)

DI unsigned xb_ld(unsigned* p)              { return __hip_atomic_load(p, __ATOMIC_RELAXED, __HIP_MEMORY_SCOPE_AGENT); }
DI unsigned xb_add(unsigned* p, unsigned v) { return __hip_atomic_fetch_add(p, v, __ATOMIC_RELAXED, __HIP_MEMORY_SCOPE_AGENT); }
DI unsigned xb_xcc_id() { return (unsigned)__builtin_amdgcn_s_getreg((3 << 11) | 20) & 0xFu; }
#define XB_SPIN(cond, bar) do { unsigned _sp = 0; while (cond) { __builtin_amdgcn_s_sleep(1); \
    if ((++_sp & 255u) == 0u) { if (xb_ld(&(bar)[XB_TMO])) break; if (_sp > XB_SPIN_CAP) { atomicAdd(&(bar)[XB_TMO], 1u); break; } } } } while (0)

struct XcdBarrier { unsigned* bar; unsigned x; volatile LAS unsigned* st; };

DI XcdBarrier xcd_barrier_post(unsigned* bar, volatile LAS unsigned* st) {
    XcdBarrier b; b.bar = bar; b.x = xb_xcc_id(); b.st = st;
    if (threadIdx.x == 0) (void)xb_add(&bar[XB_XCNT(b.x)], 1u);
    return b;
}
DI void xcd_barrier_complete(unsigned* bar, unsigned x, unsigned& nloc, unsigned& nx) {
    const unsigned G = gridDim.x * gridDim.y * gridDim.z;
    unsigned sum, cnt, mine, sp = 0u;
    for (;;) {
        sum = 0u; cnt = 0u; mine = 0u;
#pragma unroll
        for (unsigned j = 0; j < 16; ++j) { const unsigned c = xb_ld(&bar[XB_XCNT(j)]); sum += c; cnt += (c > 0u) ? 1u : 0u; mine = (j == x) ? c : mine; }
        if (sum == G) break;
        __builtin_amdgcn_s_sleep(1);
        if ((++sp & 255u) == 0u) { if (xb_ld(&bar[XB_TMO])) break; if (sp > XB_SPIN_CAP) { atomicAdd(&bar[XB_TMO], 1u); break; } }
    }
    nloc = mine > 0u ? mine : 1u; nx = cnt > 0u ? cnt : 1u;
}
DI void xcd_barrier(const XcdBarrier& b) {
    asm volatile("s_waitcnt vmcnt(0)" ::: "memory");
    __syncthreads();
    if (threadIdx.x == 0) {
        unsigned* bar = b.bar;
        __builtin_amdgcn_s_waitcnt(0);
        unsigned nloc = b.st[0], nx = b.st[1];
        if (nloc == 0u) { xcd_barrier_complete(bar, b.x, nloc, nx); b.st[0] = nloc; b.st[1] = nx; }
        const unsigned old = xb_add(&bar[XB_XSUB(b.x)], 1u);
        const unsigned gen = old / nloc;
        if (old + 1u == (gen + 1u) * nloc) {
            __builtin_amdgcn_fence(__ATOMIC_RELEASE, "agent");
            asm volatile("s_waitcnt vmcnt(0)" ::: "memory");
            const unsigned og = xb_add(&bar[XB_TOP], 1u);
            const unsigned tg = og / nx;
            if (og + 1u == (tg + 1u) * nx) xb_add(&bar[XB_TOPGEN], 1u);
            else XB_SPIN(xb_ld(&bar[XB_TOPGEN]) == tg, bar);
            __builtin_amdgcn_fence(__ATOMIC_ACQUIRE, "agent");
            xb_add(&bar[XB_XGEN(b.x)], 1u);
            asm volatile("s_waitcnt vmcnt(0)" ::: "memory");
        } else {
            XB_SPIN(xb_ld(&bar[XB_XGEN(b.x)]) == gen, bar);
            __builtin_amdgcn_fence(__ATOMIC_ACQUIRE, "agent");
            asm volatile("s_waitcnt vmcnt(0)" ::: "memory");
        }
    }
    __syncthreads();
}

constexpr size_t MiB = 1u << 20;
constexpr size_t WS_CTL = 0, CTL_ZERO_BYTES = 1 * MiB;
constexpr size_t WS_TAB = 1 * MiB;
constexpr size_t WS_WIN1 = 5 * MiB;
constexpr size_t WS_WOUT1 = 25 * MiB;
constexpr size_t WS_WS = 33 * MiB;
constexpr size_t WS_WGU1 = 34 * MiB;
constexpr size_t WS_WDN1 = 482 * MiB;
constexpr size_t WS_L0 = 706 * MiB;
constexpr size_t WS_WIN0 = WS_L0;
constexpr size_t WS_WQQ = WS_L0 + 16 * MiB;
constexpr size_t WS_WOUT0 = WS_L0 + 19 * MiB;
constexpr size_t WS_WGU0 = WS_L0 + 31 * MiB;
constexpr size_t WS_WDN0 = WS_L0 + 75 * MiB;
constexpr size_t WS_CQN = WS_L0 + 97 * MiB;
constexpr size_t WS_CKV = WS_L0 + 129 * MiB;
constexpr size_t WS_KX = WS_L0 + 145 * MiB;
constexpr size_t WS_WIDX = WS_L0 + 149 * MiB;
constexpr size_t WS_ACT = WS_L0 + 152 * MiB;
constexpr size_t WS_PROJ0 = WS_ACT;
constexpr size_t WS_CAT0 = WS_ACT + 256 * MiB;
constexpr size_t WS_QQ = WS_ACT + 448 * MiB;
constexpr size_t WS_H0 = WS_QQ;
constexpr size_t WS_SC = WS_ACT + 640 * MiB;
constexpr size_t WS_H1 = WS_SC;
constexpr size_t WS_ACT0 = WS_ACT;
constexpr size_t WS_H2 = WS_ACT;
constexpr size_t WS_PROJ1 = WS_ACT + 128 * MiB;
constexpr size_t WS_CAT1 = WS_ACT + 448 * MiB;
constexpr size_t WS_HS = WS_L0;
constexpr size_t WS_Y = WS_L0 + 264 * MiB;
constexpr size_t WS_ACT1 = WS_L0 + 528 * MiB;
constexpr size_t WS_H3 = WS_L0 + 840 * MiB;
constexpr size_t WS_END = WS_L0 + 968 * MiB;
static_assert(WS_SC + 128 * MiB <= WS_END && WS_CAT1 + 128 * MiB <= WS_H3 && WS_ACT1 + (size_t)MOE_CHUNK_TILES * 256 * DFFE * 2 <= WS_H3, "ws map");
constexpr size_t TAB_ER = 0;
constexpr size_t TAB_GATE = 512 * 1024;
constexpr size_t TAB_SLOT = 1024 * 1024;
constexpr int CW_BAR = 1024;
constexpr int CW_CNT = 8192;
constexpr int RING_BYTES = 131072, MISC_OFF = RING_BYTES, LDS_BYTES = 147456;

struct Args { const float* in[28]; float* out; unsigned char* ws; int ph_lo, ph_hi; };
enum { I_X = 0, I_RELB, I_FNORM, I_ENMIX, I_EWIN, I_ECONV, I_ENCQ, I_ENCKV, I_EWUQ, I_EWUK, I_EWUV, I_EWQIDX, I_EWOUT, I_ENFFN, I_EGATE, I_EUP, I_EDOWN,
       I_ONMIX, I_OWIN, I_ONV, I_OWS, I_OBS, I_OWOUT, I_ONFFN, I_OROUTER, I_OGATE, I_OUP, I_ODOWN };

struct Frame {
    LAS unsigned char* lds;
    int tid, lane, wave, gw, NGW, G, bid;
    unsigned char* ws;
};

DI void tr_item(const float* W, int ldsrc, int N, bf16_t* WT, int ldd, int koff, int row_off, int mode, int nblk, LAS float* scr, int item, int lane) {
    const int kb = item / nblk, nb = item % nblk, k0 = 64 * kb, n0 = 32 * nb;
    const int nn = n0 + (lane & 31); const bool ok = nn < N;
#pragma unroll 8
    for (int i = 0; i < 32; ++i) { const int kk = 2 * i + (lane >> 5); scr[kk * 33 + (lane & 31)] = ok ? W[(size_t)(k0 + kk) * ldsrc + nn] : 0.f; }
    asm volatile("s_waitcnt lgkmcnt(0)" ::: "memory");
    const int c = lane & 7;
    const int drow0 = (mode == 1) ? ((n0 >> 7) * 256 + (n0 & 127) + row_off) : (row_off + n0);
#pragma unroll
    for (int j = 0; j < 4; ++j) { const int n = (lane >> 3) + 8 * j; const LAS float* s = scr + (8 * c) * 33 + n;
        u32x4 o; o.x = pk2(s[0 * 33], s[1 * 33]); o.y = pk2(s[2 * 33], s[3 * 33]); o.z = pk2(s[4 * 33], s[5 * 33]); o.w = pk2(s[6 * 33], s[7 * 33]);
        *(u32x4*)(WT + (size_t)(drow0 + n) * ldd + koff + k0 + 8 * c) = o; }
    asm volatile("s_waitcnt lgkmcnt(0)" ::: "memory");
}
DI void tr_job(const Frame& F, const float* W, int K, int ldsrc, int N, int Npad, bf16_t* WT, int ldd, int koff, int row_off, int mode) {
    LAS float* scr = (LAS float*)(F.lds + F.wave * 16384);
    const int nblk = Npad / 32, nitems = (K / 64) * nblk;
    for (int it = F.gw; it < nitems; it += F.NGW) tr_item(W, ldsrc, N, WT, ldd, koff, row_off, mode, nblk, scr, it, F.lane);
}

DI void rms_row_to_bf16(const float* xrow, const float* g, bf16_t* orow, int lane) {
    const f32x4* xr = (const f32x4*)xrow + lane; const f32x4* gr = (const f32x4*)g + lane;
    f32x4 v[8]; float s = 0.f;
#pragma unroll
    for (int j = 0; j < 8; ++j) { v[j] = xr[64 * j]; s += (v[j].x * v[j].x + v[j].y * v[j].y) + (v[j].z * v[j].z + v[j].w * v[j].w); }
    const float rstd = 1.0f / sqrtf(wave_sum(s) * (1.f / DM) + EPS);
    u32x2* o8 = (u32x2*)orow + lane;
#pragma unroll
    for (int j = 0; j < 8; ++j) { const f32x4 gg = gr[64 * j]; u32x2 w; w.x = pk2(v[j].x * rstd * gg.x, v[j].y * rstd * gg.y); w.y = pk2(v[j].z * rstd * gg.z, v[j].w * rstd * gg.w); o8[64 * j] = w; }
}
DI void rms_phase(const Frame& F, const float* x, const float* g, bf16_t* out) {
    for (int m = F.gw; m < MT; m += F.NGW) rms_row_to_bf16(x + (size_t)m * DM, g, out + (size_t)m * DM, F.lane);
}

DI void p0_prologue(const Frame& F, const Args& a) {
    unsigned char* ws = F.ws;
    tr_job(F, a.in[I_EWIN], 2048, EVEN_IN, EVEN_IN, EVEN_INP, (bf16_t*)(ws + WS_WIN0), 2048, 0, 0, 0);
    tr_job(F, a.in[I_EWQIDX], 512, 1024, 1024, 1024, (bf16_t*)(ws + WS_WQQ), 512, 0, 2048, 0);
    tr_job(F, a.in[I_EWOUT], 1024, 2048, 2048, 2048, (bf16_t*)(ws + WS_WOUT0), CAT0_K, 0, 0, 0);
    tr_job(F, a.in[I_EGATE], 2048, DFF, DFF, DFF, (bf16_t*)(ws + WS_WGU0), 2048, 0, 0, 1);
    tr_job(F, a.in[I_EUP], 2048, DFF, DFF, DFF, (bf16_t*)(ws + WS_WGU0), 2048, 0, 128, 1);
    tr_job(F, a.in[I_EDOWN], DFF, 2048, 2048, 2048, (bf16_t*)(ws + WS_WDN0), DFF, 0, 0, 0);
    tr_job(F, a.in[I_OWIN], 2048, ODD_IN, ODD_IN, ODD_IN, (bf16_t*)(ws + WS_WIN1), 2048, 0, 0, 0);
    tr_job(F, a.in[I_OWOUT], 2048, 2048, 2048, 2048, (bf16_t*)(ws + WS_WOUT1), 2048, 0, 0, 0);
    for (int e = 0; e < NEXP; ++e) {
        tr_job(F, a.in[I_OGATE] + (size_t)e * 2048 * DFFE, 2048, DFFE, DFFE, DFFE, (bf16_t*)(ws + WS_WGU1) + (size_t)e * 2 * DFFE * 2048, 2048, 0, 0, 1);
        tr_job(F, a.in[I_OUP] + (size_t)e * 2048 * DFFE, 2048, DFFE, DFFE, DFFE, (bf16_t*)(ws + WS_WGU1) + (size_t)e * 2 * DFFE * 2048, 2048, 0, 128, 1);
        tr_job(F, a.in[I_ODOWN] + (size_t)e * DFFE * 2048, DFFE, 2048, 2048, 2048, (bf16_t*)(ws + WS_WDN1) + (size_t)e * 2048 * DFFE, DFFE, 0, 0, 0);
    }
    const int gt = F.bid * 512 + F.tid, NT = F.G * 512;
    { const float* uq = a.in[I_EWUQ]; const float* uk = a.in[I_EWUK]; bf16_t* o = (bf16_t*)(ws + WS_WQQ);
      for (int i = gt; i < 2048 * 512; i += NT) { const int n = i >> 9, r = i & 511, h = n >> 8, c = n & 255;
          const f32x4* pa = (const f32x4*)(uq + (size_t)r * 1024 + h * 128); const f32x4* pb = (const f32x4*)(uk + (size_t)c * 1024 + h * 128); float s = 0.f;
#pragma unroll 8
          for (int d = 0; d < 32; ++d) { const f32x4 x = pa[d], y = pb[d]; s += (x.x * y.x + x.y * y.y) + (x.z * y.z + x.w * y.w); }
          o[i] = (bf16_t)(pk2(s, 0.f) & 0xffffu); } }
    { const float* uv = a.in[I_EWUV]; const float* wo = a.in[I_EWOUT]; bf16_t* o = (bf16_t*)(ws + WS_WOUT0);
      for (int i = gt; i < 2048 * 2048; i += NT) { const int n = i >> 11, hc = i & 2047, h = hc >> 8, c = hc & 255;
          const f32x4* pa = (const f32x4*)(uv + (size_t)c * 1024 + h * 128); const float* pb = wo + (size_t)(1024 + h * 128) * 2048 + n; float s = 0.f;
#pragma unroll 4
          for (int d = 0; d < 32; ++d) { const f32x4 x = pa[d]; s += (x.x * pb[(size_t)(4 * d) * 2048] + x.y * pb[(size_t)(4 * d + 1) * 2048]) + (x.z * pb[(size_t)(4 * d + 2) * 2048] + x.w * pb[(size_t)(4 * d + 3) * 2048]); }
          o[(size_t)n * CAT0_K + 1024 + hc] = (bf16_t)(pk2(s, 0.f) & 0xffffu); } }
    { const float* w = a.in[I_OWS]; bf16_t* o = (bf16_t*)(ws + WS_WS);
      for (int i = gt; i < 8 * 128 * 128; i += NT) { const int t = (i >> 7) & 127, s = i & 127; o[i] = (bf16_t)(pk2(s <= t ? w[i] : 0.f, 0.f) & 0xffffu); } }
    rms_phase(F, a.in[I_X], a.in[I_ENMIX], (bf16_t*)(ws + WS_H0));
}

DI void p2_rows(const Frame& F, const Args& a) {
    const bf16_t* proj = (const bf16_t*)(F.ws + WS_PROJ0);
    bf16_t* cqn = (bf16_t*)(F.ws + WS_CQN); bf16_t* ckv = (bf16_t*)(F.ws + WS_CKV); bf16_t* kx = (bf16_t*)(F.ws + WS_KX); float* widx = (float*)(F.ws + WS_WIDX);
    bf16_t* cat = (bf16_t*)(F.ws + WS_CAT0);
    const float* gcq = a.in[I_ENCQ]; const float* gckv = a.in[I_ENCKV]; const float* cw = a.in[I_ECONV];
    const int lane = F.lane;
    float w0[2][8], w1[2][8], w2[2][8];
#pragma unroll
    for (int j = 0; j < 2; ++j)
#pragma unroll
        for (int e = 0; e < 8; ++e) { const int c = 512 * j + 8 * lane + e; w0[j][e] = cw[c]; w1[j][e] = cw[1024 + c]; w2[j][e] = cw[2048 + c]; }
    float gq[8], gk[8];
#pragma unroll
    for (int e = 0; e < 8; ++e) { gq[e] = gcq[8 * lane + e]; gk[e] = gckv[8 * (lane & 31) + e]; }
    for (int m = F.gw; m < MT; m += F.NGW) {
        const bf16_t* row = proj + (size_t)m * EVEN_INP;
        const int s = m & (SEQ - 1);
        { const u32x4 v = *(const u32x4*)(row + 3072 + 8 * lane); float f[8] = {bflo(v.x), bfhi(v.x), bflo(v.y), bfhi(v.y), bflo(v.z), bfhi(v.z), bflo(v.w), bfhi(v.w)}; float ss = 0.f;
#pragma unroll
          for (int e = 0; e < 8; ++e) ss += f[e] * f[e];
          const float rstd = 1.0f / sqrtf(wave_sum(ss) * (1.f / 512.f) + EPS);
          u32x4 o; o.x = pk2(f[0] * rstd * gq[0], f[1] * rstd * gq[1]); o.y = pk2(f[2] * rstd * gq[2], f[3] * rstd * gq[3]); o.z = pk2(f[4] * rstd * gq[4], f[5] * rstd * gq[5]); o.w = pk2(f[6] * rstd * gq[6], f[7] * rstd * gq[7]);
          *(u32x4*)(cqn + (size_t)m * 512 + 8 * lane) = o; }
        { const u32x4 v = *(const u32x4*)(row + 3584 + 8 * (lane & 31)); float f[8] = {bflo(v.x), bfhi(v.x), bflo(v.y), bfhi(v.y), bflo(v.z), bfhi(v.z), bflo(v.w), bfhi(v.w)}; float ss = 0.f;
#pragma unroll
          for (int e = 0; e < 8; ++e) ss += f[e] * f[e];
          const float rstd = 1.0f / sqrtf(wave_sum(ss) * (0.5f / 256.f) + EPS);
          u32x4 o; o.x = pk2(f[0] * rstd * gk[0], f[1] * rstd * gk[1]); o.y = pk2(f[2] * rstd * gk[2], f[3] * rstd * gk[3]); o.z = pk2(f[4] * rstd * gk[4], f[5] * rstd * gk[5]); o.w = pk2(f[6] * rstd * gk[6], f[7] * rstd * gk[7]);
          if (lane < 32) *(u32x4*)(ckv + (size_t)m * 256 + 8 * lane) = o; }
        if (lane < 8) *(u32x4*)(kx + (size_t)m * 64 + 8 * lane) = *(const u32x4*)(row + 3840 + 8 * lane);
        if (lane < 16) widx[(size_t)m * 16 + lane] = bf2f(row[3904 + lane]) * (0.125f * 0.25f);
#pragma unroll
        for (int j = 0; j < 2; ++j) { const int c0 = 512 * j + 8 * lane; float acc[8];
            { const u32x4 vc = *(const u32x4*)(row + 1024 + c0), vx = *(const u32x4*)(row + 2048 + c0);
              const float fc[8] = {bflo(vc.x), bfhi(vc.x), bflo(vc.y), bfhi(vc.y), bflo(vc.z), bfhi(vc.z), bflo(vc.w), bfhi(vc.w)}, fx[8] = {bflo(vx.x), bfhi(vx.x), bflo(vx.y), bfhi(vx.y), bflo(vx.z), bfhi(vx.z), bflo(vx.w), bfhi(vx.w)};
#pragma unroll
              for (int e = 0; e < 8; ++e) acc[e] = w2[j][e] * (fc[e] * fx[e]); }
            if (s >= 1) { const bf16_t* r1 = row - EVEN_INP; const u32x4 vc = *(const u32x4*)(r1 + 1024 + c0), vx = *(const u32x4*)(r1 + 2048 + c0);
              const float fc[8] = {bflo(vc.x), bfhi(vc.x), bflo(vc.y), bfhi(vc.y), bflo(vc.z), bfhi(vc.z), bflo(vc.w), bfhi(vc.w)}, fx[8] = {bflo(vx.x), bfhi(vx.x), bflo(vx.y), bfhi(vx.y), bflo(vx.z), bfhi(vx.z), bflo(vx.w), bfhi(vx.w)};
#pragma unroll
              for (int e = 0; e < 8; ++e) acc[e] += w1[j][e] * (fc[e] * fx[e]); }
            if (s >= 2) { const bf16_t* r2 = row - 2 * EVEN_INP; const u32x4 vc = *(const u32x4*)(r2 + 1024 + c0), vx = *(const u32x4*)(r2 + 2048 + c0);
              const float fc[8] = {bflo(vc.x), bfhi(vc.x), bflo(vc.y), bfhi(vc.y), bflo(vc.z), bfhi(vc.z), bflo(vc.w), bfhi(vc.w)}, fx[8] = {bflo(vx.x), bfhi(vx.x), bflo(vx.y), bfhi(vx.y), bflo(vx.z), bfhi(vx.z), bflo(vx.w), bfhi(vx.w)};
#pragma unroll
              for (int e = 0; e < 8; ++e) acc[e] += w0[j][e] * (fc[e] * fx[e]); }
            const u32x4 vb = *(const u32x4*)(row + c0); const float fb[8] = {bflo(vb.x), bfhi(vb.x), bflo(vb.y), bfhi(vb.y), bflo(vb.z), bfhi(vb.z), bflo(vb.w), bfhi(vb.w)};
            u32x4 o; o.x = pk2(fb[0] * acc[0], fb[1] * acc[1]); o.y = pk2(fb[2] * acc[2], fb[3] * acc[3]); o.z = pk2(fb[4] * acc[4], fb[5] * acc[5]); o.w = pk2(fb[6] * acc[6], fb[7] * acc[7]);
            *(u32x4*)(cat + (size_t)m * CAT0_K + c0) = o; }
    }
}

DI unsigned kx_lds_off(int key_local, int ch) { const int R = key_local >> 1, C = ((key_local & 1) << 3) | ch; return (unsigned)(R * 256 + ((C ^ (R & 15)) << 4)); }
DI void p4_indexer(const Frame& F) {
    const bf16_t* qq = (const bf16_t*)(F.ws + WS_QQ); const bf16_t* kx = (const bf16_t*)(F.ws + WS_KX); const float* widx = (const float*)(F.ws + WS_WIDX);
    _Float16* sc = (_Float16*)(F.ws + WS_SC);
    const int lane = F.lane, r = lane & 31, h = lane >> 5, w = F.wave, tid = F.tid;
    LAS unsigned char* kb = F.lds;
    const int nunits = NB * (SEQ / 16);
    for (int rd = 0; rd * F.G < nunits; ++rd) {
        const int j = (rd & 1) ? (F.G - 1 - F.bid) : F.bid; const int u = rd * F.G + j; if (u >= nunits) continue;
        const int qg = (SEQ / 16 - 1) - u / NB, b = u % NB;
        const int t0 = qg * 16, t1 = ((t0 >> 7) + 1) << 7;
        const int tq = t0 + 2 * w + (r >> 4), g = r & 15;
        bf16x8 aq[4];
#pragma unroll
        for (int s = 0; s < 4; ++s) aq[s] = *(const bf16x8*)(qq + (size_t)(b * SEQ + tq) * QQ_N + 2048 + g * 64 + 16 * s + 8 * h);
        float wts[16];
#pragma unroll
        for (int i = 0; i < 16; ++i) wts[i] = widx[(size_t)(b * SEQ + t0 + 2 * w + (i >> 3)) * 16 + ((i & 3) + 8 * ((i >> 2) & 1) + 4 * h)];
        const int tme = t0 + 2 * w + h;
        unsigned kv[64];
#pragma unroll
        for (int c = 0; c < 4; ++c) {
            if (512 * c < t1) {
                __syncthreads();
#pragma unroll
                for (int i = 0; i < 8; ++i) { const int p = tid + 512 * i, kl = p >> 3, ch = p & 7;
                    if (512 * c + kl < t1) *(LAS u32x4*)(kb + kx_lds_off(kl, ch)) = *(const u32x4*)(kx + (size_t)(b * SEQ + 512 * c + kl) * 64 + 8 * ch); }
                __syncthreads();
            }
#pragma unroll
            for (int jn = 0; jn < 16; ++jn) { const int n = 16 * c + jn;
                if (32 * n < t1) {
                    f32x16 acc;
#pragma unroll
                    for (int i = 0; i < 16; ++i) acc[i] = 0.f;
#pragma unroll
                    for (int s = 0; s < 4; ++s) { const bf16x8 bk = *(const LAS bf16x8*)(kb + kx_lds_off(32 * jn + r, 2 * s + h)); acc = __builtin_amdgcn_mfma_f32_32x32x16_bf16(aq[s], bk, acc, 0, 0, 0); }
                    float p0 = 0.f, p1 = 0.f;
#pragma unroll
                    for (int i = 0; i < 8; ++i) { p0 += wts[i] * fmaxf(acc[i], 0.f); p1 += wts[8 + i] * fmaxf(acc[8 + i], 0.f); }
                    const float mine = h ? p1 : p0, send = h ? p0 : p1;
                    float tot = mine + __shfl_xor(send, 32);
                    if (32 * n + r > tme) tot = -__builtin_inff();
                    const unsigned ub = __builtin_bit_cast(unsigned, tot);
                    kv[n] = (ub & 0x80000000u) ? ~ub : (ub | 0x80000000u);
                    __builtin_amdgcn_sched_barrier(0);
                } else kv[n] = 0u;
            }
        }
        unsigned T = 0u;
        if (t1 > 256) {
            for (int bit = 31; bit >= 0; --bit) { const unsigned cand = T | (1u << bit); int cnt = 0;
#pragma unroll
                for (int n = 0; n < 64; ++n) cnt += (kv[n] >= cand) ? 1 : 0;
                cnt += __shfl_xor(cnt, 1); cnt += __shfl_xor(cnt, 2); cnt += __shfl_xor(cnt, 4); cnt += __shfl_xor(cnt, 8); cnt += __shfl_xor(cnt, 16);
                T = (cnt >= 256) ? cand : T; }
        }
        _Float16* orow = sc + (size_t)(b * SEQ + tme) * SEQ;
#pragma unroll
        for (int n = 0; n < 64; ++n) if (32 * n < t1) { const unsigned k = kv[n]; const bool sel = (k >= T) && (k > 0x007fffffu);
            const unsigned ub = (k & 0x80000000u) ? (k ^ 0x80000000u) : ~k; const float v = sel ? __builtin_bit_cast(float, ub) : -__builtin_inff();
            orow[32 * n + r] = (_Float16)v; }
    }
    __syncthreads();
}

DI unsigned kv_off(int row, int ch) { return (unsigned)(512 * row + 16 * (ch ^ (((row & 3) << 2) | ((row >> 2) & 3)))); }
DI s16x4 tr_read4(const LAS unsigned char* p) { return __builtin_amdgcn_ds_read_tr16_b64_v4i16((LAS s16x4*)p); }
DI bf16x8 cat8(s16x4 a, s16x4 b) { bf16x8 v; v[0] = a[0]; v[1] = a[1]; v[2] = a[2]; v[3] = a[3]; v[4] = b[0]; v[5] = b[1]; v[6] = b[2]; v[7] = b[3]; return v; }
DI bf16x8 pack8(float a0, float a1, float a2, float a3, float a4, float a5, float a6, float a7) { u32x4 w; w.x = pk2(a0, a1); w.y = pk2(a2, a3); w.z = pk2(a4, a5); w.w = pk2(a6, a7); return __builtin_bit_cast(bf16x8, w); }
DI void p5_dsa(const Frame& F, const Args& a) {
    const bf16_t* qq = (const bf16_t*)(F.ws + WS_QQ); const bf16_t* ckv = (const bf16_t*)(F.ws + WS_CKV); const _Float16* sc = (const _Float16*)(F.ws + WS_SC);
    bf16_t* cat = (bf16_t*)(F.ws + WS_CAT0);
    const int lane = F.lane, r = lane & 31, h = lane >> 5, tid = F.tid, dh = F.wave & 1;
    const int q4 = (lane & 15) >> 2, p4 = lane & 3, blk = (lane >> 4) & 1;
    LAS unsigned char* kvb = F.lds;
    LAS unsigned char* scb = F.lds + 32768;
    LAS float* lut = (LAS float*)(F.lds + 40960);
    __syncthreads();
    for (int i = tid; i < 8 * 129; i += 512) { const int hd = i / 129, d = i % 129; int bk = d;
        if (d >= 16) { bk = 16 + (int)(logf((float)d / 16.0f) / 2.0794415416798357f * 16.0f); bk = bk > 31 ? 31 : bk; }
        lut[hd * 132 + d] = a.in[I_RELB][bk * 8 + hd] * 1.44269504f; }
    __syncthreads();
    const float SC2 = 0.08838834764831845f * 1.44269504f;
    const int nunits = NB * (SEQ / 32) * 2;
    for (int rd = 0; rd * F.G < nunits; ++rd) {
        const int j = (rd & 1) ? (F.G - 1 - F.bid) : F.bid; const int u = rd * F.G + j; if (u >= nunits) continue;
        const int hg = u & 1, u2 = u >> 1, head = 4 * hg + (F.wave >> 1);
        const int qt = (SEQ / 32 - 1) - u2 / NB, b = u2 % NB, q0 = qt * 32, nkt = qt + 1, tq = q0 + r;
        bf16x8 qf[16];
#pragma unroll
        for (int s = 0; s < 16; ++s) qf[s] = *(const bf16x8*)(qq + (size_t)(b * SEQ + tq) * QQ_N + head * 256 + 16 * s + 8 * h);
        f32x16 O[4];
#pragma unroll
        for (int c = 0; c < 4; ++c)
#pragma unroll
            for (int i = 0; i < 16; ++i) O[c][i] = 0.f;
        float m_run = -__builtin_inff(), l_run = 0.f;
        u32x4 st0, st1; u32x2 st2 = {0u, 0u};
        const int skey0 = tid >> 5, sch = tid & 31, sq = tid >> 3, spc = tid & 7;
#define DSA_LOAD(kt) do { const bf16_t* src = ckv + (size_t)(b * SEQ + 32 * (kt)) * 256; st0 = *(const u32x4*)(src + (size_t)skey0 * 256 + 8 * sch); st1 = *(const u32x4*)(src + (size_t)(skey0 + 16) * 256 + 8 * sch); \
        if (tid < 256) st2 = *(const u32x2*)(sc + (size_t)(b * SEQ + q0 + sq) * SEQ + 32 * (kt) + 4 * spc); } while (0)
#define DSA_WRITE(bufi) do { LAS unsigned char* kd_ = kvb + (bufi) * 16384; *(LAS u32x4*)(kd_ + kv_off(skey0, sch)) = st0; *(LAS u32x4*)(kd_ + kv_off(skey0 + 16, sch)) = st1; \
        if (tid < 256) *(LAS u32x2*)(scb + (bufi) * 2304 + sq * 72 + spc * 8) = st2; } while (0)
        __syncthreads();
        DSA_LOAD(0); DSA_WRITE(0);
        __syncthreads();
        for (int kt = 0; kt < nkt; ++kt) {
            const int cur = kt & 1;
            if (kt + 1 < nkt) DSA_LOAD(kt + 1);
            const LAS unsigned char* kd = kvb + cur * 16384; const LAS unsigned char* sd = scb + cur * 2304;
            f32x16 S;
#pragma unroll
            for (int i = 0; i < 16; ++i) S[i] = 0.f;
#pragma unroll
            for (int s = 0; s < 16; ++s) { const bf16x8 kf = *(const LAS bf16x8*)(kd + kv_off(r, 2 * s + h)); S = __builtin_amdgcn_mfma_f32_32x32x16_bf16(kf, qf[s], S, 0, 0, 0); if ((s & 3) == 3) __builtin_amdgcn_sched_barrier(0); }
            float mx = -__builtin_inff();
#pragma unroll
            for (int gq = 0; gq < 4; ++gq) { const u32x2 iw = *(const LAS u32x2*)(sd + r * 72 + (2 * gq + h) * 8);
                const _Float16 h0 = __builtin_bit_cast(_Float16, (unsigned short)(iw.x & 0xffffu)), h1 = __builtin_bit_cast(_Float16, (unsigned short)(iw.x >> 16)), h2 = __builtin_bit_cast(_Float16, (unsigned short)(iw.y & 0xffffu)), h3 = __builtin_bit_cast(_Float16, (unsigned short)(iw.y >> 16));
                const float idx[4] = {(float)h0, (float)h1, (float)h2, (float)h3};
#pragma unroll
                for (int e = 0; e < 4; ++e) { const int i = 4 * gq + e, key = 32 * kt + 8 * gq + 4 * h + e; int dist = tq - key; dist = dist < 0 ? 0 : (dist > 128 ? 128 : dist);
                    const float x = S[i] * SC2 + lut[head * 132 + dist] + idx[e] * 1.44269504f; S[i] = x; mx = fmaxf(mx, x); } }
            mx = fmaxf(mx, __shfl_xor(mx, 32));
            const float m_new = fmaxf(m_run, mx), msafe = (m_new == -__builtin_inff()) ? 0.f : m_new, alpha = fast_exp2(m_run - msafe);
            float rs = 0.f;
#pragma unroll
            for (int i = 0; i < 16; ++i) { S[i] = fast_exp2(S[i] - msafe); rs += S[i]; }
            rs += __shfl_xor(rs, 32);
            l_run = l_run * alpha + rs; m_run = m_new;
#pragma unroll
            for (int c = 0; c < 4; ++c)
#pragma unroll
                for (int i = 0; i < 16; ++i) O[c][i] *= alpha;
            const bf16x8 pf0 = pack8(S[0], S[1], S[2], S[3], S[4], S[5], S[6], S[7]), pf1 = pack8(S[8], S[9], S[10], S[11], S[12], S[13], S[14], S[15]);
#pragma unroll
            for (int c = 0; c < 4; ++c) {
                const int chn = 4 * (4 * dh + c) + 2 * blk + (p4 >> 1), bo = 8 * (p4 & 1);
                const bf16x8 v0 = cat8(tr_read4(kd + kv_off(0 + 4 * h + q4, chn) + bo), tr_read4(kd + kv_off(8 + 4 * h + q4, chn) + bo));
                const bf16x8 v1 = cat8(tr_read4(kd + kv_off(16 + 4 * h + q4, chn) + bo), tr_read4(kd + kv_off(24 + 4 * h + q4, chn) + bo));
                O[c] = __builtin_amdgcn_mfma_f32_32x32x16_bf16(v0, pf0, O[c], 0, 0, 0);
                O[c] = __builtin_amdgcn_mfma_f32_32x32x16_bf16(v1, pf1, O[c], 0, 0, 0);
                __builtin_amdgcn_sched_barrier(0);
            }
            if (kt + 1 < nkt) DSA_WRITE(cur ^ 1);
            __syncthreads();
        }
#undef DSA_LOAD
#undef DSA_WRITE
        const float inv = 1.0f / l_run;
        bf16_t* orow = cat + (size_t)(b * SEQ + tq) * CAT0_K + 1024 + head * 256 + 128 * dh;
#pragma unroll
        for (int c = 0; c < 4; ++c)
#pragma unroll
            for (int gq = 0; gq < 4; ++gq) { u32x2 w; w.x = pk2(O[c][4 * gq] * inv, O[c][4 * gq + 1] * inv); w.y = pk2(O[c][4 * gq + 2] * inv, O[c][4 * gq + 3] * inv);
                *(u32x2*)(orow + 32 * c + 8 * gq + 4 * h) = w; }
    }
    __syncthreads();
}

DI unsigned img_off(int row, int ch) { return (unsigned)(256 * row + 16 * (ch ^ (((row & 3) << 2) | ((row >> 2) & 3)))); }
DI void p12_gmlp(const Frame& F, const Args& a) {
    const bf16_t* proj = (const bf16_t*)(F.ws + WS_PROJ1); const bf16_t* wsm = (const bf16_t*)(F.ws + WS_WS); bf16_t* cat = (bf16_t*)(F.ws + WS_CAT1);
    const float* gv = a.in[I_ONV]; const float* bs = a.in[I_OBS];
    const int lane = F.lane, r = lane & 31, h = lane >> 5, w = F.wave, tid = F.tid;
    const int q4 = (lane & 15) >> 2, p4 = lane & 3, blk = (lane >> 4) & 1;
    LAS unsigned char* img = F.lds;
    LAS float* rs = (LAS float*)(F.lds + 32768);
    for (int u = F.bid; u < NB * (SEQ / 128); u += F.G) {
        const int b = u / (SEQ / 128), ch0 = u % (SEQ / 128); const size_t row0 = (size_t)b * SEQ + (size_t)ch0 * 128;
        __syncthreads();
        for (int i = 0; i < 16; ++i) { const int s = 16 * w + i; const bf16_t* vr = proj + (row0 + s) * ODD_IN + 1024; float ss = 0.f;
#pragma unroll
            for (int jj = 0; jj < 2; ++jj) { const u32x4 v = *(const u32x4*)(vr + 512 * jj + 8 * lane); const float f[8] = {bflo(v.x), bfhi(v.x), bflo(v.y), bfhi(v.y), bflo(v.z), bfhi(v.z), bflo(v.w), bfhi(v.w)};
#pragma unroll
                for (int e = 0; e < 8; ++e) ss += f[e] * f[e]; }
            ss = wave_sum(ss); if (lane == 0) rs[s] = 1.0f / sqrtf(ss * (1.f / 1024.f) + EPS); }
        __syncthreads();
        for (int g = 0; g < 8; ++g) {
#pragma unroll
            for (int i = 0; i < 4; ++i) { const int p = tid + 512 * i, s = p >> 4, chk = p & 15;
                const u32x4 v = *(const u32x4*)(proj + (row0 + s) * ODD_IN + 1024 + g * 128 + 8 * chk); const float rr = rs[s];
                const f32x4 g0 = *(const f32x4*)(gv + g * 128 + 8 * chk), g1 = *(const f32x4*)(gv + g * 128 + 8 * chk + 4);
                u32x4 o; o.x = pk2(bflo(v.x) * rr * g0.x, bfhi(v.x) * rr * g0.y); o.y = pk2(bflo(v.y) * rr * g0.z, bfhi(v.y) * rr * g0.w); o.z = pk2(bflo(v.z) * rr * g1.x, bfhi(v.z) * rr * g1.y); o.w = pk2(bflo(v.w) * rr * g1.z, bfhi(v.w) * rr * g1.w);
                *(LAS u32x4*)(img + (s >> 5) * 8192 + img_off(s & 31, chk)) = o; }
            __syncthreads();
            const int tb = w & 3, t = 32 * tb + r;
#pragma unroll
            for (int cc = 0; cc < 2; ++cc) { const int cb = 2 * (w >> 2) + cc;
                f32x16 D;
#pragma unroll
                for (int i = 0; i < 16; ++i) D[i] = 0.f;
                for (int ks = 0; ks <= 2 * tb + 1; ++ks) {
                    const LAS unsigned char* im = img + (ks >> 1) * 8192; const int k2 = ks & 1;
                    const int chn = 4 * cb + 2 * blk + (p4 >> 1), bo = 8 * (p4 & 1);
                    const bf16x8 af = cat8(tr_read4(im + img_off(16 * k2 + 8 * h + 0 + q4, chn) + bo), tr_read4(im + img_off(16 * k2 + 8 * h + 4 + q4, chn) + bo));
                    const bf16x8 bf = *(const bf16x8*)(wsm + (size_t)g * 16384 + (size_t)t * 128 + 16 * ks + 8 * h);
                    D = __builtin_amdgcn_mfma_f32_32x32x16_bf16(af, bf, D, 0, 0, 0);
                }
                const float bias = bs[g * 128 + t];
                const bf16_t* urow = proj + (row0 + t) * ODD_IN + g * 128 + 32 * cb; bf16_t* orow = cat + (row0 + t) * 2048 + g * 128 + 32 * cb;
#pragma unroll
                for (int gq = 0; gq < 4; ++gq) { const u32x2 uu = *(const u32x2*)(urow + 8 * gq + 4 * h);
                    u32x2 o; o.x = pk2(bflo(uu.x) * (D[4 * gq] + bias), bfhi(uu.x) * (D[4 * gq + 1] + bias)); o.y = pk2(bflo(uu.y) * (D[4 * gq + 2] + bias), bfhi(uu.y) * (D[4 * gq + 3] + bias));
                    *(u32x2*)(orow + 8 * gq + 4 * h) = o; }
            }
            __syncthreads();
        }
    }
    __syncthreads();
}

DI void p12_stick(const Frame& F) {
    const bf16_t* proj = (const bf16_t*)(F.ws + WS_PROJ1); bf16_t* cat = (bf16_t*)(F.ws + WS_CAT1);
    const int lane = F.lane, r = lane & 31, h = lane >> 5, w = F.wave, tid = F.tid;
    const int q4 = (lane & 15) >> 2, p4 = lane & 3, blk = (lane >> 4) & 1;
    LAS unsigned char* kb = F.lds;
    LAS unsigned char* vb = F.lds + 16384;
    const float SC2 = 0.08838834764831845f * 1.44269504f;
    const int nunits = NB * 8 * (SEQ / 256);
    for (int rd = 0; rd * F.G < nunits; ++rd) {
        const int j = (rd & 1) ? (F.G - 1 - F.bid) : F.bid; const int u = rd * F.G + j; if (u >= nunits) continue;
        const int qb = (SEQ / 256 - 1) - u / (NB * 8), bh = u % (NB * 8), b = bh >> 3, head = bh & 7;
        const int Q0 = qb * 256, tq = Q0 + 32 * w + r, ktd = (Q0 >> 5) + w, kt_hi = (Q0 >> 5) + 7;
        const bf16_t* base = proj + (size_t)b * SEQ * ODD_IN + head * 128;
        bf16x8 qf[8];
#pragma unroll
        for (int s = 0; s < 8; ++s) qf[s] = *(const bf16x8*)(base + (size_t)tq * ODD_IN + 2048 + 16 * s + 8 * h);
        f32x16 O[4];
#pragma unroll
        for (int c = 0; c < 4; ++c)
#pragma unroll
            for (int i = 0; i < 16; ++i) O[c][i] = 0.f;
        float R = 0.f;
        u32x4 st0, st1; const int skey = tid >> 4, sch = tid & 15;
#define SB_LOAD(kt) do { const bf16_t* src = base + (size_t)(32 * (kt) + skey) * ODD_IN + 8 * sch; st0 = *(const u32x4*)(src + 3072); st1 = *(const u32x4*)(src + 4096); } while (0)
#define SB_WRITE(bufi) do { *(LAS u32x4*)(kb + (bufi) * 8192 + img_off(skey, sch)) = st0; *(LAS u32x4*)(vb + (bufi) * 8192 + img_off(skey, sch)) = st1; } while (0)
        __syncthreads();
        SB_LOAD(kt_hi); SB_WRITE(0);
        __syncthreads();
        int cur = 0;
        for (int kt = kt_hi; kt >= 0; --kt) {
            if (kt > 0) SB_LOAD(kt - 1);
            if (kt <= ktd) {
                const LAS unsigned char* kd = kb + cur * 8192; const LAS unsigned char* vd = vb + cur * 8192;
                f32x16 S;
#pragma unroll
                for (int i = 0; i < 16; ++i) S[i] = 0.f;
#pragma unroll
                for (int s = 0; s < 8; ++s) { const bf16x8 kf = *(const LAS bf16x8*)(kd + img_off(r, 2 * s + h)); S = __builtin_amdgcn_mfma_f32_32x32x16_bf16(kf, qf[s], S, 0, 0, 0); }
                float lk[16], G[4];
#pragma unroll
                for (int gq = 0; gq < 4; ++gq) { G[gq] = 0.f;
#pragma unroll
                    for (int e = 0; e < 4; ++e) { const int i = 4 * gq + e, key = 32 * kt + 8 * gq + 4 * h + e; const bool past = key < tq;
                        const float z = S[i] * SC2, az = fabsf(z), sp = fmaxf(z, 0.f) + fast_log2(1.0f + fast_exp2(-az));
                        lk[i] = past ? -sp : 0.f; S[i] = past ? (z - sp) : -__builtin_inff(); G[gq] += lk[i]; } }
                float PG[4];
#pragma unroll
                for (int gq = 0; gq < 4; ++gq) PG[gq] = __shfl_xor(G[gq], 32);
                float hi = 0.f;
                float wv[16];
#pragma unroll
                for (int gq = 3; gq >= 0; --gq) { const float above = hi + (h ? 0.f : PG[gq]);
                    float run = R + above;
#pragma unroll
                    for (int e = 3; e >= 0; --e) { const int i = 4 * gq + e; wv[i] = fast_exp2(S[i] + run); run += lk[i]; }
                    hi += G[gq] + PG[gq]; }
                R += hi;
                const bf16x8 pf0 = pack8(wv[0], wv[1], wv[2], wv[3], wv[4], wv[5], wv[6], wv[7]), pf1 = pack8(wv[8], wv[9], wv[10], wv[11], wv[12], wv[13], wv[14], wv[15]);
#pragma unroll
                for (int c = 0; c < 4; ++c) {
                    const int chn = 4 * c + 2 * blk + (p4 >> 1), bo = 8 * (p4 & 1);
                    const bf16x8 v0 = cat8(tr_read4(vd + img_off(0 + 4 * h + q4, chn) + bo), tr_read4(vd + img_off(8 + 4 * h + q4, chn) + bo));
                    const bf16x8 v1 = cat8(tr_read4(vd + img_off(16 + 4 * h + q4, chn) + bo), tr_read4(vd + img_off(24 + 4 * h + q4, chn) + bo));
                    O[c] = __builtin_amdgcn_mfma_f32_32x32x16_bf16(v0, pf0, O[c], 0, 0, 0);
                    O[c] = __builtin_amdgcn_mfma_f32_32x32x16_bf16(v1, pf1, O[c], 0, 0, 0);
                }
            }
            if (kt > 0) SB_WRITE(cur ^ 1);
            __syncthreads();
            cur ^= 1;
        }
#undef SB_LOAD
#undef SB_WRITE
        bf16_t* orow = cat + (size_t)(b * SEQ + tq) * 2048 + 1024 + head * 128;
#pragma unroll
        for (int c = 0; c < 4; ++c)
#pragma unroll
            for (int gq = 0; gq < 4; ++gq) { u32x2 o; o.x = pk2(O[c][4 * gq], O[c][4 * gq + 1]); o.y = pk2(O[c][4 * gq + 2], O[c][4 * gq + 3]);
                *(u32x2*)(orow + 32 * c + 8 * gq + 4 * h) = o; }
    }
    __syncthreads();
}

DI void p14_router(const Frame& F, const Args& a, const float* x3) {
    bf16_t* h3 = (bf16_t*)(F.ws + WS_H3); const float* gn = a.in[I_ONFFN]; const float* wr = a.in[I_OROUTER];
    int* tab_er = (int*)(F.ws + WS_TAB + TAB_ER); float* tab_gate = (float*)(F.ws + WS_TAB + TAB_GATE); unsigned* gcnt = (unsigned*)(F.ws + WS_CTL) + CW_CNT;
    const int lane = F.lane, w = F.wave, tid = F.tid;
    LAS float* wrT = (LAS float*)F.lds;
    LAS int* lcnt = (LAS int*)(F.lds + 65536);
    LAS int* lbase = lcnt + 8;
    LAS int* tokE = lcnt + 16;
    LAS int* tokR = tokE + 256;
    __syncthreads();
    for (int i = tid; i < 2048 * 8; i += 512) wrT[(i & 7) * 2048 + (i >> 3)] = wr[i];
    if (tid < 8) lcnt[tid] = 0;
    __syncthreads();
    for (int grp = F.bid; grp < MT / 128; grp += F.G) {
        for (int i = 0; i < 16; ++i) {
            const int tl = 16 * w + i, m = grp * 128 + tl;
            const f32x4* xr = (const f32x4*)(x3 + (size_t)m * DM) + lane; const f32x4* gr = (const f32x4*)gn + lane;
            f32x4 v[8]; float s = 0.f;
#pragma unroll
            for (int j = 0; j < 8; ++j) { v[j] = xr[64 * j]; s += (v[j].x * v[j].x + v[j].y * v[j].y) + (v[j].z * v[j].z + v[j].w * v[j].w); }
            const float rstd = 1.0f / sqrtf(wave_sum(s) * (1.f / DM) + EPS);
            u32x2* o8 = (u32x2*)(h3 + (size_t)m * DM) + lane;
#pragma unroll
            for (int j = 0; j < 8; ++j) { const f32x4 gg = gr[64 * j]; v[j].x *= rstd * gg.x; v[j].y *= rstd * gg.y; v[j].z *= rstd * gg.z; v[j].w *= rstd * gg.w;
                u32x2 ww; ww.x = pk2(v[j].x, v[j].y); ww.y = pk2(v[j].z, v[j].w); o8[64 * j] = ww; }
            float lg[8];
#pragma unroll
            for (int e = 0; e < 8; ++e) { float acc = 0.f;
#pragma unroll
                for (int j = 0; j < 8; ++j) { const f32x4 ww = *(const LAS f32x4*)(wrT + e * 2048 + 4 * (lane + 64 * j)); acc += (v[j].x * ww.x + v[j].y * ww.y) + (v[j].z * ww.z + v[j].w * ww.w); }
                lg[e] = wave_sum(acc); }
            int i1 = 0; float v1 = lg[0];
#pragma unroll
            for (int e = 1; e < 8; ++e) if (lg[e] > v1) { v1 = lg[e]; i1 = e; }
            int i2 = -1; float v2 = -__builtin_inff();
#pragma unroll
            for (int e = 0; e < 8; ++e) if (e != i1 && lg[e] > v2) { v2 = lg[e]; i2 = e; }
            if (lane == 0) {
                const float g1 = 1.0f / (1.0f + __expf(v2 - v1));
                tab_gate[(size_t)m * 2] = g1; tab_gate[(size_t)m * 2 + 1] = 1.0f - g1;
                tokE[tl * 2] = i1; tokE[tl * 2 + 1] = i2;
                tokR[tl * 2] = __hip_atomic_fetch_add(lcnt + i1, 1, __ATOMIC_RELAXED, __HIP_MEMORY_SCOPE_WORKGROUP);
                tokR[tl * 2 + 1] = __hip_atomic_fetch_add(lcnt + i2, 1, __ATOMIC_RELAXED, __HIP_MEMORY_SCOPE_WORKGROUP);
            }
        }
        __syncthreads();
        if (tid < 8) lbase[tid] = (int)__hip_atomic_fetch_add(gcnt + 64 * tid, (unsigned)lcnt[tid], __ATOMIC_RELAXED, __HIP_MEMORY_SCOPE_AGENT);
        __syncthreads();
        if (tid < 256) { const int e = tokE[tid]; tab_er[((size_t)grp * 128) * 4 + tid * 2] = e; tab_er[((size_t)grp * 128) * 4 + tid * 2 + 1] = lbase[e] + tokR[tid]; }
        __syncthreads();
        if (tid < 8) lcnt[tid] = 0;
        __syncthreads();
    }
}

DI void moe_tiles(const Frame& F, int (&ts)[9], int (&cnt)[8]) {
    const unsigned* gcnt = (const unsigned*)(F.ws + WS_CTL) + CW_CNT;
    ts[0] = 0;
#pragma unroll
    for (int e = 0; e < 8; ++e) { cnt[e] = (int)__builtin_amdgcn_readfirstlane(__hip_atomic_load(gcnt + 64 * e, __ATOMIC_RELAXED, __HIP_MEMORY_SCOPE_AGENT)); ts[e + 1] = ts[e] + ((cnt[e] + 255) >> 8); }
}

DI void p15_gather(const Frame& F) {
    const bf16_t* h3 = (const bf16_t*)(F.ws + WS_H3); bf16_t* hs = (bf16_t*)(F.ws + WS_HS);
    const int* tab_er = (const int*)(F.ws + WS_TAB + TAB_ER); int* tab_slot = (int*)(F.ws + WS_TAB + TAB_SLOT);
    int ts[9], cnt[8]; moe_tiles(F, ts, cnt);
    const int lane = F.lane;
    for (int m = F.gw; m < MT; m += F.NGW) {
        const u32x4* src = (const u32x4*)(h3 + (size_t)m * DM) + lane;
        const u32x4 v0 = src[0], v1 = src[64], v2 = src[128], v3 = src[192];
#pragma unroll
        for (int k = 0; k < 2; ++k) { const int e = tab_er[(size_t)m * 4 + 2 * k], rk = tab_er[(size_t)m * 4 + 2 * k + 1];
            int t0 = 0;
#pragma unroll
            for (int q = 0; q < 8; ++q) t0 = (e == q) ? ts[q] : t0;
            const int slot = t0 * 256 + rk;
            u32x4* dst = (u32x4*)(hs + (size_t)slot * DM) + lane; dst[0] = v0; dst[64] = v1; dst[128] = v2; dst[192] = v3;
            if (lane == 0) tab_slot[(size_t)m * 2 + k] = slot; }
    }
    for (int idx = F.gw; idx < 8 * 256; idx += F.NGW) { const int e = idx >> 8, rr = idx & 255; int t0 = 0, t1 = 0, c = 0;
#pragma unroll
        for (int q = 0; q < 8; ++q) { t0 = (e == q) ? ts[q] : t0; t1 = (e == q) ? ts[q + 1] : t1; c = (e == q) ? cnt[q] : c; }
        const int row = t0 * 256 + c + rr;
        if (row < t1 * 256) { u32x4* dst = (u32x4*)(hs + (size_t)row * DM) + lane; const u32x4 z = {0u, 0u, 0u, 0u}; dst[0] = z; dst[64] = z; dst[128] = z; dst[192] = z; } }
}

DI void p22_final(const Frame& F, const Args& a, float* out) {
    const bf16_t* Y = (const bf16_t*)(F.ws + WS_Y); const float* tab_gate = (const float*)(F.ws + WS_TAB + TAB_GATE); const int* tab_slot = (const int*)(F.ws + WS_TAB + TAB_SLOT);
    const float* gn = a.in[I_FNORM]; const int lane = F.lane;
    for (int m = F.gw; m < MT; m += F.NGW) {
        const float g1 = tab_gate[(size_t)m * 2], g2 = tab_gate[(size_t)m * 2 + 1]; const int s1 = tab_slot[(size_t)m * 2], s2 = tab_slot[(size_t)m * 2 + 1];
        f32x4* xr = (f32x4*)(out + (size_t)m * DM) + lane; const u32x2* y1 = (const u32x2*)(Y + (size_t)s1 * DM) + lane; const u32x2* y2 = (const u32x2*)(Y + (size_t)s2 * DM) + lane;
        const f32x4* gr = (const f32x4*)gn + lane;
        f32x4 v[8]; float s = 0.f;
#pragma unroll
        for (int j = 0; j < 8; ++j) { v[j] = xr[64 * j]; const u32x2 a1 = y1[64 * j], a2 = y2[64 * j];
            v[j].x += g1 * bflo(a1.x) + g2 * bflo(a2.x); v[j].y += g1 * bfhi(a1.x) + g2 * bfhi(a2.x); v[j].z += g1 * bflo(a1.y) + g2 * bflo(a2.y); v[j].w += g1 * bfhi(a1.y) + g2 * bfhi(a2.y);
            s += (v[j].x * v[j].x + v[j].y * v[j].y) + (v[j].z * v[j].z + v[j].w * v[j].w); }
        const float rstd = 1.0f / sqrtf(wave_sum(s) * (1.f / DM) + EPS);
#pragma unroll
        for (int j = 0; j < 8; ++j) { const f32x4 gg = gr[64 * j]; f32x4 o; o.x = v[j].x * rstd * gg.x; o.y = v[j].y * rstd * gg.y; o.z = v[j].z * rstd * gg.z; o.w = v[j].w * rstd * gg.w; xr[64 * j] = o; }
    }
}

constexpr int N_PHASES = 23;
__global__ void __launch_bounds__(512, 2) fwd(Args args) {
    extern __shared__ __attribute__((aligned(16))) unsigned char lds_raw[];
    Frame F;
    F.lds = (LAS unsigned char*)lds_raw; F.tid = threadIdx.x; F.lane = F.tid & 63; F.wave = __builtin_amdgcn_readfirstlane(F.tid >> 6);
    F.G = gridDim.x; F.bid = blockIdx.x; F.gw = F.bid * 8 + F.wave; F.NGW = F.G * 8; F.ws = args.ws;
    volatile LAS unsigned* MISC = (volatile LAS unsigned*)(F.lds + MISC_OFF);
    if (F.tid < 64) MISC[F.tid] = 0u;
    __syncthreads();
    const int lo = args.ph_lo, hi = args.ph_hi;
    XcdBarrier bar; bar.bar = (unsigned*)(F.ws + WS_CTL) + CW_BAR; bar.x = 0; bar.st = MISC + 8;
    if (hi - lo > 1) bar = xcd_barrier_post((unsigned*)(F.ws + WS_CTL) + CW_BAR, MISC + 8);
#ifdef ONLY_PHASE
#define IN(k) ((k) == ONLY_PHASE && lo <= (k) && (k) < hi)
#else
#define IN(k) (lo <= (k) && (k) < hi)
#endif
#define SEAM(k) do { if (IN(k) && IN((k) + 1)) xcd_barrier(bar); } while (0)
    unsigned char* ws = F.ws; float* out = args.out;
    LAS unsigned char* ring = F.lds;

    if (IN(0)) { p0_prologue(F, args); } SEAM(0);
    if (IN(1)) { pg8::Gemm g{(const bf16_t*)(ws + WS_H0), (const bf16_t*)(ws + WS_WIN0), 2048, 2048, 2048}; pg8::Sched S; S.init(MT / 256, EVEN_INP / 256, F.G, F.bid, 0);
        pg8::EpiStore E{(bf16_t*)(ws + WS_PROJ0), EVEN_INP, 0, 0}; pg8::gemm_phase(ring, g, S, E); } SEAM(1);
    if (IN(2)) { p2_rows(F, args); } SEAM(2);
    if (IN(3)) { pg8::Gemm g{(const bf16_t*)(ws + WS_CQN), (const bf16_t*)(ws + WS_WQQ), 512, 512, 512}; pg8::Sched S; S.init(MT / 256, QQ_N / 256, F.G, F.bid, 0);
        pg8::EpiStore E{(bf16_t*)(ws + WS_QQ), QQ_N, 0, 0}; pg8::gemm_phase(ring, g, S, E); } SEAM(3);
    #ifndef NO_P4
    if (IN(4)) { p4_indexer(F); } SEAM(4);
#endif
    #ifndef NO_P5
    if (IN(5)) { p5_dsa(F, args); } SEAM(5);
#endif
    if (IN(6)) { pg8::Gemm g{(const bf16_t*)(ws + WS_CAT0), (const bf16_t*)(ws + WS_WOUT0), CAT0_K, CAT0_K, CAT0_K}; pg8::Sched S; S.init(MT / 256, DM / 256, F.G, F.bid, 0);
        pg8::EpiRes E{args.in[I_X], out, DM}; pg8::gemm_phase(ring, g, S, E); } SEAM(6);
    if (IN(7)) { rms_phase(F, out, args.in[I_ENFFN], (bf16_t*)(ws + WS_H1)); } SEAM(7);
    if (IN(8)) { pg8::Gemm g{(const bf16_t*)(ws + WS_H1), (const bf16_t*)(ws + WS_WGU0), 2048, 2048, 2048}; pg8::Sched S; S.init(MT / 256, 2 * DFF / 256, F.G, F.bid, 0);
        pg8::EpiSwiglu E{(bf16_t*)(ws + WS_ACT0), DFF, 0}; pg8::gemm_phase(ring, g, S, E); } SEAM(8);
    if (IN(9)) { pg8::Gemm g{(const bf16_t*)(ws + WS_ACT0), (const bf16_t*)(ws + WS_WDN0), DFF, DFF, DFF}; pg8::Sched S; S.init(MT / 256, DM / 256, F.G, F.bid, 0);
        pg8::EpiRes E{out, out, DM}; pg8::gemm_phase(ring, g, S, E); } SEAM(9);
    if (IN(10)) { rms_phase(F, out, args.in[I_ONMIX], (bf16_t*)(ws + WS_H2)); } SEAM(10);
    if (IN(11)) { pg8::Gemm g{(const bf16_t*)(ws + WS_H2), (const bf16_t*)(ws + WS_WIN1), 2048, 2048, 2048}; pg8::Sched S; S.init(MT / 256, ODD_IN / 256, F.G, F.bid, 0);
        pg8::EpiStore E{(bf16_t*)(ws + WS_PROJ1), ODD_IN, 0, 8}; pg8::gemm_phase(ring, g, S, E); } SEAM(11);
        if (IN(12)) {
#ifndef NO_P12A
        p12_gmlp(F, args);
#endif
#ifndef NO_P12B
        p12_stick(F);
#endif
    } SEAM(12);
    if (IN(13)) { pg8::Gemm g{(const bf16_t*)(ws + WS_CAT1), (const bf16_t*)(ws + WS_WOUT1), 2048, 2048, 2048}; pg8::Sched S; S.init(MT / 256, DM / 256, F.G, F.bid, 0);
        pg8::EpiRes E{out, out, DM}; pg8::gemm_phase(ring, g, S, E); } SEAM(13);
    if (IN(14)) { p14_router(F, args, out); } SEAM(14);
    if (IN(15)) { p15_gather(F); } SEAM(15);
#define MOE_CHUNK(c, pgu, pdn) \
    if (IN(pgu)) { int ts[9], cnt[8]; moe_tiles(F, ts, cnt); int nM = ts[8] - (c) * MOE_CHUNK_TILES; nM = nM > MOE_CHUNK_TILES ? MOE_CHUNK_TILES : (nM < 0 ? 0 : nM); \
        pg8::Gemm g{(const bf16_t*)(ws + WS_HS), (const bf16_t*)(ws + WS_WGU1), 2048, 2048, 2048}; pg8::Sched S; S.init(nM, 2 * DFFE / 256, F.G, F.bid, (c) * MOE_CHUNK_TILES); \
        for (int j = 0; j < 7; ++j) S.ts[j] = ts[j + 1]; \
        pg8::EpiSwiglu E{(bf16_t*)(ws + WS_ACT1), DFFE, (c) * MOE_CHUNK_TILES * 256}; pg8::gemm_phase(ring, g, S, E); } SEAM(pgu); \
    if (IN(pdn)) { int ts[9], cnt[8]; moe_tiles(F, ts, cnt); int nM = ts[8] - (c) * MOE_CHUNK_TILES; nM = nM > MOE_CHUNK_TILES ? MOE_CHUNK_TILES : (nM < 0 ? 0 : nM); \
        pg8::Gemm g{(const bf16_t*)(ws + WS_ACT1) - (size_t)(c) * MOE_CHUNK_TILES * 256 * DFFE, (const bf16_t*)(ws + WS_WDN1), DFFE, DFFE, DFFE}; pg8::Sched S; S.init(nM, DM / 256, F.G, F.bid, (c) * MOE_CHUNK_TILES); \
        for (int j = 0; j < 7; ++j) S.ts[j] = ts[j + 1]; \
        pg8::EpiStore E{(bf16_t*)(ws + WS_Y), DM, 0, 0}; pg8::gemm_phase(ring, g, S, E); } SEAM(pdn);
    MOE_CHUNK(0, 16, 17)
    MOE_CHUNK(1, 18, 19)
    MOE_CHUNK(2, 20, 21)
    if (IN(22)) { p22_final(F, args, out); }
#undef IN
#undef SEAM
}

extern "C" void kernel_launch(void* const* d_in, const int* in_sizes, int n_in, void* d_out, int out_size, void* d_ws, size_t ws_size, hipStream_t stream) {
    static int grid = 0;
    if (grid == 0) {
        if (n_in != 28 || out_size != MT * DM || ws_size < WS_END) { fprintf(stderr, "kernel_launch: unexpected shapes (n_in %d out %d ws %zu need %zu)\n", n_in, out_size, ws_size, (size_t)WS_END); grid = -1; return; }
        int dev = 0, cus = 0, per_cu = 0;
        if (hipGetDevice(&dev) != hipSuccess || hipDeviceGetAttribute(&cus, hipDeviceAttributeMultiprocessorCount, dev) != hipSuccess) { grid = -1; return; }
        if (hipFuncSetAttribute((const void*)fwd, hipFuncAttributeMaxDynamicSharedMemorySize, LDS_BYTES) != hipSuccess) { fprintf(stderr, "kernel_launch: hipFuncSetAttribute failed\n"); grid = -1; return; }
        if (hipOccupancyMaxActiveBlocksPerMultiprocessor(&per_cu, (const void*)fwd, 512, LDS_BYTES) != hipSuccess || per_cu < 1) { fprintf(stderr, "kernel_launch: occupancy query says %d\n", per_cu); }
        (void)hipGetLastError();
        grid = cus;
    }
    if (grid < 0) return;
    (void)hipMemsetAsync((char*)d_ws + WS_CTL, 0, CTL_ZERO_BYTES, stream);
    Args a{};
    for (int i = 0; i < 28; ++i) a.in[i] = (const float*)d_in[i];
    a.out = (float*)d_out; a.ws = (unsigned char*)d_ws;
#if MK_ONE_LAUNCH
    a.ph_lo = 0; a.ph_hi = N_PHASES;
    hipLaunchKernelGGL(fwd, dim3(grid), dim3(512), LDS_BYTES, stream, a);
#else
    for (int p = 0; p < N_PHASES; ++p) { a.ph_lo = p; a.ph_hi = p + 1; hipLaunchKernelGGL(fwd, dim3(grid), dim3(512), LDS_BYTES, stream, a); }
#endif
}
```

```cpp
#include <hip/hip_runtime.h>
#include <cstdio>
#include <cstdint>

#ifndef MK_ONE_LAUNCH
#define MK_ONE_LAUNCH 1
#endif

#define LAS __attribute__((address_space(3)))
#define GAS __attribute__((address_space(1)))
typedef unsigned short bf16_t;
typedef short bf16x8 __attribute__((ext_vector_type(8)));
typedef short s16x4 __attribute__((ext_vector_type(4)));
typedef float f32x2 __attribute__((ext_vector_type(2)));
typedef float f32x4 __attribute__((ext_vector_type(4)));
typedef float f32x16 __attribute__((ext_vector_type(16)));
typedef unsigned u32x2 __attribute__((ext_vector_type(2)));
typedef unsigned u32x4 __attribute__((ext_vector_type(4)));
typedef __bf16 bf16x2_t __attribute__((ext_vector_type(2)));
typedef GAS unsigned gu32;

#define DI __device__ __forceinline__

constexpr int DM = 2048, NB = 16, SEQ = 2048, MT = NB * SEQ;
constexpr int EVEN_IN = 3920, EVEN_INP = 4096, ODD_IN = 5120;
constexpr int DFF = 5632, NEXP = 8, DFFE = 7168;
constexpr float EPS = 1e-6f;
constexpr int QQ_N = 3072;
constexpr int CAT0_K = 3072;
constexpr int MOE_ROWS = 65536 + 2048;
constexpr int MOE_CHUNK_TILES = 88;

DI unsigned pk2(float a, float b) { bf16x2_t v = __builtin_convertvector((f32x2){a, b}, bf16x2_t); return __builtin_bit_cast(unsigned, v); }
DI float bf2f(bf16_t v) { return __builtin_bit_cast(float, (unsigned)v << 16); }
DI float bflo(unsigned w) { return __builtin_bit_cast(float, w << 16); }
DI float bfhi(unsigned w) { return __builtin_bit_cast(float, w & 0xffff0000u); }
DI float wave_sum(float v) {
#pragma unroll
    for (int o = 1; o < 64; o <<= 1) v += __shfl_xor(v, o);
    return v;
}
DI float fast_exp2(float x) { return __builtin_amdgcn_exp2f(x); }
DI float fast_log2(float x) { return __builtin_amdgcn_logf(x); }
DI float fast_rcp(float x) { return __builtin_amdgcn_rcpf(x); }

namespace pg8 {
constexpr int BM = 256, BK = 64, HALF = 128, HTB = HALF * BK * 2, STAGE_BYTES = 8 * HTB, NXCD = 8, WGM = 8;
__host__ __device__ __forceinline__ int lds_byte(int r, int c) { const int st = (r >> 4) * 2 + (c >> 5), rr = r & 15, cc = c & 31, ob = rr * 64 + cc * 2; return st * 1024 + (ob ^ (((ob >> 9) & 1) << 5)); }
__host__ __device__ __forceinline__ void stage_rc(int b, int& R, int& C) { const int st = b / 1024, sb = b % 1024, swz = sb ^ (((sb >> 9) & 1) << 5); R = (st >> 1) * 16 + swz / 64; C = (st & 1) * 32 + (swz % 64) / 2; }
__host__ __device__ __forceinline__ int perm32(int rho) { const int n = rho >> 4, i = rho & 15; return 8 * (i >> 2) + 4 * n + (i & 3); }

struct Unit { int pm, pn, bt; };
struct Gemm { const bf16_t* A; const bf16_t* Bt; int lda, ldb, K; };

struct Sched {
    int nM, nN, nwg, G, c, pm0, grouped; int ts[7];
    __device__ void init(int nM_, int nN_, int G_, int c_, int pm0_) { nM = nM_; nN = nN_; nwg = nM * nN; G = G_; c = c_; pm0 = pm0_; grouped = 0; for (int j = 0; j < 7; ++j) ts[j] = 0x7fffffff; }
    __device__ __forceinline__ bool next(int i, Unit& u) const {
        const long L = (long)i * G + c; if (L >= nwg) return false;
        int wgid = (int)L; { const int q = nwg / NXCD, r = nwg % NXCD, xcd = wgid % NXCD, off = wgid / NXCD; wgid = (xcd < r ? xcd * (q + 1) : r * (q + 1) + (xcd - r) * q) + off; }
        const int nig = WGM * nN, gid = wgid / nig, fm = gid * WGM, gsz = (nM - fm) < WGM ? (nM - fm) : WGM;
        u.pm = pm0 + fm + ((wgid % nig) % gsz); u.pn = (wgid % nig) / gsz;
        int e = 0;
#pragma unroll
        for (int j = 0; j < 7; ++j) e += (u.pm >= ts[j]) ? 1 : 0;
        u.bt = e * nN + u.pn; return true;
    }
};

DI f32x4 gelu_tanh4(f32x4 v) {
    f32x4 o;
#pragma unroll
    for (int j = 0; j < 4; ++j) { const float x = v[j]; const float t = x * (1.0f + 0.044715f * x * x) * (-2.0f * 0.7978845608f * 1.44269504f); o[j] = x * fast_rcp(1.0f + fast_exp2(t)); }
    return o;
}
struct EpiStore {
    static constexpr bool PERM = true;
    bf16_t* O; int ldc, row_sub, gelu_tiles;
    DI void operator()(const f32x4 (&acc)[2][2][4][2], const Unit& u, int wr, int wc, int fr, int fq) const {
        const int row0 = u.pm * BM - row_sub + wr * 64 + fr, col0 = u.pn * BM + wc * 32 + 8 * fq; const bool g = u.pn < gelu_tiles;
#pragma unroll
        for (int ai = 0; ai < 2; ++ai)
#pragma unroll
            for (int m = 0; m < 4; ++m) { bf16_t* rowp = O + (size_t)(row0 + ai * HALF + m * 16) * ldc + col0;
#pragma unroll
                for (int bj = 0; bj < 2; ++bj) { f32x4 v0 = acc[ai][bj][m][0], v1 = acc[ai][bj][m][1];
                    if (g) { v0 = gelu_tanh4(v0); v1 = gelu_tanh4(v1); }
                    u32x4 w; w.x = pk2(v0[0], v0[1]); w.y = pk2(v0[2], v0[3]); w.z = pk2(v1[0], v1[1]); w.w = pk2(v1[2], v1[3]);
                    *(u32x4*)(rowp + bj * HALF) = w; } }
    }
};
struct EpiRes {
    static constexpr bool PERM = false;
    const float* base; float* out; int ldc;
    DI void operator()(const f32x4 (&acc)[2][2][4][2], const Unit& u, int wr, int wc, int fr, int fq) const {
        const int row0 = u.pm * BM + wr * 64 + fr, col0 = u.pn * BM + wc * 32 + 4 * fq;
#pragma unroll
        for (int ai = 0; ai < 2; ++ai)
#pragma unroll
            for (int m = 0; m < 4; ++m) { const size_t off = (size_t)(row0 + ai * HALF + m * 16) * ldc + col0;
#pragma unroll
                for (int bj = 0; bj < 2; ++bj)
#pragma unroll
                    for (int n = 0; n < 2; ++n) { const f32x4 b = *(const f32x4*)(base + off + bj * HALF + n * 16); *(f32x4*)(out + off + bj * HALF + n * 16) = b + acc[ai][bj][m][n]; } }
    }
};
struct EpiSwiglu {
    static constexpr bool PERM = true;
    bf16_t* O; int ldc, row_sub;
    DI void operator()(const f32x4 (&acc)[2][2][4][2], const Unit& u, int wr, int wc, int fr, int fq) const {
        const int row0 = u.pm * BM - row_sub + wr * 64 + fr, col0 = u.pn * HALF + wc * 32 + 8 * fq;
#pragma unroll
        for (int ai = 0; ai < 2; ++ai)
#pragma unroll
            for (int m = 0; m < 4; ++m) { float o[8];
#pragma unroll
                for (int n = 0; n < 2; ++n)
#pragma unroll
                    for (int j = 0; j < 4; ++j) { const float g = acc[ai][0][m][n][j], up = acc[ai][1][m][n][j]; o[4 * n + j] = g * fast_rcp(1.0f + fast_exp2(-1.44269504f * g)) * up; }
                u32x4 w; w.x = pk2(o[0], o[1]); w.y = pk2(o[2], o[3]); w.z = pk2(o[4], o[5]); w.w = pk2(o[6], o[7]);
                *(u32x4*)(O + (size_t)(row0 + ai * HALF + m * 16) * ldc + col0) = w; }
    }
};

template <class Epi>
DI void gemm_phase(LAS unsigned char* lds, const Gemm g, const Sched& S, const Epi& E) {
    const int tid = threadIdx.x, wid = __builtin_amdgcn_readfirstlane(tid >> 6), lane = tid & 63, wr = wid >> 2, wc = wid & 3, fr = lane & 15, fq = lane >> 4;
    const int K = g.K, nt = K / BK;
    unsigned voffA[2], voffB[2];
#pragma unroll
    for (int i = 0; i < 2; ++i) { int R, C; stage_rc(tid * 16 + i * 8192, R, C); const int Rb = Epi::PERM ? ((R & ~31) + perm32(R & 31)) : R;
        voffA[i] = (unsigned)(R * g.lda + C) * 2u; voffB[i] = (unsigned)(Rb * g.ldb + C) * 2u; }
    const size_t kstep = (size_t)(BK * 2);
    const size_t hstepA = (size_t)HALF * g.lda * 2, hstepB = (size_t)HALF * g.ldb * 2;
    const size_t tstepA = 2 * hstepA, tstepB = 2 * hstepB;
    const unsigned ldsw = (unsigned)wid * 1024u;
    const int aoff = lds_byte(wr * 64 + fr, fq * 8), boff = lds_byte(wc * 32 + fr, fq * 8);
#define PG8_SA(b, h) (((b) * 2 + (h)) * HTB)
#define PG8_SB(b, h) ((4 + (b) * 2 + (h)) * HTB)
#define PG8_STAGE(bufoff, gbase, voff) do { _Pragma("unroll") for (int _i = 0; _i < 2; ++_i) \
        __builtin_amdgcn_global_load_lds((const unsigned*)((const char*)(gbase) + (voff)[_i]), (LAS unsigned*)(lds + (bufoff) + ldsw + _i * 8192), 16, 0, 0); } while (0)
#define PG8_LDA(dst, b, h) do { _Pragma("unroll") for (int m = 0; m < 4; ++m) _Pragma("unroll") for (int k = 0; k < 2; ++k) dst[m][k] = *(const LAS bf16x8*)(lds + PG8_SA(b, h) + aoff + m * 2048 + k * 1024); } while (0)
#define PG8_LDB(dst, b, h) do { _Pragma("unroll") for (int n = 0; n < 2; ++n) _Pragma("unroll") for (int k = 0; k < 2; ++k) dst[n][k] = *(const LAS bf16x8*)(lds + PG8_SB(b, h) + boff + n * 2048 + k * 1024); } while (0)
#define PG8_MMA(ai, bj, At, Bt) do { __builtin_amdgcn_s_setprio(1); _Pragma("unroll") for (int m = 0; m < 4; ++m) _Pragma("unroll") for (int n = 0; n < 2; ++n) _Pragma("unroll") for (int k = 0; k < 2; ++k) \
        acc[ai][bj][m][n] = __builtin_amdgcn_mfma_f32_16x16x32_bf16(Bt[n][k], At[m][k], acc[ai][bj][m][n], 0, 0, 0); __builtin_amdgcn_s_setprio(0); } while (0)
#define PG8_WAIT_V(n) asm volatile("s_waitcnt vmcnt(" #n ")" ::: "memory")
#define PG8_WAIT_L(n) asm volatile("s_waitcnt lgkmcnt(" #n ")" ::: "memory")
#define PG8_BAR __builtin_amdgcn_s_barrier()
#define PG8_SCHED __builtin_amdgcn_sched_barrier(0)
    Unit cur, nxt; int ui = 0;
    if (!S.next(0, cur)) return;
    f32x4 acc[2][2][4][2];
#pragma unroll
    for (int a = 0; a < 2; ++a)
#pragma unroll
        for (int b = 0; b < 2; ++b)
#pragma unroll
            for (int m = 0; m < 4; ++m)
#pragma unroll
                for (int n = 0; n < 2; ++n) acc[a][b][m][n] = (f32x4){0.f, 0.f, 0.f, 0.f};
    bf16x8 At[4][2], B0[2][2], B1[2][2];
    const char* cA = (const char*)g.A + (size_t)cur.pm * tstepA; const char* cB = (const char*)g.Bt + (size_t)cur.bt * tstepB;
    PG8_STAGE(PG8_SB(0, 0), cB, voffB); PG8_STAGE(PG8_SB(0, 1), cB + hstepB, voffB); PG8_STAGE(PG8_SA(0, 0), cA, voffA); PG8_STAGE(PG8_SA(0, 1), cA + hstepA, voffA);
    if (wr == 1) PG8_BAR;
    PG8_WAIT_V(2); PG8_BAR;
    PG8_STAGE(PG8_SB(1, 0), cB + kstep, voffB); PG8_STAGE(PG8_SA(1, 0), cA + kstep, voffA); PG8_STAGE(PG8_SB(1, 1), cB + hstepB + kstep, voffB);
    PG8_WAIT_V(6); PG8_BAR;
    for (;;) {
        const bool has_next = S.next(ui + 1, nxt);
        const char* nA = has_next ? (const char*)g.A + (size_t)nxt.pm * tstepA : cA; const char* nB = has_next ? (const char*)g.Bt + (size_t)nxt.bt * tstepB : cB;
        for (int t = 0; t < nt; t += 2) {
            const bool last = (t == nt - 2);
            const char* a1 = cA + (size_t)(t + 1) * kstep;
            const char* a2 = last ? nA : cA + (size_t)(t + 2) * kstep; const char* b2 = last ? nB : cB + (size_t)(t + 2) * kstep;
            const char* a3 = a2 + kstep; const char* b3 = b2 + kstep;
            PG8_LDB(B0, 0, 0); PG8_LDB(B1, 0, 1); PG8_SCHED; PG8_LDA(At, 0, 0); PG8_STAGE(PG8_SA(1, 1), a1 + hstepA, voffA);
            PG8_WAIT_V(8); PG8_WAIT_L(0); PG8_BAR; PG8_MMA(0, 0, At, B0); PG8_MMA(0, 1, At, B1); PG8_BAR; PG8_SCHED;
            PG8_LDA(At, 0, 1); PG8_STAGE(PG8_SB(0, 0), b2, voffB); PG8_STAGE(PG8_SB(0, 1), b2 + hstepB, voffB); PG8_STAGE(PG8_SA(0, 0), a2, voffA);
            PG8_WAIT_V(8); PG8_WAIT_L(0); PG8_BAR; PG8_MMA(1, 0, At, B0); PG8_MMA(1, 1, At, B1); PG8_BAR; PG8_SCHED;
            PG8_LDB(B0, 1, 0); PG8_LDB(B1, 1, 1); PG8_SCHED; PG8_LDA(At, 1, 0); PG8_STAGE(PG8_SA(0, 1), a2 + hstepA, voffA);
            PG8_WAIT_V(8); PG8_WAIT_L(0); PG8_BAR; PG8_MMA(0, 0, At, B0); PG8_MMA(0, 1, At, B1); PG8_BAR; PG8_SCHED;
            PG8_LDA(At, 1, 1); PG8_STAGE(PG8_SB(1, 0), b3, voffB); PG8_STAGE(PG8_SB(1, 1), b3 + hstepB, voffB); PG8_STAGE(PG8_SA(1, 0), a3, voffA);
            PG8_WAIT_V(8); PG8_WAIT_L(0); PG8_BAR; PG8_MMA(1, 0, At, B0); PG8_MMA(1, 1, At, B1); PG8_BAR; PG8_SCHED;
        }
        if (wr == 0) PG8_BAR;
        E(acc, cur, wr, wc, fr, fq);
        if (!has_next) break;
#pragma unroll
        for (int a = 0; a < 2; ++a)
#pragma unroll
            for (int b = 0; b < 2; ++b)
#pragma unroll
                for (int m = 0; m < 4; ++m)
#pragma unroll
                    for (int n = 0; n < 2; ++n) acc[a][b][m][n] = (f32x4){0.f, 0.f, 0.f, 0.f};
        cur = nxt; cA = nA; cB = nB; ++ui;
        if (wr == 1) PG8_BAR;
    }
    PG8_WAIT_V(0);
    PG8_BAR;
#undef PG8_SA
#undef PG8_SB
#undef PG8_STAGE
#undef PG8_LDA
#undef PG8_LDB
#undef PG8_MMA
#undef PG8_WAIT_V
#undef PG8_WAIT_L
#undef PG8_BAR
#undef PG8_SCHED
}
}

#define XB_TMO      128
#define XB_XCNT(j)  (256  + 64 * (j))
#define XB_XSUB(j)  (1280 + 64 * (j))
#define XB_XGEN(j)  (2304 + 64 * (j))
#define XB_TOP      3328
#define XB_TOPGEN   3392
#define XCD_BAR_WORDS 3456
#define XB_SPIN_CAP (1u << 22)

DI unsigned xb_ld(unsigned* p)              { return __hip_atomic_load(p, __ATOMIC_RELAXED, __HIP_MEMORY_SCOPE_AGENT); }
DI unsigned xb_add(unsigned* p, unsigned v) { return __hip_atomic_fetch_add(p, v, __ATOMIC_RELAXED, __HIP_MEMORY_SCOPE_AGENT); }
DI unsigned xb_xcc_id() { return (unsigned)__builtin_amdgcn_s_getreg((3 << 11) | 20) & 0xFu; }
#define XB_SPIN(cond, bar) do { unsigned _sp = 0; while (cond) { __builtin_amdgcn_s_sleep(1); \
    if ((++_sp & 255u) == 0u) { if (xb_ld(&(bar)[XB_TMO])) break; if (_sp > XB_SPIN_CAP) { atomicAdd(&(bar)[XB_TMO], 1u); break; } } } } while (0)

struct XcdBarrier { unsigned* bar; unsigned x; volatile LAS unsigned* st; };

DI XcdBarrier xcd_barrier_post(unsigned* bar, volatile LAS unsigned* st) {
    XcdBarrier b; b.bar = bar; b.x = xb_xcc_id(); b.st = st;
    if (threadIdx.x == 0) (void)xb_add(&bar[XB_XCNT(b.x)], 1u);
    return b;
}
DI void xcd_barrier_complete(unsigned* bar, unsigned x, unsigned& nloc, unsigned& nx) {
    const unsigned G = gridDim.x * gridDim.y * gridDim.z;
    unsigned sum, cnt, mine, sp = 0u;
    for (;;) {
        sum = 0u; cnt = 0u; mine = 0u;
#pragma unroll
        for (unsigned j = 0; j < 16; ++j) { const unsigned c = xb_ld(&bar[XB_XCNT(j)]); sum += c; cnt += (c > 0u) ? 1u : 0u; mine = (j == x) ? c : mine; }
        if (sum == G) break;
        __builtin_amdgcn_s_sleep(1);
        if ((++sp & 255u) == 0u) { if (xb_ld(&bar[XB_TMO])) break; if (sp > XB_SPIN_CAP) { atomicAdd(&bar[XB_TMO], 1u); break; } }
    }
    nloc = mine > 0u ? mine : 1u; nx = cnt > 0u ? cnt : 1u;
}
DI void xcd_barrier(const XcdBarrier& b) {
    asm volatile("s_waitcnt vmcnt(0)" ::: "memory");
    __syncthreads();
    if (threadIdx.x == 0) {
        unsigned* bar = b.bar;
        __builtin_amdgcn_s_waitcnt(0);
        unsigned nloc = b.st[0], nx = b.st[1];
        if (nloc == 0u) { xcd_barrier_complete(bar, b.x, nloc, nx); b.st[0] = nloc; b.st[1] = nx; }
        const unsigned old = xb_add(&bar[XB_XSUB(b.x)], 1u);
        const unsigned gen = old / nloc;
        if (old + 1u == (gen + 1u) * nloc) {
            __builtin_amdgcn_fence(__ATOMIC_RELEASE, "agent");
            asm volatile("s_waitcnt vmcnt(0)" ::: "memory");
            const unsigned og = xb_add(&bar[XB_TOP], 1u);
            const unsigned tg = og / nx;
            if (og + 1u == (tg + 1u) * nx) xb_add(&bar[XB_TOPGEN], 1u);
            else XB_SPIN(xb_ld(&bar[XB_TOPGEN]) == tg, bar);
            __builtin_amdgcn_fence(__ATOMIC_ACQUIRE, "agent");
            xb_add(&bar[XB_XGEN(b.x)], 1u);
            asm volatile("s_waitcnt vmcnt(0)" ::: "memory");
        } else {
            XB_SPIN(xb_ld(&bar[XB_XGEN(b.x)]) == gen, bar);
            __builtin_amdgcn_fence(__ATOMIC_ACQUIRE, "agent");
            asm volatile("s_waitcnt vmcnt(0)" ::: "memory");
        }
    }
    __syncthreads();
}

constexpr size_t MiB = 1u << 20;
constexpr size_t WS_CTL = 0, CTL_ZERO_BYTES = 1 * MiB;
constexpr size_t WS_TAB = 1 * MiB;
constexpr size_t WS_WIN1 = 5 * MiB;
constexpr size_t WS_WOUT1 = 25 * MiB;
constexpr size_t WS_WS = 33 * MiB;
constexpr size_t WS_WGU1 = 34 * MiB;
constexpr size_t WS_WDN1 = 482 * MiB;
constexpr size_t WS_L0 = 706 * MiB;
constexpr size_t WS_WIN0 = WS_L0;
constexpr size_t WS_WQQ = WS_L0 + 16 * MiB;
constexpr size_t WS_WOUT0 = WS_L0 + 19 * MiB;
constexpr size_t WS_WGU0 = WS_L0 + 31 * MiB;
constexpr size_t WS_WDN0 = WS_L0 + 75 * MiB;
constexpr size_t WS_CQN = WS_L0 + 97 * MiB;
constexpr size_t WS_CKV = WS_L0 + 129 * MiB;
constexpr size_t WS_KX = WS_L0 + 145 * MiB;
constexpr size_t WS_WIDX = WS_L0 + 149 * MiB;
constexpr size_t WS_ACT = WS_L0 + 152 * MiB;
constexpr size_t WS_PROJ0 = WS_ACT;
constexpr size_t WS_CAT0 = WS_ACT + 256 * MiB;
constexpr size_t WS_QQ = WS_ACT + 448 * MiB;
constexpr size_t WS_H0 = WS_QQ;
constexpr size_t WS_SC = WS_ACT + 640 * MiB;
constexpr size_t WS_H1 = WS_SC;
constexpr size_t WS_ACT0 = WS_ACT;
constexpr size_t WS_H2 = WS_ACT;
constexpr size_t WS_PROJ1 = WS_ACT + 128 * MiB;
constexpr size_t WS_CAT1 = WS_ACT + 448 * MiB;
constexpr size_t WS_HS = WS_L0;
constexpr size_t WS_Y = WS_L0 + 264 * MiB;
constexpr size_t WS_ACT1 = WS_L0 + 528 * MiB;
constexpr size_t WS_H3 = WS_L0 + 840 * MiB;
constexpr size_t WS_END = WS_L0 + 968 * MiB;
static_assert(WS_SC + 128 * MiB <= WS_END && WS_CAT1 + 128 * MiB <= WS_H3 && WS_ACT1 + (size_t)MOE_CHUNK_TILES * 256 * DFFE * 2 <= WS_H3, "ws map");
constexpr size_t TAB_ER = 0;
constexpr size_t TAB_GATE = 512 * 1024;
constexpr size_t TAB_SLOT = 1024 * 1024;
constexpr int CW_BAR = 1024;
constexpr int CW_CNT = 8192;
constexpr int RING_BYTES = 131072, LDS_BYTES = 147456, MISC_OFF = LDS_BYTES - 256;

struct Args { const float* in[28]; float* out; unsigned char* ws; int ph_lo, ph_hi; };
enum { I_X = 0, I_RELB, I_FNORM, I_ENMIX, I_EWIN, I_ECONV, I_ENCQ, I_ENCKV, I_EWUQ, I_EWUK, I_EWUV, I_EWQIDX, I_EWOUT, I_ENFFN, I_EGATE, I_EUP, I_EDOWN,
       I_ONMIX, I_OWIN, I_ONV, I_OWS, I_OBS, I_OWOUT, I_ONFFN, I_OROUTER, I_OGATE, I_OUP, I_ODOWN };

struct Frame {
    LAS unsigned char* lds;
    int tid, lane, wave, gw, NGW, G, bid;
    unsigned char* ws;
};

DI void tr_item(const float* W, int ldsrc, int N, bf16_t* WT, int ldd, int koff, int row_off, int mode, int nblk, LAS float* scr, int item, int lane) {
    const int kb = item / nblk, nb = item % nblk, k0 = 64 * kb, n0 = 64 * nb;
    const int q = lane & 15, rr = lane >> 4; const bool ok = n0 + 4 * q < N;
    const float* src = W + (size_t)(k0 + rr) * ldsrc + n0 + 4 * q;
    f32x4 v[16];
#pragma unroll
    for (int i = 0; i < 16; ++i) v[i] = ok ? *(const f32x4*)(src + (size_t)(4 * i) * ldsrc) : (f32x4){0.f, 0.f, 0.f, 0.f};
#pragma unroll
    for (int i = 0; i < 16; ++i) { LAS float* d = scr + (4 * i + rr) * 65 + 4 * q; d[0] = v[i].x; d[1] = v[i].y; d[2] = v[i].z; d[3] = v[i].w; }
    asm volatile("s_waitcnt lgkmcnt(0)" ::: "memory");
    const int c = lane & 7;
    const int drow0 = (mode == 1) ? ((n0 >> 7) * 256 + (n0 & 127) + row_off) : (row_off + n0);
#pragma unroll
    for (int j = 0; j < 8; ++j) { const int n = (lane >> 3) + 8 * j; const LAS float* s = scr + (8 * c) * 65 + n;
        u32x4 o; o.x = pk2(s[0 * 65], s[1 * 65]); o.y = pk2(s[2 * 65], s[3 * 65]); o.z = pk2(s[4 * 65], s[5 * 65]); o.w = pk2(s[6 * 65], s[7 * 65]);
        *(u32x4*)(WT + (size_t)(drow0 + n) * ldd + koff + k0 + 8 * c) = o; }
    asm volatile("s_waitcnt lgkmcnt(0)" ::: "memory");
}
DI void tr_job(const Frame& F, const float* W, int K, int ldsrc, int N, int Npad, bf16_t* WT, int ldd, int koff, int row_off, int mode) {
    LAS float* scr = (LAS float*)(F.lds + F.wave * 16640);
    const int nblk = Npad / 64, nitems = (K / 64) * nblk;
    for (int it = F.gw; it < nitems; it += F.NGW) tr_item(W, ldsrc, N, WT, ldd, koff, row_off, mode, nblk, scr, it, F.lane);
}

DI void rms_row_to_bf16(const float* xrow, const float* g, bf16_t* orow, int lane) {
    const f32x4* xr = (const f32x4*)xrow + lane; const f32x4* gr = (const f32x4*)g + lane;
    f32x4 v[8]; float s = 0.f;
#pragma unroll
    for (int j = 0; j < 8; ++j) { v[j] = xr[64 * j]; s += (v[j].x * v[j].x + v[j].y * v[j].y) + (v[j].z * v[j].z + v[j].w * v[j].w); }
    const float rstd = 1.0f / sqrtf(wave_sum(s) * (1.f / DM) + EPS);
    u32x2* o8 = (u32x2*)orow + lane;
#pragma unroll
    for (int j = 0; j < 8; ++j) { const f32x4 gg = gr[64 * j]; u32x2 w; w.x = pk2(v[j].x * rstd * gg.x, v[j].y * rstd * gg.y); w.y = pk2(v[j].z * rstd * gg.z, v[j].w * rstd * gg.w); o8[64 * j] = w; }
}
DI void rms_phase(const Frame& F, const float* x, const float* g, bf16_t* out) {
    for (int m = F.gw; m < MT; m += F.NGW) rms_row_to_bf16(x + (size_t)m * DM, g, out + (size_t)m * DM, F.lane);
}

DI void p0_prologue(const Frame& F, const Args& a) {
    unsigned char* ws = F.ws;
    tr_job(F, a.in[I_EWIN], 2048, EVEN_IN, EVEN_IN, EVEN_INP, (bf16_t*)(ws + WS_WIN0), 2048, 0, 0, 0);
    tr_job(F, a.in[I_EWQIDX], 512, 1024, 1024, 1024, (bf16_t*)(ws + WS_WQQ), 512, 0, 2048, 0);
    tr_job(F, a.in[I_EWOUT], 1024, 2048, 2048, 2048, (bf16_t*)(ws + WS_WOUT0), CAT0_K, 0, 0, 0);
    tr_job(F, a.in[I_EGATE], 2048, DFF, DFF, DFF, (bf16_t*)(ws + WS_WGU0), 2048, 0, 0, 1);
    tr_job(F, a.in[I_EUP], 2048, DFF, DFF, DFF, (bf16_t*)(ws + WS_WGU0), 2048, 0, 128, 1);
    tr_job(F, a.in[I_EDOWN], DFF, 2048, 2048, 2048, (bf16_t*)(ws + WS_WDN0), DFF, 0, 0, 0);
    tr_job(F, a.in[I_OWIN], 2048, ODD_IN, ODD_IN, ODD_IN, (bf16_t*)(ws + WS_WIN1), 2048, 0, 0, 0);
    tr_job(F, a.in[I_OWOUT], 2048, 2048, 2048, 2048, (bf16_t*)(ws + WS_WOUT1), 2048, 0, 0, 0);
    for (int e = 0; e < NEXP; ++e) {
        tr_job(F, a.in[I_OGATE] + (size_t)e * 2048 * DFFE, 2048, DFFE, DFFE, DFFE, (bf16_t*)(ws + WS_WGU1) + (size_t)e * 2 * DFFE * 2048, 2048, 0, 0, 1);
        tr_job(F, a.in[I_OUP] + (size_t)e * 2048 * DFFE, 2048, DFFE, DFFE, DFFE, (bf16_t*)(ws + WS_WGU1) + (size_t)e * 2 * DFFE * 2048, 2048, 0, 128, 1);
        tr_job(F, a.in[I_ODOWN] + (size_t)e * DFFE * 2048, DFFE, 2048, 2048, 2048, (bf16_t*)(ws + WS_WDN1) + (size_t)e * 2048 * DFFE, DFFE, 0, 0, 0);
    }
    const int gt = F.bid * 512 + F.tid, NT = F.G * 512;
    { const float* uq = a.in[I_EWUQ]; const float* uk = a.in[I_EWUK]; bf16_t* o = (bf16_t*)(ws + WS_WQQ);
      for (int i = gt; i < 2048 * 512; i += NT) { const int n = i >> 9, r = i & 511, h = n >> 8, c = n & 255;
          const f32x4* pa = (const f32x4*)(uq + (size_t)r * 1024 + h * 128); const f32x4* pb = (const f32x4*)(uk + (size_t)c * 1024 + h * 128); float s = 0.f;
#pragma unroll 8
          for (int d = 0; d < 32; ++d) { const f32x4 x = pa[d], y = pb[d]; s += (x.x * y.x + x.y * y.y) + (x.z * y.z + x.w * y.w); }
          o[i] = (bf16_t)(pk2(s, 0.f) & 0xffffu); } }
    { const float* uv = a.in[I_EWUV]; const float* wo = a.in[I_EWOUT]; bf16_t* o = (bf16_t*)(ws + WS_WOUT0);
      for (int i = gt; i < 2048 * 2048; i += NT) { const int n = i >> 11, hc = i & 2047, h = hc >> 8, c = hc & 255;
          const f32x4* pa = (const f32x4*)(uv + (size_t)c * 1024 + h * 128); const float* pb = wo + (size_t)(1024 + h * 128) * 2048 + n; float s = 0.f;
#pragma unroll 4
          for (int d = 0; d < 32; ++d) { const f32x4 x = pa[d]; s += (x.x * pb[(size_t)(4 * d) * 2048] + x.y * pb[(size_t)(4 * d + 1) * 2048]) + (x.z * pb[(size_t)(4 * d + 2) * 2048] + x.w * pb[(size_t)(4 * d + 3) * 2048]); }
          o[(size_t)n * CAT0_K + 1024 + hc] = (bf16_t)(pk2(s, 0.f) & 0xffffu); } }
    { const float* w = a.in[I_OWS]; bf16_t* o = (bf16_t*)(ws + WS_WS);
      for (int i = gt; i < 8 * 128 * 128; i += NT) { const int t = (i >> 7) & 127, s = i & 127; o[i] = (bf16_t)(pk2(s <= t ? w[i] : 0.f, 0.f) & 0xffffu); } }
    rms_phase(F, a.in[I_X], a.in[I_ENMIX], (bf16_t*)(ws + WS_H0));
}

DI void p2_rows(const Frame& F, const Args& a) {
    const bf16_t* proj = (const bf16_t*)(F.ws + WS_PROJ0);
    bf16_t* cqn = (bf16_t*)(F.ws + WS_CQN); bf16_t* ckv = (bf16_t*)(F.ws + WS_CKV); bf16_t* kx = (bf16_t*)(F.ws + WS_KX); float* widx = (float*)(F.ws + WS_WIDX);
    bf16_t* cat = (bf16_t*)(F.ws + WS_CAT0);
    const float* gcq = a.in[I_ENCQ]; const float* gckv = a.in[I_ENCKV]; const float* cw = a.in[I_ECONV];
    const int lane = F.lane;
    float w0[2][8], w1[2][8], w2[2][8];
#pragma unroll
    for (int j = 0; j < 2; ++j)
#pragma unroll
        for (int e = 0; e < 8; ++e) { const int c = 512 * j + 8 * lane + e; w0[j][e] = cw[c]; w1[j][e] = cw[1024 + c]; w2[j][e] = cw[2048 + c]; }
    float gq[8], gk[8];
#pragma unroll
    for (int e = 0; e < 8; ++e) { gq[e] = gcq[8 * lane + e]; gk[e] = gckv[8 * (lane & 31) + e]; }
    for (int m = F.gw; m < MT; m += F.NGW) {
        const bf16_t* row = proj + (size_t)m * EVEN_INP;
        const int s = m & (SEQ - 1);
        { const u32x4 v = *(const u32x4*)(row + 3072 + 8 * lane); float f[8] = {bflo(v.x), bfhi(v.x), bflo(v.y), bfhi(v.y), bflo(v.z), bfhi(v.z), bflo(v.w), bfhi(v.w)}; float ss = 0.f;
#pragma unroll
          for (int e = 0; e < 8; ++e) ss += f[e] * f[e];
          const float rstd = 1.0f / sqrtf(wave_sum(ss) * (1.f / 512.f) + EPS);
          u32x4 o; o.x = pk2(f[0] * rstd * gq[0], f[1] * rstd * gq[1]); o.y = pk2(f[2] * rstd * gq[2], f[3] * rstd * gq[3]); o.z = pk2(f[4] * rstd * gq[4], f[5] * rstd * gq[5]); o.w = pk2(f[6] * rstd * gq[6], f[7] * rstd * gq[7]);
          *(u32x4*)(cqn + (size_t)m * 512 + 8 * lane) = o; }
        { const u32x4 v = *(const u32x4*)(row + 3584 + 8 * (lane & 31)); float f[8] = {bflo(v.x), bfhi(v.x), bflo(v.y), bfhi(v.y), bflo(v.z), bfhi(v.z), bflo(v.w), bfhi(v.w)}; float ss = 0.f;
#pragma unroll
          for (int e = 0; e < 8; ++e) ss += f[e] * f[e];
          const float rstd = 1.0f / sqrtf(wave_sum(ss) * (0.5f / 256.f) + EPS);
          u32x4 o; o.x = pk2(f[0] * rstd * gk[0], f[1] * rstd * gk[1]); o.y = pk2(f[2] * rstd * gk[2], f[3] * rstd * gk[3]); o.z = pk2(f[4] * rstd * gk[4], f[5] * rstd * gk[5]); o.w = pk2(f[6] * rstd * gk[6], f[7] * rstd * gk[7]);
          if (lane < 32) *(u32x4*)(ckv + (size_t)m * 256 + 8 * lane) = o; }
        if (lane < 8) *(u32x4*)(kx + (size_t)m * 64 + 8 * lane) = *(const u32x4*)(row + 3840 + 8 * lane);
        if (lane < 16) widx[(size_t)m * 16 + lane] = bf2f(row[3904 + lane]) * (0.125f * 0.25f);
#pragma unroll
        for (int j = 0; j < 2; ++j) { const int c0 = 512 * j + 8 * lane; float acc[8];
            { const u32x4 vc = *(const u32x4*)(row + 1024 + c0), vx = *(const u32x4*)(row + 2048 + c0);
              const float fc[8] = {bflo(vc.x), bfhi(vc.x), bflo(vc.y), bfhi(vc.y), bflo(vc.z), bfhi(vc.z), bflo(vc.w), bfhi(vc.w)}, fx[8] = {bflo(vx.x), bfhi(vx.x), bflo(vx.y), bfhi(vx.y), bflo(vx.z), bfhi(vx.z), bflo(vx.w), bfhi(vx.w)};
#pragma unroll
              for (int e = 0; e < 8; ++e) acc[e] = w2[j][e] * (fc[e] * fx[e]); }
            if (s >= 1) { const bf16_t* r1 = row - EVEN_INP; const u32x4 vc = *(const u32x4*)(r1 + 1024 + c0), vx = *(const u32x4*)(r1 + 2048 + c0);
              const float fc[8] = {bflo(vc.x), bfhi(vc.x), bflo(vc.y), bfhi(vc.y), bflo(vc.z), bfhi(vc.z), bflo(vc.w), bfhi(vc.w)}, fx[8] = {bflo(vx.x), bfhi(vx.x), bflo(vx.y), bfhi(vx.y), bflo(vx.z), bfhi(vx.z), bflo(vx.w), bfhi(vx.w)};
#pragma unroll
              for (int e = 0; e < 8; ++e) acc[e] += w1[j][e] * (fc[e] * fx[e]); }
            if (s >= 2) { const bf16_t* r2 = row - 2 * EVEN_INP; const u32x4 vc = *(const u32x4*)(r2 + 1024 + c0), vx = *(const u32x4*)(r2 + 2048 + c0);
              const float fc[8] = {bflo(vc.x), bfhi(vc.x), bflo(vc.y), bfhi(vc.y), bflo(vc.z), bfhi(vc.z), bflo(vc.w), bfhi(vc.w)}, fx[8] = {bflo(vx.x), bfhi(vx.x), bflo(vx.y), bfhi(vx.y), bflo(vx.z), bfhi(vx.z), bflo(vx.w), bfhi(vx.w)};
#pragma unroll
              for (int e = 0; e < 8; ++e) acc[e] += w0[j][e] * (fc[e] * fx[e]); }
            const u32x4 vb = *(const u32x4*)(row + c0); const float fb[8] = {bflo(vb.x), bfhi(vb.x), bflo(vb.y), bfhi(vb.y), bflo(vb.z), bfhi(vb.z), bflo(vb.w), bfhi(vb.w)};
            u32x4 o; o.x = pk2(fb[0] * acc[0], fb[1] * acc[1]); o.y = pk2(fb[2] * acc[2], fb[3] * acc[3]); o.z = pk2(fb[4] * acc[4], fb[5] * acc[5]); o.w = pk2(fb[6] * acc[6], fb[7] * acc[7]);
            *(u32x4*)(cat + (size_t)m * CAT0_K + c0) = o; }
    }
}

DI unsigned kx_lds_off(int key_local, int ch) { const int R = key_local >> 1, C = ((key_local & 1) << 3) | ch; return (unsigned)(R * 256 + ((C ^ (R & 15)) << 4)); }
DI void p4_indexer(const Frame& F) {
    const bf16_t* qq = (const bf16_t*)(F.ws + WS_QQ); const bf16_t* kx = (const bf16_t*)(F.ws + WS_KX); const float* widx = (const float*)(F.ws + WS_WIDX);
    _Float16* sc = (_Float16*)(F.ws + WS_SC);
    const int lane = F.lane, r = lane & 31, h = lane >> 5, w = F.wave, tid = F.tid;
    LAS unsigned char* kb = F.lds;
    const unsigned st_off = kx_lds_off(tid >> 3, tid & 7);
    unsigned rd_off[4];
#pragma unroll
    for (int s = 0; s < 4; ++s) rd_off[s] = kx_lds_off(r, 2 * s + h);
    const int nunits = NB * (SEQ / 16);
    for (int rd = 0; rd * F.G < nunits; ++rd) {
        const int j = (rd & 1) ? (F.G - 1 - F.bid) : F.bid; const int u = rd * F.G + j; if (u >= nunits) continue;
        const int qg = (SEQ / 16 - 1) - u / NB, b = u % NB;
        const int t0 = qg * 16, t1 = ((t0 >> 7) + 1) << 7;
        const int tq = t0 + 2 * w + (r >> 4), g = r & 15;
        bf16x8 aq[4];
#pragma unroll
        for (int s = 0; s < 4; ++s) aq[s] = *(const bf16x8*)(qq + (size_t)(b * SEQ + tq) * QQ_N + 2048 + g * 64 + 16 * s + 8 * h);
        float wts[16];
#pragma unroll
        for (int i = 0; i < 16; ++i) wts[i] = widx[(size_t)(b * SEQ + t0 + 2 * w + (i >> 3)) * 16 + ((i & 3) + 8 * ((i >> 2) & 1) + 4 * h)];
        const int tme = t0 + 2 * w + h;
        unsigned kv[64];
#pragma unroll
        for (int c = 0; c < 4; ++c) {
            if (512 * c < t1) {
                __syncthreads();
                { const bf16_t* src = kx + (size_t)(b * SEQ + 512 * c) * 64 + tid * 8;
#pragma unroll
                  for (int i = 0; i < 8; ++i) if (512 * c + 64 * i < t1) *(LAS u32x4*)(kb + st_off + 8192 * i) = *(const u32x4*)(src + 4096 * i); }
                __syncthreads();
            }
#pragma unroll
            for (int q = 0; q < 4; ++q) {
                if (512 * c + 128 * q < t1) {
#pragma unroll
                    for (int jj = 0; jj < 4; ++jj) { const int jn = 4 * q + jj, n = 16 * c + jn;
                        f32x16 acc;
#pragma unroll
                        for (int i = 0; i < 16; ++i) acc[i] = 0.f;
#pragma unroll
                        for (int s = 0; s < 4; ++s) { const bf16x8 bk = *(const LAS bf16x8*)(kb + rd_off[s] + 4096 * jn); acc = __builtin_amdgcn_mfma_f32_32x32x16_bf16(aq[s], bk, acc, 0, 0, 0); }
                        float p0 = 0.f, p1 = 0.f;
#pragma unroll
                        for (int i = 0; i < 8; ++i) { p0 += wts[i] * fmaxf(acc[i], 0.f); p1 += wts[8 + i] * fmaxf(acc[8 + i], 0.f); }
                        const float mine = h ? p1 : p0, send = h ? p0 : p1;
                        float tot = mine + __shfl_xor(send, 32);
                        if (32 * n + r > tme) tot = -__builtin_inff();
                        const unsigned ub = __builtin_bit_cast(unsigned, tot);
                        kv[n] = (ub & 0x80000000u) ? ~ub : (ub | 0x80000000u);
                        __builtin_amdgcn_sched_barrier(0);
                    }
                } else {
#pragma unroll
                    for (int jj = 0; jj < 4; ++jj) kv[16 * c + 4 * q + jj] = 0u;
                }
            }
        }
        unsigned T = 0u;
        if (t1 > 256) {
            for (int bit = 31; bit >= 0; --bit) { const unsigned cand = T | (1u << bit); int cnt = 0;
#pragma unroll
                for (int n = 0; n < 64; ++n) cnt += (kv[n] >= cand) ? 1 : 0;
                cnt += __shfl_xor(cnt, 1); cnt += __shfl_xor(cnt, 2); cnt += __shfl_xor(cnt, 4); cnt += __shfl_xor(cnt, 8); cnt += __shfl_xor(cnt, 16);
                T = (cnt >= 256) ? cand : T; }
        }
        _Float16* orow = sc + (size_t)(b * SEQ + tme) * SEQ;
#pragma unroll
        for (int q = 0; q < 16; ++q) if (128 * q < t1) {
#pragma unroll
            for (int jj = 0; jj < 4; ++jj) { const int n = 4 * q + jj; const unsigned k = kv[n]; const bool sel = (k >= T) && (k > 0x007fffffu);
                const unsigned ub = (k & 0x80000000u) ? (k ^ 0x80000000u) : ~k; const float v = sel ? __builtin_bit_cast(float, ub) : -__builtin_inff();
                orow[32 * n + r] = (_Float16)v; } }
    }
    __syncthreads();
}

DI unsigned kv_off(int row, int ch) { return (unsigned)(512 * row + 16 * (ch ^ (((row & 3) << 2) | ((row >> 2) & 3)))); }
DI s16x4 tr_read4(const LAS unsigned char* p) { return __builtin_amdgcn_ds_read_tr16_b64_v4i16((LAS s16x4*)p); }
DI bf16x8 cat8(s16x4 a, s16x4 b) { bf16x8 v; v[0] = a[0]; v[1] = a[1]; v[2] = a[2]; v[3] = a[3]; v[4] = b[0]; v[5] = b[1]; v[6] = b[2]; v[7] = b[3]; return v; }
DI bf16x8 pack8(float a0, float a1, float a2, float a3, float a4, float a5, float a6, float a7) { u32x4 w; w.x = pk2(a0, a1); w.y = pk2(a2, a3); w.z = pk2(a4, a5); w.w = pk2(a6, a7); return __builtin_bit_cast(bf16x8, w); }
DI void p5_dsa(const Frame& F, const Args& a) {
    const bf16_t* qq = (const bf16_t*)(F.ws + WS_QQ); const bf16_t* ckv = (const bf16_t*)(F.ws + WS_CKV); const _Float16* sc = (const _Float16*)(F.ws + WS_SC);
    bf16_t* cat = (bf16_t*)(F.ws + WS_CAT0);
    const int lane = F.lane, r = lane & 31, h = lane >> 5, tid = F.tid, dh = F.wave & 1;
    const int q4 = (lane & 15) >> 2, p4 = lane & 3, blk = (lane >> 4) & 1;
    LAS unsigned char* kvb = F.lds;
    LAS unsigned char* scb = F.lds + 32768;
    LAS float* lut = (LAS float*)(F.lds + 40960);
    __syncthreads();
    for (int i = tid; i < 8 * 129; i += 512) { const int hd = i / 129, d = i % 129; int bk = d;
        if (d >= 16) { bk = 16 + (int)(logf((float)d / 16.0f) / 2.0794415416798357f * 16.0f); bk = bk > 31 ? 31 : bk; }
        lut[hd * 132 + d] = a.in[I_RELB][bk * 8 + hd] * 1.44269504f; }
    __syncthreads();
    const float SC2 = 0.08838834764831845f * 1.44269504f;
    const int nunits = NB * (SEQ / 32) * 2;
    for (int rd = 0; rd * F.G < nunits; ++rd) {
        const int j = (rd & 1) ? (F.G - 1 - F.bid) : F.bid; const int u = rd * F.G + j; if (u >= nunits) continue;
        const int hg = u & 1, u2 = u >> 1, head = 4 * hg + (F.wave >> 1);
        const int qt = (SEQ / 32 - 1) - u2 / NB, b = u2 % NB, q0 = qt * 32, nkt = qt + 1, tq = q0 + r;
        bf16x8 qf[16];
#pragma unroll
        for (int s = 0; s < 16; ++s) qf[s] = *(const bf16x8*)(qq + (size_t)(b * SEQ + tq) * QQ_N + head * 256 + 16 * s + 8 * h);
        f32x16 O[4];
#pragma unroll
        for (int c = 0; c < 4; ++c)
#pragma unroll
            for (int i = 0; i < 16; ++i) O[c][i] = 0.f;
        float m_run = -__builtin_inff(), l_run = 0.f;
        u32x4 st0, st1; u32x2 st2 = {0u, 0u};
        const int skey0 = tid >> 5, sch = tid & 31, sq = tid >> 3, spc = tid & 7;
#define DSA_LOAD(kt) do { const bf16_t* src = ckv + (size_t)(b * SEQ + 32 * (kt)) * 256; st0 = *(const u32x4*)(src + (size_t)skey0 * 256 + 8 * sch); st1 = *(const u32x4*)(src + (size_t)(skey0 + 16) * 256 + 8 * sch); \
        if (tid < 256) st2 = *(const u32x2*)(sc + (size_t)(b * SEQ + q0 + sq) * SEQ + 32 * (kt) + 4 * spc); } while (0)
#define DSA_WRITE(bufi) do { LAS unsigned char* kd_ = kvb + (bufi) * 16384; *(LAS u32x4*)(kd_ + kv_off(skey0, sch)) = st0; *(LAS u32x4*)(kd_ + kv_off(skey0 + 16, sch)) = st1; \
        if (tid < 256) *(LAS u32x2*)(scb + (bufi) * 2304 + sq * 72 + spc * 8) = st2; } while (0)
        __syncthreads();
        DSA_LOAD(0); DSA_WRITE(0);
        __syncthreads();
        for (int kt = 0; kt < nkt; ++kt) {
            const int cur = kt & 1;
            if (kt + 1 < nkt) DSA_LOAD(kt + 1);
            const LAS unsigned char* kd = kvb + cur * 16384; const LAS unsigned char* sd = scb + cur * 2304;
            f32x16 S;
#pragma unroll
            for (int i = 0; i < 16; ++i) S[i] = 0.f;
#pragma unroll
            for (int s = 0; s < 16; ++s) { const bf16x8 kf = *(const LAS bf16x8*)(kd + kv_off(r, 2 * s + h)); S = __builtin_amdgcn_mfma_f32_32x32x16_bf16(kf, qf[s], S, 0, 0, 0); if ((s & 3) == 3) __builtin_amdgcn_sched_barrier(0); }
            float mx = -__builtin_inff();
#pragma unroll
            for (int gq = 0; gq < 4; ++gq) { const u32x2 iw = *(const LAS u32x2*)(sd + r * 72 + (2 * gq + h) * 8);
                const _Float16 h0 = __builtin_bit_cast(_Float16, (unsigned short)(iw.x & 0xffffu)), h1 = __builtin_bit_cast(_Float16, (unsigned short)(iw.x >> 16)), h2 = __builtin_bit_cast(_Float16, (unsigned short)(iw.y & 0xffffu)), h3 = __builtin_bit_cast(_Float16, (unsigned short)(iw.y >> 16));
                const float idx[4] = {(float)h0, (float)h1, (float)h2, (float)h3};
#pragma unroll
                for (int e = 0; e < 4; ++e) { const int i = 4 * gq + e, key = 32 * kt + 8 * gq + 4 * h + e; int dist = tq - key; dist = dist < 0 ? 0 : (dist > 128 ? 128 : dist);
                    const float x = S[i] * SC2 + lut[head * 132 + dist] + idx[e] * 1.44269504f; S[i] = x; mx = fmaxf(mx, x); } }
            mx = fmaxf(mx, __shfl_xor(mx, 32));
            const float m_new = fmaxf(m_run, mx), msafe = (m_new == -__builtin_inff()) ? 0.f : m_new, alpha = fast_exp2(m_run - msafe);
            float rs = 0.f;
#pragma unroll
            for (int i = 0; i < 16; ++i) { S[i] = fast_exp2(S[i] - msafe); rs += S[i]; }
            rs += __shfl_xor(rs, 32);
            l_run = l_run * alpha + rs; m_run = m_new;
#pragma unroll
            for (int c = 0; c < 4; ++c)
#pragma unroll
                for (int i = 0; i < 16; ++i) O[c][i] *= alpha;
            const bf16x8 pf0 = pack8(S[0], S[1], S[2], S[3], S[4], S[5], S[6], S[7]), pf1 = pack8(S[8], S[9], S[10], S[11], S[12], S[13], S[14], S[15]);
#pragma unroll
            for (int c = 0; c < 4; ++c) {
                const int chn = 4 * (4 * dh + c) + 2 * blk + (p4 >> 1), bo = 8 * (p4 & 1);
                const bf16x8 v0 = cat8(tr_read4(kd + kv_off(0 + 4 * h + q4, chn) + bo), tr_read4(kd + kv_off(8 + 4 * h + q4, chn) + bo));
                const bf16x8 v1 = cat8(tr_read4(kd + kv_off(16 + 4 * h + q4, chn) + bo), tr_read4(kd + kv_off(24 + 4 * h + q4, chn) + bo));
                O[c] = __builtin_amdgcn_mfma_f32_32x32x16_bf16(v0, pf0, O[c], 0, 0, 0);
                O[c] = __builtin_amdgcn_mfma_f32_32x32x16_bf16(v1, pf1, O[c], 0, 0, 0);
                __builtin_amdgcn_sched_barrier(0);
            }
            if (kt + 1 < nkt) DSA_WRITE(cur ^ 1);
            __syncthreads();
        }
#undef DSA_LOAD
#undef DSA_WRITE
        const float inv = 1.0f / l_run;
        bf16_t* orow = cat + (size_t)(b * SEQ + tq) * CAT0_K + 1024 + head * 256 + 128 * dh;
#pragma unroll
        for (int c = 0; c < 4; ++c)
#pragma unroll
            for (int gq = 0; gq < 4; ++gq) { u32x2 w; w.x = pk2(O[c][4 * gq] * inv, O[c][4 * gq + 1] * inv); w.y = pk2(O[c][4 * gq + 2] * inv, O[c][4 * gq + 3] * inv);
                *(u32x2*)(orow + 32 * c + 8 * gq + 4 * h) = w; }
    }
    __syncthreads();
}

DI unsigned img_off(int row, int ch) { return (unsigned)(256 * row + 16 * (ch ^ (((row & 3) << 2) | ((row >> 2) & 3)))); }
DI void p12_gmlp(const Frame& F, const Args& a) {
    const bf16_t* proj = (const bf16_t*)(F.ws + WS_PROJ1); const bf16_t* wsm = (const bf16_t*)(F.ws + WS_WS); bf16_t* cat = (bf16_t*)(F.ws + WS_CAT1);
    const float* gv = a.in[I_ONV]; const float* bs = a.in[I_OBS];
    const int lane = F.lane, r = lane & 31, h = lane >> 5, w = F.wave, tid = F.tid;
    const int q4 = (lane & 15) >> 2, p4 = lane & 3, blk = (lane >> 4) & 1;
    LAS unsigned char* img = F.lds;
    LAS float* rs = (LAS float*)(F.lds + 32768);
    for (int u = F.bid; u < NB * (SEQ / 128); u += F.G) {
        const int b = u / (SEQ / 128), ch0 = u % (SEQ / 128); const size_t row0 = (size_t)b * SEQ + (size_t)ch0 * 128;
        __syncthreads();
        for (int i = 0; i < 16; ++i) { const int s = 16 * w + i; const bf16_t* vr = proj + (row0 + s) * ODD_IN + 1024; float ss = 0.f;
#pragma unroll
            for (int jj = 0; jj < 2; ++jj) { const u32x4 v = *(const u32x4*)(vr + 512 * jj + 8 * lane); const float f[8] = {bflo(v.x), bfhi(v.x), bflo(v.y), bfhi(v.y), bflo(v.z), bfhi(v.z), bflo(v.w), bfhi(v.w)};
#pragma unroll
                for (int e = 0; e < 8; ++e) ss += f[e] * f[e]; }
            ss = wave_sum(ss); if (lane == 0) rs[s] = 1.0f / sqrtf(ss * (1.f / 1024.f) + EPS); }
        __syncthreads();
        for (int g = 0; g < 8; ++g) {
#pragma unroll
            for (int i = 0; i < 4; ++i) { const int p = tid + 512 * i, s = p >> 4, chk = p & 15;
                const u32x4 v = *(const u32x4*)(proj + (row0 + s) * ODD_IN + 1024 + g * 128 + 8 * chk); const float rr = rs[s];
                const f32x4 g0 = *(const f32x4*)(gv + g * 128 + 8 * chk), g1 = *(const f32x4*)(gv + g * 128 + 8 * chk + 4);
                u32x4 o; o.x = pk2(bflo(v.x) * rr * g0.x, bfhi(v.x) * rr * g0.y); o.y = pk2(bflo(v.y) * rr * g0.z, bfhi(v.y) * rr * g0.w); o.z = pk2(bflo(v.z) * rr * g1.x, bfhi(v.z) * rr * g1.y); o.w = pk2(bflo(v.w) * rr * g1.z, bfhi(v.w) * rr * g1.w);
                *(LAS u32x4*)(img + (s >> 5) * 8192 + img_off(s & 31, chk)) = o; }
            __syncthreads();
            const int tb = w & 3, t = 32 * tb + r;
#pragma unroll
            for (int cc = 0; cc < 2; ++cc) { const int cb = 2 * (w >> 2) + cc;
                f32x16 D;
#pragma unroll
                for (int i = 0; i < 16; ++i) D[i] = 0.f;
                for (int ks = 0; ks <= 2 * tb + 1; ++ks) {
                    const LAS unsigned char* im = img + (ks >> 1) * 8192; const int k2 = ks & 1;
                    const int chn = 4 * cb + 2 * blk + (p4 >> 1), bo = 8 * (p4 & 1);
                    const bf16x8 af = cat8(tr_read4(im + img_off(16 * k2 + 8 * h + 0 + q4, chn) + bo), tr_read4(im + img_off(16 * k2 + 8 * h + 4 + q4, chn) + bo));
                    const bf16x8 bf = *(const bf16x8*)(wsm + (size_t)g * 16384 + (size_t)t * 128 + 16 * ks + 8 * h);
                    D = __builtin_amdgcn_mfma_f32_32x32x16_bf16(af, bf, D, 0, 0, 0);
                }
                const float bias = bs[g * 128 + t];
                const bf16_t* urow = proj + (row0 + t) * ODD_IN + g * 128 + 32 * cb; bf16_t* orow = cat + (row0 + t) * 2048 + g * 128 + 32 * cb;
#pragma unroll
                for (int gq = 0; gq < 4; ++gq) { const u32x2 uu = *(const u32x2*)(urow + 8 * gq + 4 * h);
                    u32x2 o; o.x = pk2(bflo(uu.x) * (D[4 * gq] + bias), bfhi(uu.x) * (D[4 * gq + 1] + bias)); o.y = pk2(bflo(uu.y) * (D[4 * gq + 2] + bias), bfhi(uu.y) * (D[4 * gq + 3] + bias));
                    *(u32x2*)(orow + 8 * gq + 4 * h) = o; }
            }
            __syncthreads();
        }
    }
    __syncthreads();
}

DI void p12_stick(const Frame& F) {
    const bf16_t* proj = (const bf16_t*)(F.ws + WS_PROJ1); bf16_t* cat = (bf16_t*)(F.ws + WS_CAT1);
    const int lane = F.lane, r = lane & 31, h = lane >> 5, w = F.wave, tid = F.tid;
    const int q4 = (lane & 15) >> 2, p4 = lane & 3, blk = (lane >> 4) & 1;
    LAS unsigned char* kb = F.lds;
    LAS unsigned char* vb = F.lds + 16384;
    const float SC2 = 0.08838834764831845f * 1.44269504f;
    const int nunits = NB * 8 * (SEQ / 256);
    for (int rd = 0; rd * F.G < nunits; ++rd) {
        const int j = (rd & 1) ? (F.G - 1 - F.bid) : F.bid; const int u = rd * F.G + j; if (u >= nunits) continue;
        const int qb = (SEQ / 256 - 1) - u / (NB * 8), bh = u % (NB * 8), b = bh >> 3, head = bh & 7;
        const int Q0 = qb * 256, tq = Q0 + 32 * w + r, ktd = (Q0 >> 5) + w, kt_hi = (Q0 >> 5) + 7;
        const bf16_t* base = proj + (size_t)b * SEQ * ODD_IN + head * 128;
        bf16x8 qf[8];
#pragma unroll
        for (int s = 0; s < 8; ++s) qf[s] = *(const bf16x8*)(base + (size_t)tq * ODD_IN + 2048 + 16 * s + 8 * h);
        f32x16 O[4];
#pragma unroll
        for (int c = 0; c < 4; ++c)
#pragma unroll
            for (int i = 0; i < 16; ++i) O[c][i] = 0.f;
        float R = 0.f;
        u32x4 st0, st1; const int skey = tid >> 4, sch = tid & 15;
#define SB_LOAD(kt) do { const bf16_t* src = base + (size_t)(32 * (kt) + skey) * ODD_IN + 8 * sch; st0 = *(const u32x4*)(src + 3072); st1 = *(const u32x4*)(src + 4096); } while (0)
#define SB_WRITE(bufi) do { *(LAS u32x4*)(kb + (bufi) * 8192 + img_off(skey, sch)) = st0; *(LAS u32x4*)(vb + (bufi) * 8192 + img_off(skey, sch)) = st1; } while (0)
        __syncthreads();
        SB_LOAD(kt_hi); SB_WRITE(0);
        __syncthreads();
        int cur = 0;
        for (int kt = kt_hi; kt >= 0; --kt) {
            if (kt > 0) SB_LOAD(kt - 1);
            if (kt <= ktd) {
                const LAS unsigned char* kd = kb + cur * 8192; const LAS unsigned char* vd = vb + cur * 8192;
                f32x16 S;
#pragma unroll
                for (int i = 0; i < 16; ++i) S[i] = 0.f;
#pragma unroll
                for (int s = 0; s < 8; ++s) { const bf16x8 kf = *(const LAS bf16x8*)(kd + img_off(r, 2 * s + h)); S = __builtin_amdgcn_mfma_f32_32x32x16_bf16(kf, qf[s], S, 0, 0, 0); }
                float lk[16], G[4];
#pragma unroll
                for (int gq = 0; gq < 4; ++gq) { G[gq] = 0.f;
#pragma unroll
                    for (int e = 0; e < 4; ++e) { const int i = 4 * gq + e, key = 32 * kt + 8 * gq + 4 * h + e; const bool past = key < tq;
                        const float z = S[i] * SC2, az = fabsf(z), sp = fmaxf(z, 0.f) + fast_log2(1.0f + fast_exp2(-az));
                        lk[i] = past ? -sp : 0.f; S[i] = past ? (z - sp) : -__builtin_inff(); G[gq] += lk[i]; } }
                float PG[4];
#pragma unroll
                for (int gq = 0; gq < 4; ++gq) PG[gq] = __shfl_xor(G[gq], 32);
                float hi = 0.f;
                float wv[16];
#pragma unroll
                for (int gq = 3; gq >= 0; --gq) { const float above = hi + (h ? 0.f : PG[gq]);
                    float run = R + above;
#pragma unroll
                    for (int e = 3; e >= 0; --e) { const int i = 4 * gq + e; wv[i] = fast_exp2(S[i] + run); run += lk[i]; }
                    hi += G[gq] + PG[gq]; }
                R += hi;
                const bf16x8 pf0 = pack8(wv[0], wv[1], wv[2], wv[3], wv[4], wv[5], wv[6], wv[7]), pf1 = pack8(wv[8], wv[9], wv[10], wv[11], wv[12], wv[13], wv[14], wv[15]);
#pragma unroll
                for (int c = 0; c < 4; ++c) {
                    const int chn = 4 * c + 2 * blk + (p4 >> 1), bo = 8 * (p4 & 1);
                    const bf16x8 v0 = cat8(tr_read4(vd + img_off(0 + 4 * h + q4, chn) + bo), tr_read4(vd + img_off(8 + 4 * h + q4, chn) + bo));
                    const bf16x8 v1 = cat8(tr_read4(vd + img_off(16 + 4 * h + q4, chn) + bo), tr_read4(vd + img_off(24 + 4 * h + q4, chn) + bo));
                    O[c] = __builtin_amdgcn_mfma_f32_32x32x16_bf16(v0, pf0, O[c], 0, 0, 0);
                    O[c] = __builtin_amdgcn_mfma_f32_32x32x16_bf16(v1, pf1, O[c], 0, 0, 0);
                }
            }
            if (kt > 0) SB_WRITE(cur ^ 1);
            __syncthreads();
            cur ^= 1;
        }
#undef SB_LOAD
#undef SB_WRITE
        bf16_t* orow = cat + (size_t)(b * SEQ + tq) * 2048 + 1024 + head * 128;
#pragma unroll
        for (int c = 0; c < 4; ++c)
#pragma unroll
            for (int gq = 0; gq < 4; ++gq) { u32x2 o; o.x = pk2(O[c][4 * gq], O[c][4 * gq + 1]); o.y = pk2(O[c][4 * gq + 2], O[c][4 * gq + 3]);
                *(u32x2*)(orow + 32 * c + 8 * gq + 4 * h) = o; }
    }
    __syncthreads();
}

DI void p14_router(const Frame& F, const Args& a, const float* x3) {
    bf16_t* h3 = (bf16_t*)(F.ws + WS_H3); const float* gn = a.in[I_ONFFN]; const float* wr = a.in[I_OROUTER];
    int* tab_er = (int*)(F.ws + WS_TAB + TAB_ER); float* tab_gate = (float*)(F.ws + WS_TAB + TAB_GATE); unsigned* gcnt = (unsigned*)(F.ws + WS_CTL) + CW_CNT;
    const int lane = F.lane, w = F.wave, tid = F.tid;
    LAS float* wrT = (LAS float*)F.lds;
    LAS int* lcnt = (LAS int*)(F.lds + 65536);
    LAS int* lbase = lcnt + 8;
    LAS int* tokE = lcnt + 16;
    LAS int* tokR = tokE + 256;
    __syncthreads();
    for (int i = tid; i < 2048 * 8; i += 512) wrT[(i & 7) * 2048 + (i >> 3)] = wr[i];
    if (tid < 8) lcnt[tid] = 0;
    __syncthreads();
    for (int grp = F.bid; grp < MT / 128; grp += F.G) {
        for (int i = 0; i < 16; ++i) {
            const int tl = 16 * w + i, m = grp * 128 + tl;
            const f32x4* xr = (const f32x4*)(x3 + (size_t)m * DM) + lane; const f32x4* gr = (const f32x4*)gn + lane;
            f32x4 v[8]; float s = 0.f;
#pragma unroll
            for (int j = 0; j < 8; ++j) { v[j] = xr[64 * j]; s += (v[j].x * v[j].x + v[j].y * v[j].y) + (v[j].z * v[j].z + v[j].w * v[j].w); }
            const float rstd = 1.0f / sqrtf(wave_sum(s) * (1.f / DM) + EPS);
            u32x2* o8 = (u32x2*)(h3 + (size_t)m * DM) + lane;
#pragma unroll
            for (int j = 0; j < 8; ++j) { const f32x4 gg = gr[64 * j]; v[j].x *= rstd * gg.x; v[j].y *= rstd * gg.y; v[j].z *= rstd * gg.z; v[j].w *= rstd * gg.w;
                u32x2 ww; ww.x = pk2(v[j].x, v[j].y); ww.y = pk2(v[j].z, v[j].w); o8[64 * j] = ww; }
            float lg[8];
#pragma unroll
            for (int e = 0; e < 8; ++e) { float acc = 0.f;
#pragma unroll
                for (int j = 0; j < 8; ++j) { const f32x4 ww = *(const LAS f32x4*)(wrT + e * 2048 + 4 * (lane + 64 * j)); acc += (v[j].x * ww.x + v[j].y * ww.y) + (v[j].z * ww.z + v[j].w * ww.w); }
                lg[e] = wave_sum(acc); }
            int i1 = 0; float v1 = lg[0];
#pragma unroll
            for (int e = 1; e < 8; ++e) if (lg[e] > v1) { v1 = lg[e]; i1 = e; }
            int i2 = -1; float v2 = -__builtin_inff();
#pragma unroll
            for (int e = 0; e < 8; ++e) if (e != i1 && lg[e] > v2) { v2 = lg[e]; i2 = e; }
            if (lane == 0) {
                const float g1 = 1.0f / (1.0f + __expf(v2 - v1));
                tab_gate[(size_t)m * 2] = g1; tab_gate[(size_t)m * 2 + 1] = 1.0f - g1;
                tokE[tl * 2] = i1; tokE[tl * 2 + 1] = i2;
                tokR[tl * 2] = __hip_atomic_fetch_add(lcnt + i1, 1, __ATOMIC_RELAXED, __HIP_MEMORY_SCOPE_WORKGROUP);
                tokR[tl * 2 + 1] = __hip_atomic_fetch_add(lcnt + i2, 1, __ATOMIC_RELAXED, __HIP_MEMORY_SCOPE_WORKGROUP);
            }
        }
        __syncthreads();
        if (tid < 8) lbase[tid] = (int)__hip_atomic_fetch_add(gcnt + 64 * tid, (unsigned)lcnt[tid], __ATOMIC_RELAXED, __HIP_MEMORY_SCOPE_AGENT);
        __syncthreads();
        if (tid < 256) { const int e = tokE[tid]; tab_er[((size_t)grp * 128) * 4 + tid * 2] = e; tab_er[((size_t)grp * 128) * 4 + tid * 2 + 1] = lbase[e] + tokR[tid]; }
        __syncthreads();
        if (tid < 8) lcnt[tid] = 0;
        __syncthreads();
    }
}

DI void moe_tiles(const Frame& F, int (&ts)[9], int (&cnt)[8]) {
    const unsigned* gcnt = (const unsigned*)(F.ws + WS_CTL) + CW_CNT;
    ts[0] = 0;
#pragma unroll
    for (int e = 0; e < 8; ++e) { cnt[e] = (int)__builtin_amdgcn_readfirstlane(__hip_atomic_load(gcnt + 64 * e, __ATOMIC_RELAXED, __HIP_MEMORY_SCOPE_AGENT)); ts[e + 1] = ts[e] + ((cnt[e] + 255) >> 8); }
}

DI void p15_gather(const Frame& F) {
    const bf16_t* h3 = (const bf16_t*)(F.ws + WS_H3); bf16_t* hs = (bf16_t*)(F.ws + WS_HS);
    const int* tab_er = (const int*)(F.ws + WS_TAB + TAB_ER); int* tab_slot = (int*)(F.ws + WS_TAB + TAB_SLOT);
    int ts[9], cnt[8]; moe_tiles(F, ts, cnt);
    const int lane = F.lane;
    for (int m = F.gw; m < MT; m += F.NGW) {
        const u32x4* src = (const u32x4*)(h3 + (size_t)m * DM) + lane;
        const u32x4 v0 = src[0], v1 = src[64], v2 = src[128], v3 = src[192];
#pragma unroll
        for (int k = 0; k < 2; ++k) { const int e = tab_er[(size_t)m * 4 + 2 * k], rk = tab_er[(size_t)m * 4 + 2 * k + 1];
            int t0 = 0;
#pragma unroll
            for (int q = 0; q < 8; ++q) t0 = (e == q) ? ts[q] : t0;
            const int slot = t0 * 256 + rk;
            u32x4* dst = (u32x4*)(hs + (size_t)slot * DM) + lane; dst[0] = v0; dst[64] = v1; dst[128] = v2; dst[192] = v3;
            if (lane == 0) tab_slot[(size_t)m * 2 + k] = slot; }
    }
    for (int idx = F.gw; idx < 8 * 256; idx += F.NGW) { const int e = idx >> 8, rr = idx & 255; int t0 = 0, t1 = 0, c = 0;
#pragma unroll
        for (int q = 0; q < 8; ++q) { t0 = (e == q) ? ts[q] : t0; t1 = (e == q) ? ts[q + 1] : t1; c = (e == q) ? cnt[q] : c; }
        const int row = t0 * 256 + c + rr;
        if (row < t1 * 256) { u32x4* dst = (u32x4*)(hs + (size_t)row * DM) + lane; const u32x4 z = {0u, 0u, 0u, 0u}; dst[0] = z; dst[64] = z; dst[128] = z; dst[192] = z; } }
}

DI void p22_final(const Frame& F, const Args& a, float* out) {
    const bf16_t* Y = (const bf16_t*)(F.ws + WS_Y); const float* tab_gate = (const float*)(F.ws + WS_TAB + TAB_GATE); const int* tab_slot = (const int*)(F.ws + WS_TAB + TAB_SLOT);
    const float* gn = a.in[I_FNORM]; const int lane = F.lane;
    for (int m = F.gw; m < MT; m += F.NGW) {
        const float g1 = tab_gate[(size_t)m * 2], g2 = tab_gate[(size_t)m * 2 + 1]; const int s1 = tab_slot[(size_t)m * 2], s2 = tab_slot[(size_t)m * 2 + 1];
        f32x4* xr = (f32x4*)(out + (size_t)m * DM) + lane; const u32x2* y1 = (const u32x2*)(Y + (size_t)s1 * DM) + lane; const u32x2* y2 = (const u32x2*)(Y + (size_t)s2 * DM) + lane;
        const f32x4* gr = (const f32x4*)gn + lane;
        f32x4 v[8]; float s = 0.f;
#pragma unroll
        for (int j = 0; j < 8; ++j) { v[j] = xr[64 * j]; const u32x2 a1 = y1[64 * j], a2 = y2[64 * j];
            v[j].x += g1 * bflo(a1.x) + g2 * bflo(a2.x); v[j].y += g1 * bfhi(a1.x) + g2 * bfhi(a2.x); v[j].z += g1 * bflo(a1.y) + g2 * bflo(a2.y); v[j].w += g1 * bfhi(a1.y) + g2 * bfhi(a2.y);
            s += (v[j].x * v[j].x + v[j].y * v[j].y) + (v[j].z * v[j].z + v[j].w * v[j].w); }
        const float rstd = 1.0f / sqrtf(wave_sum(s) * (1.f / DM) + EPS);
#pragma unroll
        for (int j = 0; j < 8; ++j) { const f32x4 gg = gr[64 * j]; f32x4 o; o.x = v[j].x * rstd * gg.x; o.y = v[j].y * rstd * gg.y; o.z = v[j].z * rstd * gg.z; o.w = v[j].w * rstd * gg.w; xr[64 * j] = o; }
    }
}

constexpr int N_PHASES = 23;
__global__ void __launch_bounds__(512, 2) fwd(Args args) {
    extern __shared__ __attribute__((aligned(16))) unsigned char lds_raw[];
    Frame F;
    F.lds = (LAS unsigned char*)lds_raw; F.tid = threadIdx.x; F.lane = F.tid & 63; F.wave = __builtin_amdgcn_readfirstlane(F.tid >> 6);
    F.G = gridDim.x; F.bid = blockIdx.x; F.gw = F.bid * 8 + F.wave; F.NGW = F.G * 8; F.ws = args.ws;
    volatile LAS unsigned* MISC = (volatile LAS unsigned*)(F.lds + MISC_OFF);
    if (F.tid < 64) MISC[F.tid] = 0u;
    __syncthreads();
    const int lo = args.ph_lo, hi = args.ph_hi;
    XcdBarrier bar; bar.bar = (unsigned*)(F.ws + WS_CTL) + CW_BAR; bar.x = 0; bar.st = MISC + 8;
    if (hi - lo > 1) bar = xcd_barrier_post((unsigned*)(F.ws + WS_CTL) + CW_BAR, MISC + 8);
#ifdef ONLY_PHASE
#define IN(k) ((k) == ONLY_PHASE && lo <= (k) && (k) < hi)
#else
#define IN(k) (lo <= (k) && (k) < hi)
#endif
#ifndef PROBE_DOUBLE
#define PROBE_DOUBLE -1
#endif
#define REP(k) for (int rep_ = 0; rep_ < ((k) == PROBE_DOUBLE ? 2 : 1); ++rep_)
#define SEAM(k) do { if (IN(k) && IN((k) + 1)) xcd_barrier(bar); } while (0)
    unsigned char* ws = F.ws; float* out = args.out;
    LAS unsigned char* ring = F.lds;

    if (IN(0)) REP(0) { p0_prologue(F, args); } SEAM(0);
    if (IN(1)) REP(1) { pg8::Gemm g{(const bf16_t*)(ws + WS_H0), (const bf16_t*)(ws + WS_WIN0), 2048, 2048, 2048}; pg8::Sched S; S.init(MT / 256, EVEN_INP / 256, F.G, F.bid, 0);
        pg8::EpiStore E{(bf16_t*)(ws + WS_PROJ0), EVEN_INP, 0, 0}; pg8::gemm_phase(ring, g, S, E); } SEAM(1);
    if (IN(2)) REP(2) { p2_rows(F, args); } SEAM(2);
    if (IN(3)) REP(3) { pg8::Gemm g{(const bf16_t*)(ws + WS_CQN), (const bf16_t*)(ws + WS_WQQ), 512, 512, 512}; pg8::Sched S; S.init(MT / 256, QQ_N / 256, F.G, F.bid, 0);
        pg8::EpiStore E{(bf16_t*)(ws + WS_QQ), QQ_N, 0, 0}; pg8::gemm_phase(ring, g, S, E); } SEAM(3);
    #ifndef NO_P4
    if (IN(4)) REP(4) { p4_indexer(F); } SEAM(4);
#endif
    #ifndef NO_P5
    if (IN(5)) REP(5) { p5_dsa(F, args); } SEAM(5);
#endif
    if (IN(6)) REP(6) { pg8::Gemm g{(const bf16_t*)(ws + WS_CAT0), (const bf16_t*)(ws + WS_WOUT0), CAT0_K, CAT0_K, CAT0_K}; pg8::Sched S; S.init(MT / 256, DM / 256, F.G, F.bid, 0);
        pg8::EpiRes E{args.in[I_X], out, DM}; pg8::gemm_phase(ring, g, S, E); } SEAM(6);
    if (IN(7)) REP(7) { rms_phase(F, out, args.in[I_ENFFN], (bf16_t*)(ws + WS_H1)); } SEAM(7);
    if (IN(8)) REP(8) { pg8::Gemm g{(const bf16_t*)(ws + WS_H1), (const bf16_t*)(ws + WS_WGU0), 2048, 2048, 2048}; pg8::Sched S; S.init(MT / 256, 2 * DFF / 256, F.G, F.bid, 0);
        pg8::EpiSwiglu E{(bf16_t*)(ws + WS_ACT0), DFF, 0}; pg8::gemm_phase(ring, g, S, E); } SEAM(8);
    if (IN(9)) REP(9) { pg8::Gemm g{(const bf16_t*)(ws + WS_ACT0), (const bf16_t*)(ws + WS_WDN0), DFF, DFF, DFF}; pg8::Sched S; S.init(MT / 256, DM / 256, F.G, F.bid, 0);
        pg8::EpiRes E{out, out, DM}; pg8::gemm_phase(ring, g, S, E); } SEAM(9);
    if (IN(10)) REP(10) { rms_phase(F, out, args.in[I_ONMIX], (bf16_t*)(ws + WS_H2)); } SEAM(10);
    if (IN(11)) REP(11) { pg8::Gemm g{(const bf16_t*)(ws + WS_H2), (const bf16_t*)(ws + WS_WIN1), 2048, 2048, 2048}; pg8::Sched S; S.init(MT / 256, ODD_IN / 256, F.G, F.bid, 0);
        pg8::EpiStore E{(bf16_t*)(ws + WS_PROJ1), ODD_IN, 0, 8}; pg8::gemm_phase(ring, g, S, E); } SEAM(11);
        if (IN(12)) REP(12) {
#ifndef NO_P12A
        p12_gmlp(F, args);
#endif
#ifndef NO_P12B
        p12_stick(F);
#endif
    } SEAM(12);
    if (IN(13)) REP(13) { pg8::Gemm g{(const bf16_t*)(ws + WS_CAT1), (const bf16_t*)(ws + WS_WOUT1), 2048, 2048, 2048}; pg8::Sched S; S.init(MT / 256, DM / 256, F.G, F.bid, 0);
        pg8::EpiRes E{out, out, DM}; pg8::gemm_phase(ring, g, S, E); } SEAM(13);
    if (IN(14)) REP(14) { p14_router(F, args, out); } SEAM(14);
    if (IN(15)) REP(15) { p15_gather(F); } SEAM(15);
#define MOE_CHUNK(c, pgu, pdn) \
    if (IN(pgu)) REP(pgu) { int ts[9], cnt[8]; moe_tiles(F, ts, cnt); int nM = ts[8] - (c) * MOE_CHUNK_TILES; nM = nM > MOE_CHUNK_TILES ? MOE_CHUNK_TILES : (nM < 0 ? 0 : nM); \
        pg8::Gemm g{(const bf16_t*)(ws + WS_HS), (const bf16_t*)(ws + WS_WGU1), 2048, 2048, 2048}; pg8::Sched S; S.init(nM, 2 * DFFE / 256, F.G, F.bid, (c) * MOE_CHUNK_TILES); \
        for (int j = 0; j < 7; ++j) S.ts[j] = ts[j + 1]; \
        pg8::EpiSwiglu E{(bf16_t*)(ws + WS_ACT1), DFFE, (c) * MOE_CHUNK_TILES * 256}; pg8::gemm_phase(ring, g, S, E); } SEAM(pgu); \
    if (IN(pdn)) REP(pdn) { int ts[9], cnt[8]; moe_tiles(F, ts, cnt); int nM = ts[8] - (c) * MOE_CHUNK_TILES; nM = nM > MOE_CHUNK_TILES ? MOE_CHUNK_TILES : (nM < 0 ? 0 : nM); \
        pg8::Gemm g{(const bf16_t*)(ws + WS_ACT1) - (size_t)(c) * MOE_CHUNK_TILES * 256 * DFFE, (const bf16_t*)(ws + WS_WDN1), DFFE, DFFE, DFFE}; pg8::Sched S; S.init(nM, DM / 256, F.G, F.bid, (c) * MOE_CHUNK_TILES); \
        for (int j = 0; j < 7; ++j) S.ts[j] = ts[j + 1]; \
        pg8::EpiStore E{(bf16_t*)(ws + WS_Y), DM, 0, 0}; pg8::gemm_phase(ring, g, S, E); } SEAM(pdn);
    MOE_CHUNK(0, 16, 17)
    MOE_CHUNK(1, 18, 19)
    MOE_CHUNK(2, 20, 21)
    if (IN(22)) REP(22) { p22_final(F, args, out); }
#undef IN
#undef SEAM
}

extern "C" void kernel_launch(void* const* d_in, const int* in_sizes, int n_in, void* d_out, int out_size, void* d_ws, size_t ws_size, hipStream_t stream) {
    static int grid = 0;
    if (grid == 0) {
        if (n_in != 28 || out_size != MT * DM || ws_size < WS_END) { fprintf(stderr, "kernel_launch: unexpected shapes (n_in %d out %d ws %zu need %zu)\n", n_in, out_size, ws_size, (size_t)WS_END); grid = -1; return; }
        int dev = 0, cus = 0, per_cu = 0;
        if (hipGetDevice(&dev) != hipSuccess || hipDeviceGetAttribute(&cus, hipDeviceAttributeMultiprocessorCount, dev) != hipSuccess) { grid = -1; return; }
        if (hipFuncSetAttribute((const void*)fwd, hipFuncAttributeMaxDynamicSharedMemorySize, LDS_BYTES) != hipSuccess) { fprintf(stderr, "kernel_launch: hipFuncSetAttribute failed\n"); grid = -1; return; }
        if (hipOccupancyMaxActiveBlocksPerMultiprocessor(&per_cu, (const void*)fwd, 512, LDS_BYTES) != hipSuccess || per_cu < 1) { fprintf(stderr, "kernel_launch: occupancy query says %d\n", per_cu); }
        (void)hipGetLastError();
        grid = cus;
    }
    if (grid < 0) return;
    (void)hipMemsetAsync((char*)d_ws + WS_CTL, 0, CTL_ZERO_BYTES, stream);
    Args a{};
    for (int i = 0; i < 28; ++i) a.in[i] = (const float*)d_in[i];
    a.out = (float*)d_out; a.ws = (unsigned char*)d_ws;
#if MK_ONE_LAUNCH
    a.ph_lo = 0; a.ph_hi = N_PHASES;
    hipLaunchKernelGGL(fwd, dim3(grid), dim3(512), LDS_BYTES, stream, a);
#else
    for (int p = 0; p < N_PHASES; ++p) { a.ph_lo = p; a.ph_hi = p + 1; hipLaunchKernelGGL(fwd, dim3(grid), dim3(512), LDS_BYTES, stream, a); }
#endif
}
```

```cpp
#include <hip/hip_runtime.h>
#include <cstdio>
#include <cstdint>

#ifndef F8_FFN0
#define F8_FFN0 2
#endif
#ifndef F8_FFN0_DN
#define F8_FFN0_DN 1
#endif
#ifndef I8_IN0
#define I8_IN0 0
#endif
#ifndef I8_IN1
#define I8_IN1 1
#endif
#define RES_BF16 1

#ifndef MK_ONE_LAUNCH
#define MK_ONE_LAUNCH 1
#endif

#define LAS __attribute__((address_space(3)))
#define GAS __attribute__((address_space(1)))
typedef unsigned short bf16_t;
typedef short bf16x8 __attribute__((ext_vector_type(8)));
typedef short s16x4 __attribute__((ext_vector_type(4)));
typedef float f32x2 __attribute__((ext_vector_type(2)));
typedef float f32x4 __attribute__((ext_vector_type(4)));
typedef float f32x16 __attribute__((ext_vector_type(16)));
typedef unsigned u32x2 __attribute__((ext_vector_type(2)));
typedef unsigned u32x4 __attribute__((ext_vector_type(4)));
typedef __bf16 bf16x2_t __attribute__((ext_vector_type(2)));
typedef GAS unsigned gu32;

#define DI __device__ __forceinline__

constexpr int DM = 2048, NB = 16, SEQ = 2048, MT = NB * SEQ;
constexpr int EVEN_IN = 3920, EVEN_INP = 4096, ODD_IN = 5120;
constexpr int DFF = 5632, NEXP = 8, DFFE = 7168;
constexpr float EPS = 1e-6f;
constexpr int QQ_N = 3072;
constexpr int CAT0_K = 2048;
constexpr int MOE_ROWS = 65536 + 2048;
constexpr int MOE_CHUNK_TILES = 96;

DI unsigned pk2(float a, float b) { bf16x2_t v = __builtin_convertvector((f32x2){a, b}, bf16x2_t); return __builtin_bit_cast(unsigned, v); }
constexpr float F8_SACT = 8.0f, F8_OSC_DN = 1.0f / (8.0f * 2048.0f);
constexpr float F8_SA = 32.0f, F8_SW = 2048.0f, F8_OSC = 1.0f / (32.0f * 2048.0f);
DI unsigned pk4_fp8(float a, float b, float c, float d) {
    a = __builtin_amdgcn_fmed3f(a, -448.f, 448.f); b = __builtin_amdgcn_fmed3f(b, -448.f, 448.f); c = __builtin_amdgcn_fmed3f(c, -448.f, 448.f); d = __builtin_amdgcn_fmed3f(d, -448.f, 448.f);
    unsigned w = 0u; w = (unsigned)__builtin_amdgcn_cvt_pk_fp8_f32(a, b, (int)w, false); w = (unsigned)__builtin_amdgcn_cvt_pk_fp8_f32(c, d, (int)w, true); return w; }
constexpr float I8_SA = 15.875f, I8_SW = 958.0f, I8_OSC = 1.0f / (15.875f * 958.0f);
DI unsigned pk4_i8(float a, float b, float c, float d) {
    const int ia = (int)__builtin_rintf(__builtin_amdgcn_fmed3f(a, -127.f, 127.f)), ib = (int)__builtin_rintf(__builtin_amdgcn_fmed3f(b, -127.f, 127.f));
    const int ic = (int)__builtin_rintf(__builtin_amdgcn_fmed3f(c, -127.f, 127.f)), id = (int)__builtin_rintf(__builtin_amdgcn_fmed3f(d, -127.f, 127.f));
    return ((unsigned)ia & 255u) | (((unsigned)ib & 255u) << 8) | (((unsigned)ic & 255u) << 16) | ((unsigned)id << 24); }
template <int Q> DI unsigned pk4_q(float a, float b, float c, float d) { if constexpr (Q == 2) return pk4_i8(a, b, c, d); else return pk4_fp8(a, b, c, d); }
DI float bf2f(bf16_t v) { return __builtin_bit_cast(float, (unsigned)v << 16); }
DI float bflo(unsigned w) { return __builtin_bit_cast(float, w << 16); }
DI float bfhi(unsigned w) { return __builtin_bit_cast(float, w & 0xffff0000u); }
#define DPP_F(v, ctrl) __builtin_bit_cast(float, __builtin_amdgcn_update_dpp(0, __builtin_bit_cast(int, (v)), (ctrl), 0xf, 0xf, true))
DI float wave_sum(float v) {
    v += DPP_F(v, 0xB1); v += DPP_F(v, 0x4E); v += DPP_F(v, 0x141); v += DPP_F(v, 0x140);
    const int b = __builtin_bit_cast(int, v);
    const float r0 = __builtin_bit_cast(float, __builtin_amdgcn_readlane(b, 0)), r1 = __builtin_bit_cast(float, __builtin_amdgcn_readlane(b, 16)), r2 = __builtin_bit_cast(float, __builtin_amdgcn_readlane(b, 32)), r3 = __builtin_bit_cast(float, __builtin_amdgcn_readlane(b, 48));
    return (r0 + r1) + (r2 + r3);
}
DI unsigned f2u(float x) { return __builtin_bit_cast(unsigned, x); }
DI float u2f(unsigned x) { return __builtin_bit_cast(float, x); }
DI float xrow_max(float x) {
    unsigned a = f2u(x), b = a; asm volatile("" : "+v"(b)); auto s = __builtin_amdgcn_permlane16_swap(a, b, false, false); x = fmaxf(u2f(s[0]), u2f(s[1]));
    a = f2u(x); b = a; asm volatile("" : "+v"(b)); auto t = __builtin_amdgcn_permlane32_swap(a, b, false, false); return fmaxf(u2f(t[0]), u2f(t[1]));
}
DI float xrow_sum(float x) {
    unsigned a = f2u(x), b = a; asm volatile("" : "+v"(b)); auto s = __builtin_amdgcn_permlane16_swap(a, b, false, false); x = u2f(s[0]) + u2f(s[1]);
    a = f2u(x); b = a; asm volatile("" : "+v"(b)); auto t = __builtin_amdgcn_permlane32_swap(a, b, false, false); return u2f(t[0]) + u2f(t[1]);
}
DI float xor32_get(float x, int hi) {
    unsigned a = f2u(x), b = a; asm volatile("" : "+v"(b)); auto t = __builtin_amdgcn_permlane32_swap(a, b, false, false); return u2f(hi ? t[0] : t[1]);
}
DI float fast_exp2(float x) { return __builtin_amdgcn_exp2f(x); }
DI float fast_log2(float x) { return __builtin_amdgcn_logf(x); }
DI float fast_rcp(float x) { return __builtin_amdgcn_rcpf(x); }

namespace pg8 {
#ifndef WGM_WIDE
#define WGM_WIDE 4
#endif
#ifndef WGM_NARROW
#define WGM_NARROW 4
#endif
constexpr int BM = 256, BK = 64, HALF = 128, HTB = HALF * BK * 2, STAGE_BYTES = 8 * HTB, NXCD = 8, WGM = 4;
__host__ __device__ __forceinline__ int lds_byte(int r, int c) { const int st = (r >> 4) * 2 + (c >> 5), rr = r & 15, cc = c & 31, ob = rr * 64 + cc * 2; return st * 1024 + (ob ^ (((ob >> 9) & 1) << 5)); }
__host__ __device__ __forceinline__ void stage_rc(int b, int& R, int& C) { const int st = b / 1024, sb = b % 1024, swz = sb ^ (((sb >> 9) & 1) << 5); R = (st >> 1) * 16 + swz / 64; C = (st & 1) * 32 + (swz % 64) / 2; }
__host__ __device__ __forceinline__ int perm32(int rho) { const int n = rho >> 4, i = rho & 15; return 8 * (i >> 2) + 4 * n + (i & 3); }

struct Unit { int pm, pn, bt; };
struct Gemm { const bf16_t* A; const bf16_t* Bt; int lda, ldb, K; };

struct Sched {
    int nM, nN, nwg, G, c, pm0, rex; int ts[7];
    __device__ void init(int nM_, int nN_, int G_, int c_, int pm0_) { nM = nM_; nN = nN_; nwg = nM * nN; G = G_; c = c_; pm0 = pm0_; rex = 0; for (int j = 0; j < 7; ++j) ts[j] = 0x7fffffff; }
    __device__ __forceinline__ bool next(int i, Unit& u) const {
        long L = (long)i * G + c;
        if (rex) { const int ii = i + (c < rex ? 3 : 0); L = ii < 3 ? (long)ii * (G - rex) + (c - rex) : (long)3 * (G - rex) + (long)(ii - 3) * G + c; }
        if (L >= nwg) return false;
        int wgid = (int)L; { const int q = nwg / NXCD, r = nwg % NXCD, xcd = wgid % NXCD, off = wgid / NXCD; wgid = (xcd < r ? xcd * (q + 1) : r * (q + 1) + (xcd - r) * q) + off; }
        const int wgm = nN >= 40 ? WGM_WIDE : (nN <= 8 ? WGM_NARROW : WGM);
        const int nig = wgm * nN, gid = wgid / nig, fm = gid * wgm, gsz = (nM - fm) < wgm ? (nM - fm) : wgm;
        u.pm = pm0 + fm + ((wgid % nig) % gsz); u.pn = (wgid % nig) / gsz;
        int e = 0;
#pragma unroll
        for (int j = 0; j < 7; ++j) e += (u.pm >= ts[j]) ? 1 : 0;
        u.bt = e * nN + u.pn; return true;
    }
};

DI f32x4 gelu_tanh4(f32x4 v) {
    f32x4 o;
#pragma unroll
    for (int j = 0; j < 4; ++j) { const float x = v[j]; const float t = x * (1.0f + 0.044715f * x * x) * (-2.0f * 0.7978845608f * 1.44269504f); o[j] = x * fast_rcp(1.0f + fast_exp2(t)); }
    return o;
}
DI float ibits2f(float bits) { return (float)__builtin_bit_cast(int, bits); }
struct EpiStore {
    static constexpr bool PERM = true;
    bf16_t* O; int ldc, row_sub, gelu_tiles; float osc; int iacc;
    DI void operator()(const f32x4 (&acc)[2][2][4][2], const Unit& u, int wr, int wc, int fr, int fq) const {
        const int row0 = u.pm * BM - row_sub + wr * 64 + fr, col0 = u.pn * BM + wc * 32 + 8 * fq; const bool g = u.pn < gelu_tiles;
#pragma unroll
        for (int ai = 0; ai < 2; ++ai)
#pragma unroll
            for (int m = 0; m < 4; ++m) { bf16_t* rowp = O + (size_t)(row0 + ai * HALF + m * 16) * ldc + col0;
#pragma unroll
                for (int bj = 0; bj < 2; ++bj) { f32x4 v0 = acc[ai][bj][m][0], v1 = acc[ai][bj][m][1];
                    if (iacc) {
#pragma unroll
                        for (int j = 0; j < 4; ++j) { const float a0 = v0[j], a1 = v1[j]; v0[j] = ibits2f(a0); v1[j] = ibits2f(a1); } }
                    v0 = v0 * osc; v1 = v1 * osc;
                    if (g) { v0 = gelu_tanh4(v0); v1 = gelu_tanh4(v1); }
                    u32x4 w; w.x = pk2(v0[0], v0[1]); w.y = pk2(v0[2], v0[3]); w.z = pk2(v1[0], v1[1]); w.w = pk2(v1[2], v1[3]);
                    *(u32x4*)(rowp + bj * HALF) = w; } }
    }
};
struct EpiRes {
    static constexpr bool PERM = false;
    const float* base; float* out; int ldc; float osc;
    DI void operator()(const f32x4 (&acc)[2][2][4][2], const Unit& u, int wr, int wc, int fr, int fq) const {
        const int row0 = u.pm * BM + wr * 64 + fr, col0 = u.pn * BM + wc * 32 + 4 * fq;
#pragma unroll
        for (int ai = 0; ai < 2; ++ai)
#pragma unroll
            for (int m = 0; m < 4; ++m) { const size_t off = (size_t)(row0 + ai * HALF + m * 16) * ldc + col0;
#pragma unroll
                for (int bj = 0; bj < 2; ++bj)
#pragma unroll
                    for (int n = 0; n < 2; ++n) { const f32x4 b = *(const f32x4*)(base + off + bj * HALF + n * 16); *(f32x4*)(out + off + bj * HALF + n * 16) = b + acc[ai][bj][m][n] * osc; } }
    }
};
template <bool BF32> struct EpiResB {
    static constexpr bool PERM = true;
    const void* base; bf16_t* out; int ldc; float osc;
    DI void operator()(const f32x4 (&acc)[2][2][4][2], const Unit& u, int wr, int wc, int fr, int fq) const {
        const int row0 = u.pm * BM + wr * 64 + fr, col0 = u.pn * BM + wc * 32 + 8 * fq;
#pragma unroll
        for (int ai = 0; ai < 2; ++ai)
#pragma unroll
            for (int m = 0; m < 4; ++m) { const size_t off = (size_t)(row0 + ai * HALF + m * 16) * ldc + col0;
#pragma unroll
                for (int bj = 0; bj < 2; ++bj) { f32x4 v0 = acc[ai][bj][m][0] * osc, v1 = acc[ai][bj][m][1] * osc;
                    if (BF32) { const float* bp = (const float*)base + off + bj * HALF; const f32x4 b0 = *(const f32x4*)bp, b1 = *(const f32x4*)(bp + 4); v0 = v0 + b0; v1 = v1 + b1; }
                    else { const u32x4 bw = *(const u32x4*)((const bf16_t*)base + off + bj * HALF);
                        v0[0] += bflo(bw.x); v0[1] += bfhi(bw.x); v0[2] += bflo(bw.y); v0[3] += bfhi(bw.y); v1[0] += bflo(bw.z); v1[1] += bfhi(bw.z); v1[2] += bflo(bw.w); v1[3] += bfhi(bw.w); }
                    u32x4 w; w.x = pk2(v0[0], v0[1]); w.y = pk2(v0[2], v0[3]); w.z = pk2(v1[0], v1[1]); w.w = pk2(v1[2], v1[3]);
                    *(u32x4*)(out + off + bj * HALF) = w; } }
    }
};
struct EpiSwiglu {
    static constexpr bool PERM = true;
    bf16_t* O; int ldc, row_sub; float osc; int f8out; int iacc;
    DI void operator()(const f32x4 (&acc)[2][2][4][2], const Unit& u, int wr, int wc, int fr, int fq) const {
        const int row0 = u.pm * BM - row_sub + wr * 64 + fr, col0 = u.pn * HALF + wc * 32 + 8 * fq;
#pragma unroll
        for (int ai = 0; ai < 2; ++ai)
#pragma unroll
            for (int m = 0; m < 4; ++m) { float o[8]; const float kexp = -1.44269504f * osc, kout = osc * osc * (f8out ? F8_SACT : 1.0f);
#pragma unroll
                for (int n = 0; n < 2; ++n)
#pragma unroll
                    for (int j = 0; j < 4; ++j) { const float gr = acc[ai][0][m][n][j], ur = acc[ai][1][m][n][j]; const float ga = iacc ? ibits2f(gr) : gr, ua = iacc ? ibits2f(ur) : ur;
                        o[4 * n + j] = (ga * fast_rcp(1.0f + fast_exp2(ga * kexp))) * (ua * kout); }
                if (f8out) { u32x2 w8; w8.x = pk4_fp8(o[0], o[1], o[2], o[3]); w8.y = pk4_fp8(o[4], o[5], o[6], o[7]);
                    *(u32x2*)((unsigned char*)O + (size_t)(row0 + ai * HALF + m * 16) * ldc + col0) = w8; }
                else { u32x4 w; w.x = pk2(o[0], o[1]); w.y = pk2(o[2], o[3]); w.z = pk2(o[4], o[5]); w.w = pk2(o[6], o[7]);
                    *(u32x4*)(O + (size_t)(row0 + ai * HALF + m * 16) * ldc + col0) = w; } }
    }
};

template <class Epi, int MODE = 0>
DI void gemm_phase(LAS unsigned char* lds, const Gemm g, const Sched& S, const Epi& E) {
    constexpr bool F8 = (MODE == 1);
    int tid = threadIdx.x; asm volatile("" : "+v"(tid));
    const int wid = __builtin_amdgcn_readfirstlane(tid >> 6), lane = tid & 63, wr = wid >> 2, wc = wid & 3, fr = lane & 15, fq = lane >> 4;
    const int K = g.K, nt = K / BK;
    unsigned voffA[2], voffB[2];
#pragma unroll
    for (int i = 0; i < 2; ++i) { int R, C; stage_rc(tid * 16 + i * 8192, R, C); const int Rb = Epi::PERM ? ((R & ~31) + perm32(R & 31)) : R;
        voffA[i] = (unsigned)(R * g.lda + C) * 2u; voffB[i] = (unsigned)(Rb * g.ldb + C) * 2u; }
    const size_t kstep = (size_t)(BK * 2);
    const size_t hstepA = (size_t)HALF * g.lda * 2, hstepB = (size_t)HALF * g.ldb * 2;
    const size_t tstepA = 2 * hstepA, tstepB = 2 * hstepB;
    const unsigned ldsw = (unsigned)wid * 1024u;
    const int aoff = lds_byte(wr * 64 + fr, fq * 8), boff = lds_byte(wc * 32 + fr, fq * 8);
#define PG8_SA(b, h) (((b) * 2 + (h)) * HTB)
#define PG8_SB(b, h) ((4 + (b) * 2 + (h)) * HTB)
#define PG8_STAGE(bufoff, gbase, voff) do { _Pragma("unroll") for (int _i = 0; _i < 2; ++_i) \
        __builtin_amdgcn_global_load_lds((const unsigned*)((const char*)(gbase) + (voff)[_i]), (LAS unsigned*)(lds + (bufoff) + ldsw + _i * 8192), 16, 0, 0); } while (0)
#define PG8_LD16(off) (*(const LAS v4i_*)(lds + (off)))
#define PG8_LDA(dst, b, h) do { _Pragma("unroll") for (int m = 0; m < 4; ++m) { \
        if constexpr (F8) dst##8[m] = __builtin_shufflevector(PG8_LD16(PG8_SA(b, h) + aoff + m * 2048), PG8_LD16(PG8_SA(b, h) + aoff + m * 2048 + 1024), 0, 1, 2, 3, 4, 5, 6, 7); \
        else { _Pragma("unroll") for (int k = 0; k < 2; ++k) dst[m][k] = *(const LAS bf16x8*)(lds + PG8_SA(b, h) + aoff + m * 2048 + k * 1024); } } } while (0)
#define PG8_LDB(dst, b, h) do { _Pragma("unroll") for (int n = 0; n < 2; ++n) { \
        if constexpr (F8) dst##8[n] = __builtin_shufflevector(PG8_LD16(PG8_SB(b, h) + boff + n * 2048), PG8_LD16(PG8_SB(b, h) + boff + n * 2048 + 1024), 0, 1, 2, 3, 4, 5, 6, 7); \
        else { _Pragma("unroll") for (int k = 0; k < 2; ++k) dst[n][k] = *(const LAS bf16x8*)(lds + PG8_SB(b, h) + boff + n * 2048 + k * 1024); } } } while (0)
#define PG8_MMA(ai, bj, At, Bt) do { __builtin_amdgcn_s_setprio(1); _Pragma("unroll") for (int m = 0; m < 4; ++m) _Pragma("unroll") for (int n = 0; n < 2; ++n) { \
        if constexpr (F8) asm volatile("v_mfma_f32_16x16x128_f8f6f4 %0, %1, %2, %0" : "+v"(acc[ai][bj][m][n]) : "v"(Bt##8[n]), "v"(At##8[m]));   \
        else if constexpr (MODE == 2) { _Pragma("unroll") for (int k = 0; k < 2; ++k) acc[ai][bj][m][n] = __builtin_bit_cast(f32x4, __builtin_amdgcn_mfma_i32_16x16x64_i8(__builtin_bit_cast(v4i_, Bt[n][k]), __builtin_bit_cast(v4i_, At[m][k]), __builtin_bit_cast(v4i_, acc[ai][bj][m][n]), 0, 0, 0)); } \
        else { _Pragma("unroll") for (int k = 0; k < 2; ++k) acc[ai][bj][m][n] = __builtin_amdgcn_mfma_f32_16x16x32_bf16(Bt[n][k], At[m][k], acc[ai][bj][m][n], 0, 0, 0); } } \
        __builtin_amdgcn_s_setprio(0); } while (0)
#define PG8_WAIT_V(n) asm volatile("s_waitcnt vmcnt(" #n ")" ::: "memory")
#define PG8_WAIT_L(n) asm volatile("s_waitcnt lgkmcnt(" #n ")" ::: "memory")
#define PG8_BAR __builtin_amdgcn_s_barrier()
#define PG8_SCHED __builtin_amdgcn_sched_barrier(0)
    Unit cur, nxt; int ui = 0;
    if (!S.next(0, cur)) return;
    f32x4 acc[2][2][4][2];
#pragma unroll
    for (int a = 0; a < 2; ++a)
#pragma unroll
        for (int b = 0; b < 2; ++b)
#pragma unroll
            for (int m = 0; m < 4; ++m)
#pragma unroll
                for (int n = 0; n < 2; ++n) acc[a][b][m][n] = (f32x4){0.f, 0.f, 0.f, 0.f};
    typedef int v4i_ __attribute__((ext_vector_type(4))); typedef int v8i_ __attribute__((ext_vector_type(8)));
    bf16x8 At[4][2], B0[2][2], B1[2][2]; v8i_ At8[4], B08[2], B18[2];
    const char* cA = (const char*)g.A + (size_t)cur.pm * tstepA; const char* cB = (const char*)g.Bt + (size_t)cur.bt * tstepB;
    PG8_STAGE(PG8_SB(0, 0), cB, voffB); PG8_STAGE(PG8_SB(0, 1), cB + hstepB, voffB); PG8_STAGE(PG8_SA(0, 0), cA, voffA); PG8_STAGE(PG8_SA(0, 1), cA + hstepA, voffA);
    if (wr == 1) PG8_BAR;
    PG8_WAIT_V(2); PG8_BAR;
    PG8_STAGE(PG8_SB(1, 0), cB + kstep, voffB); PG8_STAGE(PG8_SA(1, 0), cA + kstep, voffA); PG8_STAGE(PG8_SB(1, 1), cB + hstepB + kstep, voffB);
    PG8_WAIT_V(6); PG8_BAR;
    for (;;) {
        const bool has_next = S.next(ui + 1, nxt);
        const char* nA = has_next ? (const char*)g.A + (size_t)nxt.pm * tstepA : cA; const char* nB = has_next ? (const char*)g.Bt + (size_t)nxt.bt * tstepB : cB;
        for (int t = 0; t < nt; t += 2) {
            const bool last = (t == nt - 2);
            const char* a1 = cA + (size_t)(t + 1) * kstep;
            const char* a2 = last ? nA : cA + (size_t)(t + 2) * kstep; const char* b2 = last ? nB : cB + (size_t)(t + 2) * kstep;
            const char* a3 = a2 + kstep; const char* b3 = b2 + kstep;
            PG8_LDB(B0, 0, 0); PG8_LDB(B1, 0, 1); PG8_SCHED; PG8_LDA(At, 0, 0); PG8_STAGE(PG8_SA(1, 1), a1 + hstepA, voffA);
            PG8_WAIT_V(8); PG8_WAIT_L(0); PG8_BAR; PG8_MMA(0, 0, At, B0); PG8_MMA(0, 1, At, B1); PG8_BAR; PG8_SCHED;
            PG8_LDA(At, 0, 1); PG8_STAGE(PG8_SB(0, 0), b2, voffB); PG8_STAGE(PG8_SB(0, 1), b2 + hstepB, voffB); PG8_STAGE(PG8_SA(0, 0), a2, voffA);
            PG8_WAIT_V(8); PG8_WAIT_L(0); PG8_BAR; PG8_MMA(1, 0, At, B0); PG8_MMA(1, 1, At, B1); PG8_BAR; PG8_SCHED;
            PG8_LDB(B0, 1, 0); PG8_LDB(B1, 1, 1); PG8_SCHED; PG8_LDA(At, 1, 0); PG8_STAGE(PG8_SA(0, 1), a2 + hstepA, voffA);
            PG8_WAIT_V(8); PG8_WAIT_L(0); PG8_BAR; PG8_MMA(0, 0, At, B0); PG8_MMA(0, 1, At, B1); PG8_BAR; PG8_SCHED;
            PG8_LDA(At, 1, 1); PG8_STAGE(PG8_SB(1, 0), b3, voffB); PG8_STAGE(PG8_SB(1, 1), b3 + hstepB, voffB); PG8_STAGE(PG8_SA(1, 0), a3, voffA);
            PG8_WAIT_V(8); PG8_WAIT_L(0); PG8_BAR; PG8_MMA(1, 0, At, B0); PG8_MMA(1, 1, At, B1); PG8_BAR; PG8_SCHED;
        }
        if (wr == 0) PG8_BAR;
        if constexpr (F8) asm volatile("s_nop 15\n\ts_nop 15" ::: "memory");
        E(acc, cur, wr, wc, fr, fq);
        if (!has_next) break;
#pragma unroll
        for (int a = 0; a < 2; ++a)
#pragma unroll
            for (int b = 0; b < 2; ++b)
#pragma unroll
                for (int m = 0; m < 4; ++m)
#pragma unroll
                    for (int n = 0; n < 2; ++n) acc[a][b][m][n] = (f32x4){0.f, 0.f, 0.f, 0.f};
        cur = nxt; cA = nA; cB = nB; ++ui;
        if (wr == 1) PG8_BAR;
    }
    PG8_WAIT_V(0);
    PG8_BAR;
#undef PG8_SA
#undef PG8_SB
#undef PG8_STAGE
#undef PG8_LDA
#undef PG8_LD16
#undef PG8_LDB
#undef PG8_MMA
#undef PG8_WAIT_V
#undef PG8_WAIT_L
#undef PG8_BAR
#undef PG8_SCHED
}
}

#define XB_TMO      128
#define XB_XCNT(j)  (256  + 64 * (j))
#define XB_XSUB(j)  (1280 + 64 * (j))
#define XB_XGEN(j)  (2304 + 64 * (j))
#define XB_TOP      3328
#define XB_TOPGEN   3392
#define XCD_BAR_WORDS 3456
#define XB_SPIN_CAP (1u << 22)

DI unsigned xb_ld(unsigned* p)              { return __hip_atomic_load(p, __ATOMIC_RELAXED, __HIP_MEMORY_SCOPE_AGENT); }
DI unsigned xb_add(unsigned* p, unsigned v) { return __hip_atomic_fetch_add(p, v, __ATOMIC_RELAXED, __HIP_MEMORY_SCOPE_AGENT); }
DI unsigned xb_xcc_id() { return (unsigned)__builtin_amdgcn_s_getreg((3 << 11) | 20) & 0xFu; }
#define XB_SPIN(cond, bar) do { unsigned _sp = 0; while (cond) { __builtin_amdgcn_s_sleep(1); \
    if ((++_sp & 255u) == 0u) { if (xb_ld(&(bar)[XB_TMO])) break; if (_sp > XB_SPIN_CAP) { atomicAdd(&(bar)[XB_TMO], 1u); break; } } } } while (0)

struct XcdBarrier { unsigned* bar; unsigned x; volatile LAS unsigned* st; };

DI XcdBarrier xcd_barrier_post(unsigned* bar, volatile LAS unsigned* st) {
    XcdBarrier b; b.bar = bar; b.x = xb_xcc_id(); b.st = st;
    if (threadIdx.x == 0) (void)xb_add(&bar[XB_XCNT(b.x)], 1u);
    return b;
}
DI void xcd_barrier_complete(unsigned* bar, unsigned x, unsigned& nloc, unsigned& nx) {
    const unsigned G = gridDim.x * gridDim.y * gridDim.z;
    unsigned sum, cnt, mine, sp = 0u;
    for (;;) {
        sum = 0u; cnt = 0u; mine = 0u;
#pragma unroll
        for (unsigned j = 0; j < 16; ++j) { const unsigned c = xb_ld(&bar[XB_XCNT(j)]); sum += c; cnt += (c > 0u) ? 1u : 0u; mine = (j == x) ? c : mine; }
        if (sum == G) break;
        __builtin_amdgcn_s_sleep(1);
        if ((++sp & 255u) == 0u) { if (xb_ld(&bar[XB_TMO])) break; if (sp > XB_SPIN_CAP) { atomicAdd(&bar[XB_TMO], 1u); break; } }
    }
    nloc = mine > 0u ? mine : 1u; nx = cnt > 0u ? cnt : 1u;
}
DI void xcd_barrier(const XcdBarrier& b) {
    asm volatile("s_waitcnt vmcnt(0)" ::: "memory");
    __syncthreads();
    if (threadIdx.x == 0) {
        unsigned* bar = b.bar;
        __builtin_amdgcn_s_waitcnt(0);
        unsigned nloc = b.st[0], nx = b.st[1];
        if (nloc == 0u) { xcd_barrier_complete(bar, b.x, nloc, nx); b.st[0] = nloc; b.st[1] = nx; }
        const unsigned old = xb_add(&bar[XB_XSUB(b.x)], 1u);
        const unsigned gen = old / nloc;
        if (old + 1u == (gen + 1u) * nloc) {
            __builtin_amdgcn_fence(__ATOMIC_RELEASE, "agent");
            asm volatile("s_waitcnt vmcnt(0)" ::: "memory");
            const unsigned og = xb_add(&bar[XB_TOP], 1u);
            const unsigned tg = og / nx;
            if (og + 1u == (tg + 1u) * nx) xb_add(&bar[XB_TOPGEN], 1u);
            else XB_SPIN(xb_ld(&bar[XB_TOPGEN]) == tg, bar);
            __builtin_amdgcn_fence(__ATOMIC_ACQUIRE, "agent");
            xb_add(&bar[XB_XGEN(b.x)], 1u);
            asm volatile("s_waitcnt vmcnt(0)" ::: "memory");
        } else {
            XB_SPIN(xb_ld(&bar[XB_XGEN(b.x)]) == gen, bar);
            __builtin_amdgcn_fence(__ATOMIC_ACQUIRE, "agent");
            asm volatile("s_waitcnt vmcnt(0)" ::: "memory");
        }
    }
    __syncthreads();
}

constexpr size_t MiB = 1u << 20;
constexpr size_t WS_CTL = 0, CTL_ZERO_BYTES = 1 * MiB;
constexpr size_t WS_TAB = 1 * MiB;
constexpr size_t WS_WIN1 = 5 * MiB;
constexpr size_t WS_WOUT1 = 25 * MiB;
constexpr size_t WS_WS = 33 * MiB;
constexpr size_t WS_WUV = 33 * MiB + 256 * 1024;
constexpr size_t WS_WGU1 = 34 * MiB;
constexpr size_t WS_XR = 258 * MiB;
constexpr size_t WS_WDN1 = 482 * MiB;
constexpr size_t WS_L0 = 706 * MiB;
constexpr size_t WS_WIN0 = WS_L0;
constexpr size_t WS_WQQ = WS_L0 + 16 * MiB;
constexpr size_t WS_WOUT0 = WS_L0 + 19 * MiB;
constexpr size_t WS_WGU0 = WS_L0 + 31 * MiB;
constexpr size_t WS_WDN0 = WS_L0 + 75 * MiB;
constexpr size_t WS_CQN = WS_L0 + 97 * MiB;
constexpr size_t WS_CKV = WS_L0 + 129 * MiB;
constexpr size_t WS_KX = WS_L0 + 145 * MiB;
constexpr size_t WS_WIDX = WS_L0 + 149 * MiB;
constexpr size_t WS_ACT = WS_L0 + 152 * MiB;
constexpr size_t WS_PROJ0 = WS_ACT;
constexpr size_t WS_CAT0 = WS_ACT + 256 * MiB;
constexpr size_t WS_QQ = WS_ACT + 448 * MiB;
constexpr size_t WS_H0 = WS_QQ;
constexpr size_t WS_SC = WS_ACT + 640 * MiB;
constexpr size_t WS_H1 = WS_SC;
constexpr size_t WS_ACT0 = WS_ACT;
constexpr size_t WS_H2 = WS_ACT;
constexpr size_t WS_PROJ1 = WS_ACT + 128 * MiB;
constexpr size_t WS_CAT1 = WS_ACT + 448 * MiB;
constexpr size_t WS_HS = WS_L0 + 264 * MiB;
constexpr size_t WS_Y = WS_L0;
constexpr size_t WS_ACT1A = WS_L0 + 396 * MiB;
constexpr size_t WS_ACT1B = WS_L0 + 732 * MiB;
constexpr size_t WS_H3 = WS_L0 + 732 * MiB;
constexpr size_t WS_END = WS_L0 + 1096 * MiB;
static_assert(WS_SC + 128 * MiB <= WS_END && WS_CAT1 + 128 * MiB <= WS_H3 && WS_ACT1A + (size_t)96 * 256 * DFFE * 2 <= WS_ACT1B && WS_ACT1B + (size_t)104 * 256 * DFFE * 2 <= WS_END, "ws map");
constexpr size_t TAB_ER = 0;
constexpr size_t TAB_GATE = 512 * 1024;
constexpr size_t TAB_SLOT = 1024 * 1024;
constexpr int CW_BAR = 1024;
constexpr int CW_CNT = 8192;
constexpr int RING_BYTES = 131072, LDS_BYTES = 147456, MISC_OFF = LDS_BYTES - 256;

struct Args { const float* in[28]; float* out; unsigned char* ws; int ph_lo, ph_hi; };
enum { I_X = 0, I_RELB, I_FNORM, I_ENMIX, I_EWIN, I_ECONV, I_ENCQ, I_ENCKV, I_EWUQ, I_EWUK, I_EWUV, I_EWQIDX, I_EWOUT, I_ENFFN, I_EGATE, I_EUP, I_EDOWN,
       I_ONMIX, I_OWIN, I_ONV, I_OWS, I_OBS, I_OWOUT, I_ONFFN, I_OROUTER, I_OGATE, I_OUP, I_ODOWN };

struct Frame {
    LAS unsigned char* lds;
    int tid, lane, wave, gw, NGW, G, bid;
    unsigned char* ws;
};

DI void tr_load(f32x4 (&v)[16], const float* W, int ldsrc, int N, int nblk, int item, int lane) {
    const int kb = item / nblk, nb = item % nblk, k0 = 64 * kb, n0 = 64 * nb;
    const int q = lane & 15, rr = lane >> 4; const bool ok = n0 + 4 * q < N;
    const float* src = W + (size_t)(k0 + rr) * ldsrc + n0 + 4 * q;
#pragma unroll
    for (int i = 0; i < 16; ++i) v[i] = ok ? __builtin_nontemporal_load((const f32x4*)(src + (size_t)(4 * i) * ldsrc)) : (f32x4){0.f, 0.f, 0.f, 0.f};
}
DI void tr_store(const f32x4 (&v)[16], bf16_t* WT, int ldd, int koff, int row_off, int mode, int nblk, LAS float* scr, int item, int lane) {
    const int kb = item / nblk, nb = item % nblk, k0 = 64 * kb, n0 = 64 * nb;
    const int q = lane & 15, rr = lane >> 4;
#pragma unroll
    for (int i = 0; i < 16; ++i) { LAS float* d = scr + (4 * i + rr) * 65 + 4 * q; d[0] = v[i].x; d[1] = v[i].y; d[2] = v[i].z; d[3] = v[i].w; }
    asm volatile("s_waitcnt lgkmcnt(0)" ::: "memory");
    const int c = lane & 7;
    const int drow0 = (mode == 1) ? ((n0 >> 7) * 256 + (n0 & 127) + row_off) : (row_off + n0);
#pragma unroll
    for (int j = 0; j < 8; ++j) { const int n = (lane >> 3) + 8 * j; const LAS float* s = scr + (8 * c) * 65 + n;
        u32x4 o; o.x = pk2(s[0 * 65], s[1 * 65]); o.y = pk2(s[2 * 65], s[3 * 65]); o.z = pk2(s[4 * 65], s[5 * 65]); o.w = pk2(s[6 * 65], s[7 * 65]);
        *(u32x4*)(WT + (size_t)(drow0 + n) * ldd + koff + k0 + 8 * c) = o; }
    asm volatile("s_waitcnt lgkmcnt(0)" ::: "memory");
}
template <int Q = 1> DI void tr_store_f8(const f32x4 (&v)[16], unsigned char* WT, int ldd, int row_off, int mode, int nblk, LAS float* scr, int item, int lane) {
    constexpr float QS = (Q == 2) ? I8_SW : F8_SW;
    const int kb = item / nblk, nb = item % nblk, k0 = 64 * kb, n0 = 64 * nb;
    const int q = lane & 15, rr = lane >> 4;
#pragma unroll
    for (int i = 0; i < 16; ++i) { LAS float* d = scr + (4 * i + rr) * 65 + 4 * q; d[0] = v[i].x; d[1] = v[i].y; d[2] = v[i].z; d[3] = v[i].w; }
    asm volatile("s_waitcnt lgkmcnt(0)" ::: "memory");
    const int c = lane & 7;
    const int drow0 = (mode == 1) ? ((n0 >> 7) * 256 + (n0 & 127) + row_off) : (row_off + n0);
#pragma unroll
    for (int j = 0; j < 8; ++j) { const int n = (lane >> 3) + 8 * j; const LAS float* s = scr + (8 * c) * 65 + n;
        u32x2 o; o.x = pk4_q<Q>(s[0 * 65] * QS, s[1 * 65] * QS, s[2 * 65] * QS, s[3 * 65] * QS); o.y = pk4_q<Q>(s[4 * 65] * QS, s[5 * 65] * QS, s[6 * 65] * QS, s[7 * 65] * QS);
        *(u32x2*)(WT + (size_t)(drow0 + n) * ldd + k0 + 8 * c) = o; }
    asm volatile("s_waitcnt lgkmcnt(0)" ::: "memory");
}
template <int Q = 1> DI void tr_job_f8(const Frame& F, const float* W, int K, int ldsrc, int N, unsigned char* WT, int ldd, int row_off, int mode, int Npad = 0) {
    LAS float* scr = (LAS float*)(F.lds + F.wave * 16640);
    const int nblk = (Npad ? Npad : N) / 64, nitems = (K / 64) * nblk;
    for (int it = F.gw; it < nitems; it += F.NGW) { f32x4 v[16]; tr_load(v, W, ldsrc, N, nblk, it, F.lane); tr_store_f8<Q>(v, WT, ldd, row_off, mode, nblk, scr, it, F.lane); }
}
DI void tr_item(const float* W, int ldsrc, int N, bf16_t* WT, int ldd, int koff, int row_off, int mode, int nblk, LAS float* scr, int item, int lane) {
    f32x4 v[16]; tr_load(v, W, ldsrc, N, nblk, item, lane); tr_store(v, WT, ldd, koff, row_off, mode, nblk, scr, item, lane);
}
DI void tr_job(const Frame& F, const float* W, int K, int ldsrc, int N, int Npad, bf16_t* WT, int ldd, int koff, int row_off, int mode) {
    LAS float* scr = (LAS float*)(F.lds + F.wave * 16640);
    const int nblk = Npad / 64, nitems = (K / 64) * nblk;
    for (int it = F.gw; it < nitems; it += F.NGW) tr_item(W, ldsrc, N, WT, ldd, koff, row_off, mode, nblk, scr, it, F.lane);
}

DI void rms_row_to_bf16(const float* xrow, const float* g, bf16_t* orow, int lane) {
    const f32x4* xr = (const f32x4*)xrow + lane; const f32x4* gr = (const f32x4*)g + lane;
    f32x4 v[8]; float s = 0.f;
#pragma unroll
    for (int j = 0; j < 8; ++j) { v[j] = xr[64 * j]; s += (v[j].x * v[j].x + v[j].y * v[j].y) + (v[j].z * v[j].z + v[j].w * v[j].w); }
    const float rstd = 1.0f / sqrtf(wave_sum(s) * (1.f / DM) + EPS);
    u32x2* o8 = (u32x2*)orow + lane;
#pragma unroll
    for (int j = 0; j < 8; ++j) { const f32x4 gg = gr[64 * j]; u32x2 w; w.x = pk2(v[j].x * rstd * gg.x, v[j].y * rstd * gg.y); w.y = pk2(v[j].z * rstd * gg.z, v[j].w * rstd * gg.w); o8[64 * j] = w; }
}
template <int Q> DI void rms_row_to_f8(const float* xrow, const float* g, unsigned char* orow, int lane) {
    const f32x4* xr = (const f32x4*)xrow + lane; const f32x4* gr = (const f32x4*)g + lane;
    f32x4 v[8]; float s = 0.f;
#pragma unroll
    for (int j = 0; j < 8; ++j) { v[j] = xr[64 * j]; s += (v[j].x * v[j].x + v[j].y * v[j].y) + (v[j].z * v[j].z + v[j].w * v[j].w); }
    const float rstd = ((Q == 2) ? I8_SA : F8_SA) / sqrtf(wave_sum(s) * (1.f / DM) + EPS);
    unsigned* o4 = (unsigned*)orow + lane;
#pragma unroll
    for (int j = 0; j < 8; ++j) { const f32x4 gg = gr[64 * j]; o4[64 * j] = pk4_q<Q>(v[j].x * rstd * gg.x, v[j].y * rstd * gg.y, v[j].z * rstd * gg.z, v[j].w * rstd * gg.w); }
}
DI void ld_row_bf16(const bf16_t* row, int lane, f32x4 (&v)[8]) {
    const u32x2* p = (const u32x2*)row + lane;
#pragma unroll
    for (int j = 0; j < 8; ++j) { const u32x2 w = p[64 * j]; v[j].x = bflo(w.x); v[j].y = bfhi(w.x); v[j].z = bflo(w.y); v[j].w = bfhi(w.y); }
}
template <int Q> DI void rms_phase_f8_b(const Frame& F, const bf16_t* x, const float* g, unsigned char* out) {
    const int lane = F.lane; const f32x4* gr = (const f32x4*)g + 2 * lane;
    for (int m = 2 * F.gw; m < MT; m += 2 * F.NGW) {
        const u32x4* x0 = (const u32x4*)(x + (size_t)m * DM) + lane; const u32x4* x1 = x0 + DM / 8;
        u32x4 a[4], b[4];
#pragma unroll
        for (int j = 0; j < 4; ++j) { a[j] = x0[64 * j]; b[j] = x1[64 * j]; }
        float sa = 0.f, sb = 0.f;
#pragma unroll
        for (int j = 0; j < 4; ++j) {
            sa += (bflo(a[j].x) * bflo(a[j].x) + bfhi(a[j].x) * bfhi(a[j].x)) + (bflo(a[j].y) * bflo(a[j].y) + bfhi(a[j].y) * bfhi(a[j].y)) + (bflo(a[j].z) * bflo(a[j].z) + bfhi(a[j].z) * bfhi(a[j].z)) + (bflo(a[j].w) * bflo(a[j].w) + bfhi(a[j].w) * bfhi(a[j].w));
            sb += (bflo(b[j].x) * bflo(b[j].x) + bfhi(b[j].x) * bfhi(b[j].x)) + (bflo(b[j].y) * bflo(b[j].y) + bfhi(b[j].y) * bfhi(b[j].y)) + (bflo(b[j].z) * bflo(b[j].z) + bfhi(b[j].z) * bfhi(b[j].z)) + (bflo(b[j].w) * bflo(b[j].w) + bfhi(b[j].w) * bfhi(b[j].w)); }
        const float qs = (Q == 2) ? I8_SA : F8_SA;
        const float ra = qs / sqrtf(wave_sum(sa) * (1.f / DM) + EPS), rb = qs / sqrtf(wave_sum(sb) * (1.f / DM) + EPS);
        u32x2* o0 = (u32x2*)(out + (size_t)m * DM) + lane; u32x2* o1 = o0 + DM / 8;
#pragma unroll
        for (int j = 0; j < 4; ++j) { const f32x4 g0 = gr[128 * j], g1 = gr[128 * j + 1]; u32x2 w;
            w.x = pk4_q<Q>(bflo(a[j].x) * ra * g0.x, bfhi(a[j].x) * ra * g0.y, bflo(a[j].y) * ra * g0.z, bfhi(a[j].y) * ra * g0.w);
            w.y = pk4_q<Q>(bflo(a[j].z) * ra * g1.x, bfhi(a[j].z) * ra * g1.y, bflo(a[j].w) * ra * g1.z, bfhi(a[j].w) * ra * g1.w); o0[64 * j] = w;
            w.x = pk4_q<Q>(bflo(b[j].x) * rb * g0.x, bfhi(b[j].x) * rb * g0.y, bflo(b[j].y) * rb * g0.z, bfhi(b[j].y) * rb * g0.w);
            w.y = pk4_q<Q>(bflo(b[j].z) * rb * g1.x, bfhi(b[j].z) * rb * g1.y, bflo(b[j].w) * rb * g1.z, bfhi(b[j].w) * rb * g1.w); o1[64 * j] = w; }
    }
}
template <int Q> DI void rms_phase_f8(const Frame& F, const float* x, const float* g, unsigned char* out) {
    for (int m = F.gw; m < MT; m += F.NGW) rms_row_to_f8<Q>(x + (size_t)m * DM, g, out + (size_t)m * DM, F.lane);
}
DI void rms_phase(const Frame& F, const float* x, const float* g, bf16_t* out) {
    const int lane = F.lane; const f32x4* gr = (const f32x4*)g + lane;
    for (int m = 2 * F.gw; m < MT; m += 2 * F.NGW) {
        const f32x4* x0 = (const f32x4*)(x + (size_t)m * DM) + lane; const f32x4* x1 = x0 + DM / 4;
        f32x4 a[8], b[8]; float sa = 0.f, sb = 0.f;
#pragma unroll
        for (int j = 0; j < 8; ++j) { a[j] = x0[64 * j]; b[j] = x1[64 * j]; }
#pragma unroll
        for (int j = 0; j < 8; ++j) { sa += (a[j].x * a[j].x + a[j].y * a[j].y) + (a[j].z * a[j].z + a[j].w * a[j].w); sb += (b[j].x * b[j].x + b[j].y * b[j].y) + (b[j].z * b[j].z + b[j].w * b[j].w); }
        const float ra = 1.0f / sqrtf(wave_sum(sa) * (1.f / DM) + EPS), rb = 1.0f / sqrtf(wave_sum(sb) * (1.f / DM) + EPS);
        u32x2* o0 = (u32x2*)(out + (size_t)m * DM) + lane; u32x2* o1 = o0 + DM / 4;
#pragma unroll
        for (int j = 0; j < 8; ++j) { const f32x4 gg = gr[64 * j]; u32x2 w; w.x = pk2(a[j].x * ra * gg.x, a[j].y * ra * gg.y); w.y = pk2(a[j].z * ra * gg.z, a[j].w * ra * gg.w); o0[64 * j] = w;
            w.x = pk2(b[j].x * rb * gg.x, b[j].y * rb * gg.y); w.y = pk2(b[j].z * rb * gg.z, b[j].w * rb * gg.w); o1[64 * j] = w; }
    }
}
DI void p0_prologue(const Frame& F, const Args& a) {
    unsigned char* ws = F.ws;
#if I8_IN0
    tr_job_f8<2>(F, a.in[I_EWIN], 2048, EVEN_IN, EVEN_IN, ws + WS_WIN0, 2048, 0, 0, EVEN_INP);
#else
    tr_job(F, a.in[I_EWIN], 2048, EVEN_IN, EVEN_IN, EVEN_INP, (bf16_t*)(ws + WS_WIN0), 2048, 0, 0, 0);
#endif
    tr_job(F, a.in[I_EWQIDX], 512, 1024, 1024, 1024, (bf16_t*)(ws + WS_WQQ), 512, 0, 2048, 0);
    tr_job(F, a.in[I_EWOUT], 2048, 2048, 2048, 2048, (bf16_t*)(ws + WS_WOUT0), CAT0_K, 0, 0, 0);
#if F8_FFN0
    tr_job_f8<F8_FFN0>(F, a.in[I_EGATE], 2048, DFF, DFF, ws + WS_WGU0, 2048, 0, 1);
    tr_job_f8<F8_FFN0>(F, a.in[I_EUP], 2048, DFF, DFF, ws + WS_WGU0, 2048, 128, 1);
#else
    tr_job(F, a.in[I_EGATE], 2048, DFF, DFF, DFF, (bf16_t*)(ws + WS_WGU0), 2048, 0, 0, 1);
    tr_job(F, a.in[I_EUP], 2048, DFF, DFF, DFF, (bf16_t*)(ws + WS_WGU0), 2048, 0, 128, 1);
#endif
#if F8_FFN0_DN
    tr_job_f8(F, a.in[I_EDOWN], DFF, 2048, 2048, ws + WS_WDN0, DFF, 0, 0);
#else
    tr_job(F, a.in[I_EDOWN], DFF, 2048, 2048, 2048, (bf16_t*)(ws + WS_WDN0), DFF, 0, 0, 0);
#endif
#if I8_IN1
    tr_job_f8<2>(F, a.in[I_OWIN], 2048, ODD_IN, ODD_IN, ws + WS_WIN1, 2048, 0, 0);
#else
    tr_job(F, a.in[I_OWIN], 2048, ODD_IN, ODD_IN, ODD_IN, (bf16_t*)(ws + WS_WIN1), 2048, 0, 0, 0);
#endif
    tr_job(F, a.in[I_OWOUT], 2048, 2048, 2048, 2048, (bf16_t*)(ws + WS_WOUT1), 2048, 0, 0, 0);
    const int gt = F.bid * 512 + F.tid, NT = F.G * 512;
    { const float* uq = a.in[I_EWUQ]; const float* uk = a.in[I_EWUK]; bf16_t* o = (bf16_t*)(ws + WS_WQQ);
      for (int i = gt; i < 2048 * 512; i += NT) { const int n = i >> 9, r = i & 511, h = n >> 8, c = n & 255;
          const f32x4* pa = (const f32x4*)(uq + (size_t)r * 1024 + h * 128); const f32x4* pb = (const f32x4*)(uk + (size_t)c * 1024 + h * 128); float s = 0.f;
#pragma unroll 8
          for (int d = 0; d < 32; ++d) { const f32x4 x = pa[d], y = pb[d]; s += (x.x * y.x + x.y * y.y) + (x.z * y.z + x.w * y.w); }
          o[i] = (bf16_t)(pk2(s, 0.f) & 0xffffu); } }
    { const float* uv = a.in[I_EWUV]; bf16_t* o = (bf16_t*)(ws + WS_WUV);
      for (int i = gt; i < 8 * 128 * 256; i += NT) { const int e = i & 7, ln = (i >> 3) & 63, kk = (i >> 9) & 7, dblk = (i >> 12) & 7, hd = i >> 15;
          const int dout = 16 * dblk + (ln & 15), c = 32 * kk + 4 * (ln >> 4) + (e < 4 ? e : 12 + e);
          o[i] = (bf16_t)(pk2(uv[(size_t)c * 1024 + hd * 128 + dout], 0.f) & 0xffffu); } }
    { const float* w = a.in[I_OWS]; bf16_t* o = (bf16_t*)(ws + WS_WS);
      for (int i = gt; i < 8 * 128 * 128; i += NT) { const int t = (i >> 7) & 127, s = i & 127; o[i] = (bf16_t)(pk2(s <= t ? w[i] : 0.f, 0.f) & 0xffffu); } }
#if I8_IN0
    rms_phase_f8<2>(F, a.in[I_X], a.in[I_ENMIX], ws + WS_H0);
#else
    rms_phase(F, a.in[I_X], a.in[I_ENMIX], (bf16_t*)(ws + WS_H0));
#endif
}

constexpr int BG_ITEMS_PER_JOB = 224, BG_NJOBS = 24, BG_NITEMS = BG_ITEMS_PER_JOB * BG_NJOBS, BG_GU_ITEMS = BG_ITEMS_PER_JOB * 16;
constexpr int CW_BGQ = 12288;
constexpr int MISC_BG_STATE = 16, MISC_BG_ITEM = 17, MISC_BG_EMPTY = 18;
DI void bg_item(const Frame& F, const Args& a, int item) {
    const int job = item / BG_ITEMS_PER_JOB, sub = item % BG_ITEMS_PER_JOB;
    LAS float* scr = (LAS float*)(F.lds + F.wave * 16640);
    const int t0 = sub * 16 + F.wave * 2; f32x4 v0[16], v1[16];
    if (job < 16) { const int e = job >> 1, up = job & 1; const float* W = a.in[up ? I_OUP : I_OGATE] + (size_t)e * 2048 * DFFE; unsigned char* WT = F.ws + WS_WGU1 + (size_t)e * 2 * DFFE * 2048;
        tr_load(v0, W, DFFE, DFFE, DFFE / 64, t0, F.lane); tr_load(v1, W, DFFE, DFFE, DFFE / 64, t0 + 1, F.lane);
        tr_store_f8<2>(v0, WT, 2048, up ? 128 : 0, 1, DFFE / 64, scr, t0, F.lane); tr_store_f8<2>(v1, WT, 2048, up ? 128 : 0, 1, DFFE / 64, scr, t0 + 1, F.lane); }
    else { const int e = job - 16; const float* W = a.in[I_ODOWN] + (size_t)e * DFFE * 2048; unsigned char* WT = F.ws + WS_WDN1 + (size_t)e * 2048 * DFFE;
        tr_load(v0, W, 2048, 2048, 32, t0, F.lane); tr_load(v1, W, 2048, 2048, 32, t0 + 1, F.lane);
        tr_store_f8(v0, WT, DFFE, 0, 0, 32, scr, t0, F.lane); tr_store_f8(v1, WT, DFFE, 0, 0, 32, scr, t0 + 1, F.lane); }
}
DI int bg_step(const Frame& F, const Args& a, volatile LAS unsigned* MISC) {
    if (F.tid == 0) { int it = -1;
        if (MISC[MISC_BG_EMPTY] == 0u) { const unsigned q = __hip_atomic_fetch_add((unsigned*)(F.ws + WS_CTL) + CW_BGQ, 1u, __ATOMIC_RELAXED, __HIP_MEMORY_SCOPE_AGENT); if (q < (unsigned)BG_NITEMS) it = (int)q; else MISC[MISC_BG_EMPTY] = 1u; }
        MISC[MISC_BG_ITEM] = (unsigned)it; }
    __syncthreads();
    const int item = (int)MISC[MISC_BG_ITEM];
    if (item >= 0) bg_item(F, a, item);
    __syncthreads();
    return item;
}
DI void xcd_barrier_bg(const XcdBarrier& b, const Frame& F, const Args& a, volatile LAS unsigned* MISC) {
    asm volatile("s_waitcnt vmcnt(0)" ::: "memory");
    __syncthreads();
    unsigned gen = 0u;
    if (threadIdx.x == 0) {
        unsigned* bar = b.bar;
        __builtin_amdgcn_s_waitcnt(0);
        unsigned nloc = b.st[0], nx = b.st[1];
        if (nloc == 0u) { xcd_barrier_complete(bar, b.x, nloc, nx); b.st[0] = nloc; b.st[1] = nx; }
        const unsigned old = xb_add(&bar[XB_XSUB(b.x)], 1u);
        gen = old / nloc;
        if (old + 1u == (gen + 1u) * nloc) {
            __builtin_amdgcn_fence(__ATOMIC_RELEASE, "agent");
            asm volatile("s_waitcnt vmcnt(0)" ::: "memory");
            const unsigned og = xb_add(&bar[XB_TOP], 1u);
            const unsigned tg = og / nx;
            if (og + 1u == (tg + 1u) * nx) xb_add(&bar[XB_TOPGEN], 1u);
            else XB_SPIN(xb_ld(&bar[XB_TOPGEN]) == tg, bar);
            __builtin_amdgcn_fence(__ATOMIC_ACQUIRE, "agent");
            xb_add(&bar[XB_XGEN(b.x)], 1u);
            asm volatile("s_waitcnt vmcnt(0)" ::: "memory");
            MISC[MISC_BG_STATE] = 0u;
        } else MISC[MISC_BG_STATE] = 1u;
    }
    __syncthreads();
    const bool must_wait = MISC[MISC_BG_STATE] != 0u;
    __syncthreads();
    if (must_wait) {
        unsigned spins = 0u;
        for (;;) {
            if (threadIdx.x == 0) { unsigned* bar = b.bar; const bool rel = (xb_ld(&bar[XB_XGEN(b.x)]) != gen) || (xb_ld(&bar[XB_TMO]) != 0u);
                if (!rel && ++spins > XB_SPIN_CAP) atomicAdd(&bar[XB_TMO], 1u);
                MISC[MISC_BG_STATE] = rel ? 0u : 1u; }
            __syncthreads();
            const bool waiting = MISC[MISC_BG_STATE] != 0u;
            __syncthreads();
            if (!waiting) break;
            if (bg_step(F, a, MISC) < 0) __builtin_amdgcn_s_sleep(2);
        }
        if (threadIdx.x == 0) __builtin_amdgcn_fence(__ATOMIC_ACQUIRE, "agent");
        asm volatile("s_waitcnt vmcnt(0)" ::: "memory");
    }
    __syncthreads();
}

DI void p2_rows(const Frame& F, const Args& a) {
    const bf16_t* proj = (const bf16_t*)(F.ws + WS_PROJ0);
    bf16_t* cqn = (bf16_t*)(F.ws + WS_CQN); bf16_t* ckv = (bf16_t*)(F.ws + WS_CKV); bf16_t* kx = (bf16_t*)(F.ws + WS_KX); float* widx = (float*)(F.ws + WS_WIDX);
    bf16_t* cat = (bf16_t*)(F.ws + WS_CAT0);
    const float* gcq = a.in[I_ENCQ]; const float* gckv = a.in[I_ENCKV]; const float* cw = a.in[I_ECONV];
    const int lane = F.lane;
    float w0[2][8], w1[2][8], w2[2][8];
#pragma unroll
    for (int j = 0; j < 2; ++j)
#pragma unroll
        for (int e = 0; e < 8; ++e) { const int c = 512 * j + 8 * lane + e; w0[j][e] = cw[c]; w1[j][e] = cw[1024 + c]; w2[j][e] = cw[2048 + c]; }
    float gq[8], gk[8];
#pragma unroll
    for (int e = 0; e < 8; ++e) { gq[e] = gcq[8 * lane + e]; gk[e] = gckv[8 * (lane & 31) + e]; }
    for (int m = F.gw; m < MT; m += F.NGW) {
        const bf16_t* row = proj + (size_t)m * EVEN_INP;
        const int s = m & (SEQ - 1);
        { const u32x4 v = *(const u32x4*)(row + 3072 + 8 * lane); float f[8] = {bflo(v.x), bfhi(v.x), bflo(v.y), bfhi(v.y), bflo(v.z), bfhi(v.z), bflo(v.w), bfhi(v.w)}; float ss = 0.f;
#pragma unroll
          for (int e = 0; e < 8; ++e) ss += f[e] * f[e];
          const float rstd = 1.0f / sqrtf(wave_sum(ss) * (1.f / 512.f) + EPS);
          u32x4 o; o.x = pk2(f[0] * rstd * gq[0], f[1] * rstd * gq[1]); o.y = pk2(f[2] * rstd * gq[2], f[3] * rstd * gq[3]); o.z = pk2(f[4] * rstd * gq[4], f[5] * rstd * gq[5]); o.w = pk2(f[6] * rstd * gq[6], f[7] * rstd * gq[7]);
          *(u32x4*)(cqn + (size_t)m * 512 + 8 * lane) = o; }
        { const u32x4 v = *(const u32x4*)(row + 3584 + 8 * (lane & 31)); float f[8] = {bflo(v.x), bfhi(v.x), bflo(v.y), bfhi(v.y), bflo(v.z), bfhi(v.z), bflo(v.w), bfhi(v.w)}; float ss = 0.f;
#pragma unroll
          for (int e = 0; e < 8; ++e) ss += f[e] * f[e];
          const float rstd = 1.0f / sqrtf(wave_sum(ss) * (0.5f / 256.f) + EPS);
          u32x4 o; o.x = pk2(f[0] * rstd * gk[0], f[1] * rstd * gk[1]); o.y = pk2(f[2] * rstd * gk[2], f[3] * rstd * gk[3]); o.z = pk2(f[4] * rstd * gk[4], f[5] * rstd * gk[5]); o.w = pk2(f[6] * rstd * gk[6], f[7] * rstd * gk[7]);
          if (lane < 32) *(u32x4*)(ckv + (size_t)m * 256 + 8 * lane) = o; }
        if (lane < 8) *(u32x4*)(kx + (size_t)m * 64 + 8 * lane) = *(const u32x4*)(row + 3840 + 8 * lane);
        if (lane < 16) widx[(size_t)m * 16 + lane] = bf2f(row[3904 + lane]) * (0.125f * 0.25f);
#pragma unroll
        for (int j = 0; j < 2; ++j) { const int c0 = 512 * j + 8 * lane; float acc[8];
            { const u32x4 vc = *(const u32x4*)(row + 1024 + c0), vx = *(const u32x4*)(row + 2048 + c0);
              const float fc[8] = {bflo(vc.x), bfhi(vc.x), bflo(vc.y), bfhi(vc.y), bflo(vc.z), bfhi(vc.z), bflo(vc.w), bfhi(vc.w)}, fx[8] = {bflo(vx.x), bfhi(vx.x), bflo(vx.y), bfhi(vx.y), bflo(vx.z), bfhi(vx.z), bflo(vx.w), bfhi(vx.w)};
#pragma unroll
              for (int e = 0; e < 8; ++e) acc[e] = w2[j][e] * (fc[e] * fx[e]); }
            if (s >= 1) { const bf16_t* r1 = row - EVEN_INP; const u32x4 vc = *(const u32x4*)(r1 + 1024 + c0), vx = *(const u32x4*)(r1 + 2048 + c0);
              const float fc[8] = {bflo(vc.x), bfhi(vc.x), bflo(vc.y), bfhi(vc.y), bflo(vc.z), bfhi(vc.z), bflo(vc.w), bfhi(vc.w)}, fx[8] = {bflo(vx.x), bfhi(vx.x), bflo(vx.y), bfhi(vx.y), bflo(vx.z), bfhi(vx.z), bflo(vx.w), bfhi(vx.w)};
#pragma unroll
              for (int e = 0; e < 8; ++e) acc[e] += w1[j][e] * (fc[e] * fx[e]); }
            if (s >= 2) { const bf16_t* r2 = row - 2 * EVEN_INP; const u32x4 vc = *(const u32x4*)(r2 + 1024 + c0), vx = *(const u32x4*)(r2 + 2048 + c0);
              const float fc[8] = {bflo(vc.x), bfhi(vc.x), bflo(vc.y), bfhi(vc.y), bflo(vc.z), bfhi(vc.z), bflo(vc.w), bfhi(vc.w)}, fx[8] = {bflo(vx.x), bfhi(vx.x), bflo(vx.y), bfhi(vx.y), bflo(vx.z), bfhi(vx.z), bflo(vx.w), bfhi(vx.w)};
#pragma unroll
              for (int e = 0; e < 8; ++e) acc[e] += w0[j][e] * (fc[e] * fx[e]); }
            const u32x4 vb = *(const u32x4*)(row + c0); const float fb[8] = {bflo(vb.x), bfhi(vb.x), bflo(vb.y), bfhi(vb.y), bflo(vb.z), bfhi(vb.z), bflo(vb.w), bfhi(vb.w)};
            u32x4 o; o.x = pk2(fb[0] * acc[0], fb[1] * acc[1]); o.y = pk2(fb[2] * acc[2], fb[3] * acc[3]); o.z = pk2(fb[4] * acc[4], fb[5] * acc[5]); o.w = pk2(fb[6] * acc[6], fb[7] * acc[7]);
            *(u32x4*)(cat + (size_t)m * CAT0_K + c0) = o; }
    }
}

DI unsigned kx_lds_off(int key_local, int ch) { const int R = key_local >> 1, C = ((key_local & 1) << 3) | ch; return (unsigned)(R * 256 + ((C ^ (R & 15)) << 4)); }
DI void p4_indexer(const Frame& F) {
    const bf16_t* qq = (const bf16_t*)(F.ws + WS_QQ); const bf16_t* kx = (const bf16_t*)(F.ws + WS_KX); const float* widx = (const float*)(F.ws + WS_WIDX);
    _Float16* sc = (_Float16*)(F.ws + WS_SC);
    const int lane = F.lane, r = lane & 31, h = lane >> 5, w = F.wave, tid = F.tid;
    LAS unsigned char* kb = F.lds;
    const unsigned st_off = kx_lds_off(tid >> 3, tid & 7);
    unsigned rd_off[4];
#pragma unroll
    for (int s = 0; s < 4; ++s) rd_off[s] = kx_lds_off(r, 2 * s + h);
    const int nunits = NB * (SEQ / 16);
    for (int rd = 0; rd * F.G < nunits; ++rd) {
        const int j = (rd & 1) ? (F.G - 1 - F.bid) : F.bid; const int u = rd * F.G + j; if (u >= nunits) continue;
        const int qg = (SEQ / 16 - 1) - u / NB, b = u % NB;
        const int t0 = qg * 16, t1 = ((t0 >> 7) + 1) << 7;
        const int tq = t0 + 2 * w + (r >> 4), g = r & 15;
        bf16x8 aq[4];
#pragma unroll
        for (int s = 0; s < 4; ++s) aq[s] = *(const bf16x8*)(qq + (size_t)(b * SEQ + tq) * QQ_N + 2048 + g * 64 + 16 * s + 8 * h);
        float wts[16];
#pragma unroll
        for (int i = 0; i < 16; ++i) wts[i] = widx[(size_t)(b * SEQ + t0 + 2 * w + (i >> 3)) * 16 + ((i & 3) + 8 * ((i >> 2) & 1) + 4 * h)];
        const int tme = t0 + 2 * w + h;
        unsigned kv[64];
#pragma unroll
        for (int c = 0; c < 4; ++c) {
            if (512 * c < t1) {
                __syncthreads();
                { const bf16_t* src = kx + (size_t)(b * SEQ + 512 * c) * 64 + tid * 8;
#pragma unroll
                  for (int i = 0; i < 8; ++i) if (512 * c + 64 * i < t1) *(LAS u32x4*)(kb + st_off + 8192 * i) = *(const u32x4*)(src + 4096 * i); }
                __syncthreads();
            }
#pragma unroll
            for (int q = 0; q < 4; ++q) {
                if (512 * c + 128 * q < t1) {
#pragma unroll
                    for (int jj = 0; jj < 4; ++jj) { const int jn = 4 * q + jj, n = 16 * c + jn;
                        f32x16 acc;
#pragma unroll
                        for (int i = 0; i < 16; ++i) acc[i] = 0.f;
#pragma unroll
                        for (int s = 0; s < 4; ++s) { const bf16x8 bk = *(const LAS bf16x8*)(kb + rd_off[s] + 4096 * jn); acc = __builtin_amdgcn_mfma_f32_32x32x16_bf16(aq[s], bk, acc, 0, 0, 0); }
                        float p0 = 0.f, p1 = 0.f;
#pragma unroll
                        for (int i = 0; i < 8; ++i) { p0 += wts[i] * fmaxf(acc[i], 0.f); p1 += wts[8 + i] * fmaxf(acc[8 + i], 0.f); }
                        float tot; { unsigned a = f2u(p0), b = f2u(p1); auto sw = __builtin_amdgcn_permlane32_swap(a, b, false, false); tot = u2f(sw[0]) + u2f(sw[1]); }
                        if (32 * n + r > tme) tot = -__builtin_inff();
                        const unsigned ub = __builtin_bit_cast(unsigned, tot);
                        kv[n] = (ub & 0x80000000u) ? ~ub : (ub | 0x80000000u);
                        __builtin_amdgcn_sched_barrier(0);
                    }
                } else {
#pragma unroll
                    for (int jj = 0; jj < 4; ++jj) kv[16 * c + 4 * q + jj] = 0u;
                }
            }
        }
        unsigned T = 0u;
        if (t1 > 256) {
            unsigned Tlo = 0u, Thi = 0u; bool dlo = false, dhi = false;
            for (int bit = 31; bit >= 0; --bit) { const unsigned clo = Tlo | (1u << bit), chi = Thi | (1u << bit); const unsigned cand = h ? chi : clo; int cnt = 0;
#pragma unroll
                for (int n = 0; n < 64; ++n) cnt += (kv[n] >= cand) ? 1 : 0;
                cnt += __builtin_amdgcn_update_dpp(0, cnt, 0xB1, 0xf, 0xf, true);
                cnt += __builtin_amdgcn_update_dpp(0, cnt, 0x4E, 0xf, 0xf, true);
                cnt += __builtin_amdgcn_update_dpp(0, cnt, 0x141, 0xf, 0xf, true);
                cnt += __builtin_amdgcn_update_dpp(0, cnt, 0x140, 0xf, 0xf, true);
                const int nlo = __builtin_amdgcn_readlane(cnt, 0) + __builtin_amdgcn_readlane(cnt, 16), nhi = __builtin_amdgcn_readlane(cnt, 32) + __builtin_amdgcn_readlane(cnt, 48);
                if (!dlo) { Tlo = (nlo >= 256) ? clo : Tlo; dlo = (nlo == 256); }
                if (!dhi) { Thi = (nhi >= 256) ? chi : Thi; dhi = (nhi == 256); }
                if (dlo && dhi) break; }
            T = h ? Thi : Tlo;
        }
        _Float16* orow = sc + (size_t)(b * SEQ + tme) * SEQ;
#pragma unroll
        for (int q = 0; q < 16; ++q) if (128 * q < t1) {
#pragma unroll
            for (int jj = 0; jj < 4; ++jj) { const int n = 4 * q + jj; const unsigned k = kv[n]; const bool sel = (k >= T) && (k > 0x007fffffu);
                const unsigned ub = (k & 0x80000000u) ? (k ^ 0x80000000u) : ~k; const float v = sel ? __builtin_bit_cast(float, ub) * 1.44269504f : -__builtin_inff();
                orow[32 * n + r] = (_Float16)v; } }
    }
    __syncthreads();
}

DI unsigned kv_off(int row, int ch) { return (unsigned)(512 * row + 16 * (ch ^ (2 * (row & 7)))); }
DI s16x4 tr_read4(const LAS unsigned char* p) { return __builtin_amdgcn_ds_read_tr16_b64_v4i16((LAS s16x4*)p); }
DI bf16x8 cat8(s16x4 a, s16x4 b) { bf16x8 v; v[0] = a[0]; v[1] = a[1]; v[2] = a[2]; v[3] = a[3]; v[4] = b[0]; v[5] = b[1]; v[6] = b[2]; v[7] = b[3]; return v; }
DI bf16x8 pack8(float a0, float a1, float a2, float a3, float a4, float a5, float a6, float a7) { u32x4 w; w.x = pk2(a0, a1); w.y = pk2(a2, a3); w.z = pk2(a4, a5); w.w = pk2(a6, a7); return __builtin_bit_cast(bf16x8, w); }
DI void p5_dsa(const Frame& F, const Args& a) {
    const bf16_t* qq = (const bf16_t*)(F.ws + WS_QQ); const bf16_t* ckv = (const bf16_t*)(F.ws + WS_CKV); const _Float16* sc = (const _Float16*)(F.ws + WS_SC);
    bf16_t* cat = (bf16_t*)(F.ws + WS_CAT0); const bf16_t* wuv = (const bf16_t*)(F.ws + WS_WUV);
    const int lane = F.lane, r = lane & 31, h = lane >> 5, tid = F.tid, dh = F.wave & 1;
    const int q4 = (lane & 15) >> 2, p4 = lane & 3, blk = (lane >> 4) & 1;
    LAS unsigned char* kvb = F.lds;
    LAS unsigned char* scb = F.lds + 32768;
    LAS float* lut = (LAS float*)(F.lds + 40960);
    __syncthreads();
    for (int i = tid; i < 8 * 129; i += 512) { const int hd = i / 129, d = i % 129; int bk = d;
        if (d >= 16) { bk = 16 + (int)(logf((float)d / 16.0f) / 2.0794415416798357f * 16.0f); bk = bk > 31 ? 31 : bk; }
        lut[hd * 132 + d] = a.in[I_RELB][bk * 8 + hd] * 1.44269504f; }
    __syncthreads();
    const float SC2 = 0.08838834764831845f * 1.44269504f;
    const int nunits = NB * (SEQ / 32) * 2;
    for (int rd = 0; rd * F.G < nunits; ++rd) {
        const int j = (rd & 1) ? (F.G - 1 - F.bid) : F.bid; const int u = rd * F.G + j; if (u >= nunits) continue;
        const int hg = u & 1, u2 = u >> 1, head = 4 * hg + (F.wave >> 1);
        const int qt = (SEQ / 32 - 1) - u2 / NB, b = u2 % NB, q0 = qt * 32, nkt = qt + 1, tq = q0 + r;
        bf16x8 qf[16];
#pragma unroll
        for (int s = 0; s < 16; ++s) qf[s] = *(const bf16x8*)(qq + (size_t)(b * SEQ + tq) * QQ_N + head * 256 + 16 * s + 8 * h);
        f32x16 O[4];
#pragma unroll
        for (int c = 0; c < 4; ++c)
#pragma unroll
            for (int i = 0; i < 16; ++i) O[c][i] = 0.f;
        float m_run = -__builtin_inff(), l_run = 0.f;
        u32x4 st0, st1; u32x2 st2 = {0u, 0u};
        const int skey0 = tid >> 5, sch = tid & 31, sq = tid >> 3, spc = tid & 7;
#define DSA_LOAD(kt) do { const bf16_t* src = ckv + (size_t)(b * SEQ + 32 * (kt)) * 256; st0 = *(const u32x4*)(src + (size_t)skey0 * 256 + 8 * sch); st1 = *(const u32x4*)(src + (size_t)(skey0 + 16) * 256 + 8 * sch); \
        if (tid < 256) st2 = *(const u32x2*)(sc + (size_t)(b * SEQ + q0 + sq) * SEQ + 32 * (kt) + 4 * spc); } while (0)
#define DSA_WRITE(bufi) do { LAS unsigned char* kd_ = kvb + (bufi) * 16384; *(LAS u32x4*)(kd_ + kv_off(skey0, sch)) = st0; *(LAS u32x4*)(kd_ + kv_off(skey0 + 16, sch)) = st1; \
        if (tid < 256) *(LAS u32x2*)(scb + (bufi) * 2304 + sq * 72 + spc * 8) = st2; } while (0)
        __syncthreads();
        DSA_LOAD(0); DSA_WRITE(0);
        __syncthreads();
        for (int kt = 0; kt < nkt; ++kt) {
            const int cur = kt & 1;
            if (kt + 1 < nkt) DSA_LOAD(kt + 1);
            const LAS unsigned char* kd = kvb + cur * 16384; const LAS unsigned char* sd = scb + cur * 2304;
            f32x16 S;
#pragma unroll
            for (int i = 0; i < 16; ++i) S[i] = 0.f;
#pragma unroll
            for (int s = 0; s < 16; ++s) { const bf16x8 kf = *(const LAS bf16x8*)(kd + kv_off(r, 2 * s + h)); S = __builtin_amdgcn_mfma_f32_32x32x16_bf16(kf, qf[s], S, 0, 0, 0); if ((s & 3) == 3) __builtin_amdgcn_sched_barrier(0); }
            float mx = -__builtin_inff();
            const bool far = (32 * kt + 31 + 128 <= q0);
            const float bfar = lut[head * 132 + 128];
#pragma unroll
            for (int gq = 0; gq < 4; ++gq) { const u32x2 iw = *(const LAS u32x2*)(sd + r * 72 + (2 * gq + h) * 8);
                const _Float16 h0 = __builtin_bit_cast(_Float16, (unsigned short)(iw.x & 0xffffu)), h1 = __builtin_bit_cast(_Float16, (unsigned short)(iw.x >> 16)), h2 = __builtin_bit_cast(_Float16, (unsigned short)(iw.y & 0xffffu)), h3 = __builtin_bit_cast(_Float16, (unsigned short)(iw.y >> 16));
                const float idx[4] = {(float)h0, (float)h1, (float)h2, (float)h3};
                if (far) {
#pragma unroll
                    for (int e = 0; e < 4; ++e) { const int i = 4 * gq + e; const float x = S[i] * SC2 + idx[e]; S[i] = x; mx = fmaxf(mx, x); }
                } else {
#pragma unroll
                    for (int e = 0; e < 4; ++e) { const int i = 4 * gq + e, key = 32 * kt + 8 * gq + 4 * h + e; int dist = tq - key; dist = dist < 0 ? 0 : (dist > 128 ? 128 : dist);
                        const float x = S[i] * SC2 + idx[e] + (lut[head * 132 + dist] - bfar); S[i] = x; mx = fmaxf(mx, x); }
                } }
            mx = fmaxf(mx, __shfl_xor(mx, 32));
            const float m_new = fmaxf(m_run, mx), msafe = (m_new == -__builtin_inff()) ? 0.f : m_new, alpha = fast_exp2(m_run - msafe);
            float rs = 0.f;
#pragma unroll
            for (int i = 0; i < 16; ++i) { S[i] = fast_exp2(S[i] - msafe); rs += S[i]; }
            rs += __shfl_xor(rs, 32);
            l_run = l_run * alpha + rs; m_run = m_new;
            if (__builtin_amdgcn_ballot_w64(alpha != 1.0f) != 0ull) {
#pragma unroll
                for (int c = 0; c < 4; ++c)
#pragma unroll
                    for (int i = 0; i < 16; ++i) O[c][i] *= alpha;
            }
            const bf16x8 pf0 = pack8(S[0], S[1], S[2], S[3], S[4], S[5], S[6], S[7]), pf1 = pack8(S[8], S[9], S[10], S[11], S[12], S[13], S[14], S[15]);
#pragma unroll
            for (int c = 0; c < 4; ++c) {
                const int chn = 4 * (4 * dh + c) + 2 * blk + (p4 >> 1), bo = 8 * (p4 & 1);
                const bf16x8 v0 = cat8(tr_read4(kd + kv_off(0 + 4 * h + q4, chn) + bo), tr_read4(kd + kv_off(8 + 4 * h + q4, chn) + bo));
                const bf16x8 v1 = cat8(tr_read4(kd + kv_off(16 + 4 * h + q4, chn) + bo), tr_read4(kd + kv_off(24 + 4 * h + q4, chn) + bo));
                O[c] = __builtin_amdgcn_mfma_f32_32x32x16_bf16(v0, pf0, O[c], 0, 0, 0);
                O[c] = __builtin_amdgcn_mfma_f32_32x32x16_bf16(v1, pf1, O[c], 0, 0, 0);
                __builtin_amdgcn_sched_barrier(0);
            }
            if (kt + 1 < nkt) DSA_WRITE(cur ^ 1);
            __syncthreads();
        }
#undef DSA_LOAD
#undef DSA_WRITE
        const float inv = 1.0f / l_run;
        bf16x8 pf[4][2];
#pragma unroll
        for (int c = 0; c < 4; ++c) { pf[c][0] = pack8(O[c][0] * inv, O[c][1] * inv, O[c][2] * inv, O[c][3] * inv, O[c][4] * inv, O[c][5] * inv, O[c][6] * inv, O[c][7] * inv);
            pf[c][1] = pack8(O[c][8] * inv, O[c][9] * inv, O[c][10] * inv, O[c][11] * inv, O[c][12] * inv, O[c][13] * inv, O[c][14] * inv, O[c][15] * inv); }
        const bf16_t* wu = wuv + (size_t)head * 128 * 256 + (size_t)r * 256 + 128 * dh + 4 * h;
        LAS float* xch = (LAS float*)(F.lds + 49152) + (F.wave >> 1) * 4096;
#pragma unroll
        for (int db = 0; db < 4; ++db) { f32x16 D;
#pragma unroll
            for (int i = 0; i < 16; ++i) D[i] = 0.f;
#pragma unroll
            for (int c = 0; c < 4; ++c)
#pragma unroll
                for (int s2 = 0; s2 < 2; ++s2) { const bf16_t* p = wu + (size_t)(32 * db) * 256 + 32 * c + 16 * s2;
                    const u32x2 lo = *(const u32x2*)p, hi = *(const u32x2*)(p + 8); u32x4 w; w.x = lo.x; w.y = lo.y; w.z = hi.x; w.w = hi.y;
                    D = __builtin_amdgcn_mfma_f32_32x32x16_bf16(__builtin_bit_cast(bf16x8, w), pf[c][s2], D, 0, 0, 0); }
            if (dh) {
#pragma unroll
                for (int i = 0; i < 16; ++i) xch[(db * 16 + i) * 64 + lane] = D[i];
            } else O[db] = D; }
        __syncthreads();
        if (!dh) { bf16_t* orow = cat + (size_t)(b * SEQ + tq) * CAT0_K + 1024 + head * 128;
#pragma unroll
            for (int db = 0; db < 4; ++db)
#pragma unroll
                for (int gq = 0; gq < 4; ++gq) { float v[4];
#pragma unroll
                    for (int e = 0; e < 4; ++e) v[e] = O[db][4 * gq + e] + xch[(db * 16 + 4 * gq + e) * 64 + lane];
                    u32x2 w; w.x = pk2(v[0], v[1]); w.y = pk2(v[2], v[3]); *(u32x2*)(orow + 32 * db + 8 * gq + 4 * h) = w; } }
    }
    __syncthreads();
}

DI void p5_dsa16(const Frame& F, const Args& a) {
    const bf16_t* qq = (const bf16_t*)(F.ws + WS_QQ); const bf16_t* ckv = (const bf16_t*)(F.ws + WS_CKV); const _Float16* sc = (const _Float16*)(F.ws + WS_SC);
    bf16_t* cat = (bf16_t*)(F.ws + WS_CAT0); const bf16_t* wuv = (const bf16_t*)(F.ws + WS_WUV);
    const int lane = F.lane, c16 = lane & 15, g = lane >> 4, tid = F.tid, qh = F.wave & 1;
    const int q4 = c16 >> 2, p4 = lane & 3;
    LAS unsigned char* kvb = F.lds;
    LAS unsigned char* scb = F.lds + 65536;
    LAS float* lut = (LAS float*)(F.lds + 75776);
    __syncthreads();
    for (int i = tid; i < 8 * 129; i += 512) { const int hd = i / 129, d = i % 129; int bk = d;
        if (d >= 16) { bk = 16 + (int)(logf((float)d / 16.0f) / 2.0794415416798357f * 16.0f); bk = bk > 31 ? 31 : bk; }
        lut[hd * 132 + d] = a.in[I_RELB][bk * 8 + hd] * 1.44269504f; }
    __syncthreads();
    const float SC2 = 0.08838834764831845f * 1.44269504f;
    unsigned kro[2][8], tro[2][16];
#pragma unroll
    for (int s = 0; s < 8; ++s) { kro[0][s] = kv_off(c16, 4 * s + g); kro[1][s] = kv_off(16 + c16, 4 * s + g); }
#pragma unroll
    for (int db = 0; db < 16; ++db) { tro[0][db] = kv_off(4 * g + q4, 2 * db + (p4 >> 1)) + 8 * (p4 & 1); tro[1][db] = kv_off(16 + 4 * g + q4, 2 * db + (p4 >> 1)) + 8 * (p4 & 1); }
    const int nunits = NB * (SEQ / 32) * 2;
    for (int rd = 0; rd * F.G < nunits; ++rd) {
        const int j = (rd & 1) ? (F.G - 1 - F.bid) : F.bid; const int u = rd * F.G + j; if (u >= nunits) continue;
        const int hg = u & 1, u2 = u >> 1, head = 4 * hg + (F.wave >> 1);
        const int qt = (SEQ / 32 - 1) - u2 / NB, b = u2 % NB, q0 = qt * 32, nk2 = (qt >> 1) + 1, tq = q0 + 16 * qh + c16;
        bf16x8 qf[8];
#pragma unroll
        for (int s = 0; s < 8; ++s) qf[s] = *(const bf16x8*)(qq + (size_t)(b * SEQ + tq) * QQ_N + head * 256 + 32 * s + 8 * g);
        f32x4 O[16];
#pragma unroll
        for (int db = 0; db < 16; ++db) O[db] = (f32x4){0.f, 0.f, 0.f, 0.f};
        float m_run = -__builtin_inff(), l_run = 0.f;
        u32x4 st[4]; u32x2 st2;
        const int skey0 = tid >> 5, sch = tid & 31, sq = tid >> 4, spc = tid & 15;
        unsigned wo[4];
#pragma unroll
        for (int i = 0; i < 4; ++i) wo[i] = (unsigned)((i >> 1) * 16384) + kv_off(skey0 + 16 * (i & 1), sch);
        const unsigned wo2 = sq * 136 + spc * 8;
#define DSA_LOAD(k2) do { const bf16_t* src = ckv + (size_t)(b * SEQ + 64 * (k2)) * 256 + (size_t)skey0 * 256 + 8 * sch; \
        _Pragma("unroll") for (int i = 0; i < 4; ++i) st[i] = *(const u32x4*)(src + (size_t)(16 * i) * 256); \
        st2 = *(const u32x2*)(sc + (size_t)(b * SEQ + q0 + sq) * SEQ + 64 * (k2) + 4 * spc); } while (0)
#define DSA_WRITE(bufi) do { LAS unsigned char* kd_ = kvb + (bufi) * 32768; _Pragma("unroll") for (int i = 0; i < 4; ++i) *(LAS u32x4*)(kd_ + wo[i]) = st[i]; \
        *(LAS u32x2*)(scb + (bufi) * 4352 + wo2) = st2; } while (0)
        __syncthreads();
        DSA_LOAD(0); DSA_WRITE(0);
        __syncthreads();
        for (int k2 = 0; k2 < nk2; ++k2) {
            const int cur = k2 & 1;
            if (k2 + 1 < nk2) DSA_LOAD(k2 + 1);
            const LAS unsigned char* kd = kvb + cur * 32768; const LAS unsigned char* sd = scb + cur * 4352 + (16 * qh + c16) * 136 + 8 * g;
            f32x4 S[4];
#pragma unroll
            for (int i = 0; i < 4; ++i) S[i] = (f32x4){0.f, 0.f, 0.f, 0.f};
            __builtin_amdgcn_s_setprio(1);
#pragma unroll
            for (int sp = 0; sp < 4; ++sp) {
                bf16x8 kf[8];
#pragma unroll
                for (int t = 0; t < 8; ++t) { const int s = 2 * sp + (t >> 2), i = t & 3; kf[t] = *(const LAS bf16x8*)(kd + (i >> 1) * 16384 + kro[i & 1][s]); }
                __builtin_amdgcn_sched_barrier(0);
#pragma unroll
                for (int t = 0; t < 8; ++t) { const int s = 2 * sp + (t >> 2), i = t & 3; S[i] = __builtin_amdgcn_mfma_f32_16x16x32_bf16(kf[t], qf[s], S[i], 0, 0, 0); }
                __builtin_amdgcn_sched_barrier(0);
            }
            __builtin_amdgcn_s_setprio(0);
            float x[16];
#pragma unroll
            for (int i = 0; i < 4; ++i) { const u32x2 iw = *(const LAS u32x2*)(sd + 32 * i);
                const _Float16 h0 = __builtin_bit_cast(_Float16, (unsigned short)(iw.x & 0xffffu)), h1 = __builtin_bit_cast(_Float16, (unsigned short)(iw.x >> 16)), h2 = __builtin_bit_cast(_Float16, (unsigned short)(iw.y & 0xffffu)), h3 = __builtin_bit_cast(_Float16, (unsigned short)(iw.y >> 16));
                x[4 * i] = S[i][0] * SC2 + (float)h0; x[4 * i + 1] = S[i][1] * SC2 + (float)h1; x[4 * i + 2] = S[i][2] * SC2 + (float)h2; x[4 * i + 3] = S[i][3] * SC2 + (float)h3; }
            const float bfar = lut[head * 132 + 128];
            if (!(64 * k2 + 63 + 128 <= q0)) {
#pragma unroll
                for (int e = 0; e < 16; ++e) { const int key = 64 * k2 + 16 * (e >> 2) + 4 * g + (e & 3); int dist = tq - key; dist = dist < 0 ? 0 : (dist > 128 ? 128 : dist); x[e] += lut[head * 132 + dist] - bfar; }
            }
            float mx = x[0];
#pragma unroll
            for (int e = 1; e < 16; ++e) mx = fmaxf(mx, x[e]);
            mx = xrow_max(mx);
            const float m_new = fmaxf(m_run, mx), msafe = (m_new == -__builtin_inff()) ? 0.f : m_new, alpha = fast_exp2(m_run - msafe);
            float rs = 0.f;
#pragma unroll
            for (int e = 0; e < 16; ++e) { x[e] = fast_exp2(x[e] - msafe); rs += x[e]; }
            rs = xrow_sum(rs);
            l_run = l_run * alpha + rs; m_run = m_new;
            if (__builtin_amdgcn_ballot_w64(alpha != 1.0f) != 0ull) {
#pragma unroll
                for (int db = 0; db < 16; ++db) O[db] = O[db] * alpha;
            }
            const bf16x8 pf0 = pack8(x[0], x[1], x[2], x[3], x[4], x[5], x[6], x[7]), pf1 = pack8(x[8], x[9], x[10], x[11], x[12], x[13], x[14], x[15]);
            __builtin_amdgcn_s_setprio(1);
#pragma unroll
            for (int dq = 0; dq < 4; ++dq) {
                bf16x8 v0[4], v1[4];
#pragma unroll
                for (int t = 0; t < 4; ++t) { const int db = 4 * dq + t; v0[t] = cat8(tr_read4(kd + tro[0][db]), tr_read4(kd + tro[1][db])); v1[t] = cat8(tr_read4(kd + 16384 + tro[0][db]), tr_read4(kd + 16384 + tro[1][db])); }
                __builtin_amdgcn_sched_barrier(0);
#pragma unroll
                for (int t = 0; t < 4; ++t) { const int db = 4 * dq + t; O[db] = __builtin_amdgcn_mfma_f32_16x16x32_bf16(v0[t], pf0, O[db], 0, 0, 0); }
#pragma unroll
                for (int t = 0; t < 4; ++t) { const int db = 4 * dq + t; O[db] = __builtin_amdgcn_mfma_f32_16x16x32_bf16(v1[t], pf1, O[db], 0, 0, 0); }
                __builtin_amdgcn_sched_barrier(0);
            }
            __builtin_amdgcn_s_setprio(0);
            if (k2 + 1 < nk2) DSA_WRITE(cur ^ 1);
            __syncthreads();
        }
#undef DSA_LOAD
#undef DSA_WRITE
        const float inv = 1.0f / l_run;
        bf16x8 of[8];
#pragma unroll
        for (int kk = 0; kk < 8; ++kk) of[kk] = pack8(O[2 * kk][0] * inv, O[2 * kk][1] * inv, O[2 * kk][2] * inv, O[2 * kk][3] * inv, O[2 * kk + 1][0] * inv, O[2 * kk + 1][1] * inv, O[2 * kk + 1][2] * inv, O[2 * kk + 1][3] * inv);
        const u32x4* wf = (const u32x4*)wuv + (size_t)head * 4096 + lane;
        bf16_t* orow = cat + (size_t)(b * SEQ + tq) * CAT0_K + 1024 + head * 128 + 4 * g;
#pragma unroll
        for (int dp = 0; dp < 4; ++dp) {
            u32x4 wa[16];
#pragma unroll
            for (int i = 0; i < 16; ++i) wa[i] = wf[(size_t)(16 * dp + i) * 64];
#pragma unroll
            for (int d2 = 0; d2 < 2; ++d2) { f32x4 D = {0.f, 0.f, 0.f, 0.f};
#pragma unroll
                for (int kk = 0; kk < 8; ++kk) D = __builtin_amdgcn_mfma_f32_16x16x32_bf16(__builtin_bit_cast(bf16x8, wa[8 * d2 + kk]), of[kk], D, 0, 0, 0);
                u32x2 w; w.x = pk2(D[0], D[1]); w.y = pk2(D[2], D[3]); *(u32x2*)(orow + 16 * (2 * dp + d2)) = w; } }
    }
    __syncthreads();
}

DI unsigned img_off(int row, int ch) { return (unsigned)(256 * row + 16 * (ch ^ (((row & 3) << 2) | ((row >> 2) & 3)))); }
DI void p12_gmlp(const Frame& F, const Args& a) {
    const bf16_t* proj = (const bf16_t*)(F.ws + WS_PROJ1); const bf16_t* wsm = (const bf16_t*)(F.ws + WS_WS); bf16_t* cat = (bf16_t*)(F.ws + WS_CAT1);
    const float* gv = a.in[I_ONV]; const float* bs = a.in[I_OBS];
    const int lane = F.lane, r = lane & 31, h = lane >> 5, w = F.wave, tid = F.tid;
    const int q4 = (lane & 15) >> 2, p4 = lane & 3, blk = (lane >> 4) & 1;
    LAS unsigned char* img = F.lds;
    LAS float* rs = (LAS float*)(F.lds + 32768);
    for (int u = F.bid; u < NB * (SEQ / 128); u += F.G) {
        const int b = u / (SEQ / 128), ch0 = u % (SEQ / 128); const size_t row0 = (size_t)b * SEQ + (size_t)ch0 * 128;
        __syncthreads();
        for (int i = 0; i < 16; ++i) { const int s = 16 * w + i; const bf16_t* vr = proj + (row0 + s) * ODD_IN + 1024; float ss = 0.f;
#pragma unroll
            for (int jj = 0; jj < 2; ++jj) { const u32x4 v = *(const u32x4*)(vr + 512 * jj + 8 * lane); const float f[8] = {bflo(v.x), bfhi(v.x), bflo(v.y), bfhi(v.y), bflo(v.z), bfhi(v.z), bflo(v.w), bfhi(v.w)};
#pragma unroll
                for (int e = 0; e < 8; ++e) ss += f[e] * f[e]; }
            ss = wave_sum(ss); if (lane == 0) rs[s] = 1.0f / sqrtf(ss * (1.f / 1024.f) + EPS); }
        __syncthreads();
        for (int g = 0; g < 8; ++g) {
#pragma unroll
            for (int i = 0; i < 4; ++i) { const int p = tid + 512 * i, s = p >> 4, chk = p & 15;
                const u32x4 v = *(const u32x4*)(proj + (row0 + s) * ODD_IN + 1024 + g * 128 + 8 * chk); const float rr = rs[s];
                const f32x4 g0 = *(const f32x4*)(gv + g * 128 + 8 * chk), g1 = *(const f32x4*)(gv + g * 128 + 8 * chk + 4);
                u32x4 o; o.x = pk2(bflo(v.x) * rr * g0.x, bfhi(v.x) * rr * g0.y); o.y = pk2(bflo(v.y) * rr * g0.z, bfhi(v.y) * rr * g0.w); o.z = pk2(bflo(v.z) * rr * g1.x, bfhi(v.z) * rr * g1.y); o.w = pk2(bflo(v.w) * rr * g1.z, bfhi(v.w) * rr * g1.w);
                *(LAS u32x4*)(img + (s >> 5) * 8192 + img_off(s & 31, chk)) = o; }
            __syncthreads();
            const int tb = w & 3, t = 32 * tb + r;
#pragma unroll
            for (int cc = 0; cc < 2; ++cc) { const int cb = 2 * (w >> 2) + cc;
                f32x16 D;
#pragma unroll
                for (int i = 0; i < 16; ++i) D[i] = 0.f;
                bf16x8 wfr[8];
#pragma unroll
                for (int ks = 0; ks < 8; ++ks) wfr[ks] = *(const bf16x8*)(wsm + (size_t)g * 16384 + (size_t)t * 128 + 16 * ks + 8 * h);
#pragma unroll
                for (int ks = 0; ks < 8; ++ks) if (ks <= 2 * tb + 1) {
                    const LAS unsigned char* im = img + (ks >> 1) * 8192; const int k2 = ks & 1;
                    const int chn = 4 * cb + 2 * blk + (p4 >> 1), bo = 8 * (p4 & 1);
                    const bf16x8 af = cat8(tr_read4(im + img_off(16 * k2 + 8 * h + 0 + q4, chn) + bo), tr_read4(im + img_off(16 * k2 + 8 * h + 4 + q4, chn) + bo));
                    D = __builtin_amdgcn_mfma_f32_32x32x16_bf16(af, wfr[ks], D, 0, 0, 0);
                }
                const float bias = bs[g * 128 + t];
                const bf16_t* urow = proj + (row0 + t) * ODD_IN + g * 128 + 32 * cb; bf16_t* orow = cat + (row0 + t) * 2048 + g * 128 + 32 * cb;
#pragma unroll
                for (int gq = 0; gq < 4; ++gq) { const u32x2 uu = *(const u32x2*)(urow + 8 * gq + 4 * h);
                    u32x2 o; o.x = pk2(bflo(uu.x) * (D[4 * gq] + bias), bfhi(uu.x) * (D[4 * gq + 1] + bias)); o.y = pk2(bflo(uu.y) * (D[4 * gq + 2] + bias), bfhi(uu.y) * (D[4 * gq + 3] + bias));
                    *(u32x2*)(orow + 8 * gq + 4 * h) = o; }
            }
            __syncthreads();
        }
    }
    __syncthreads();
}

DI bf16x8 scale_bf16x8(bf16x8 v, float sc) { const u32x4 w = __builtin_bit_cast(u32x4, v); u32x4 o;
    o.x = pk2(bflo(w.x) * sc, bfhi(w.x) * sc); o.y = pk2(bflo(w.y) * sc, bfhi(w.y) * sc); o.z = pk2(bflo(w.z) * sc, bfhi(w.z) * sc); o.w = pk2(bflo(w.w) * sc, bfhi(w.w) * sc); return __builtin_bit_cast(bf16x8, o); }
DI void p12_stick(const Frame& F) {
    const bf16_t* proj = (const bf16_t*)(F.ws + WS_PROJ1); bf16_t* cat = (bf16_t*)(F.ws + WS_CAT1);
    const int lane = F.lane, r = lane & 31, h = lane >> 5, w = F.wave, tid = F.tid;
    const int q4 = (lane & 15) >> 2, p4 = lane & 3, blk = (lane >> 4) & 1;
    LAS unsigned char* kb = F.lds;
    LAS unsigned char* vb = F.lds + 32768;
    const float SC2 = 0.08838834764831845f * 1.44269504f;
    const int nunits = NB * 8 * (SEQ / 256);
    for (int rd = 0; rd * F.G < nunits; ++rd) {
        const int j = (rd & 1) ? (F.G - 1 - F.bid) : F.bid; const int u = rd * F.G + j; if (u >= nunits) continue;
        const int qb = (SEQ / 256 - 1) - u / (NB * 8), bh = u % (NB * 8), b = bh >> 3, head = bh & 7;
        const int Q0 = qb * 256, tq = Q0 + 32 * w + r, ktd = (Q0 >> 5) + w, kt2_hi = (Q0 >> 6) + 3;
        const bf16_t* base = proj + (size_t)b * SEQ * ODD_IN + head * 128;
        bf16x8 qf[8];
#pragma unroll
        for (int s = 0; s < 8; ++s) qf[s] = scale_bf16x8(*(const bf16x8*)(base + (size_t)tq * ODD_IN + 2048 + 16 * s + 8 * h), SC2);
        f32x16 O[4];
#pragma unroll
        for (int c = 0; c < 4; ++c)
#pragma unroll
            for (int i = 0; i < 16; ++i) O[c][i] = 0.f;
        float R = 1.f;
        u32x4 st0, st1, st2, st3; const int skey = tid >> 4, sch = tid & 15;
#define SB_LOAD(kt2_) do { const bf16_t* src = base + (size_t)(64 * (kt2_) + skey) * ODD_IN + 8 * sch; st0 = *(const u32x4*)(src + 3072); st1 = *(const u32x4*)(src + 4096); \
        st2 = *(const u32x4*)(src + (size_t)32 * ODD_IN + 3072); st3 = *(const u32x4*)(src + (size_t)32 * ODD_IN + 4096); } while (0)
#define SB_WRITE(bufi) do { const unsigned o_ = (bufi) * 16384 + img_off(skey, sch); *(LAS u32x4*)(kb + o_) = st0; *(LAS u32x4*)(vb + o_) = st1; *(LAS u32x4*)(kb + o_ + 8192) = st2; *(LAS u32x4*)(vb + o_ + 8192) = st3; } while (0)
        __syncthreads();
        SB_LOAD(kt2_hi); SB_WRITE(0);
        __syncthreads();
        int cur = 0;
        for (int kt2 = kt2_hi; kt2 >= 0; --kt2) {
            if (kt2 > 0) SB_LOAD(kt2 - 1);
#pragma unroll
            for (int sub = 1; sub >= 0; --sub) { const int kt = 2 * kt2 + sub;
            if (kt <= ktd) {
                const LAS unsigned char* kd = kb + cur * 16384 + sub * 8192; const LAS unsigned char* vd = vb + cur * 16384 + sub * 8192;
                f32x16 S;
#pragma unroll
                for (int i = 0; i < 16; ++i) S[i] = 0.f;
                __builtin_amdgcn_s_setprio(1);
#pragma unroll
                for (int s = 0; s < 8; ++s) { const bf16x8 kf = *(const LAS bf16x8*)(kd + img_off(r, 2 * s + h)); S = __builtin_amdgcn_mfma_f32_32x32x16_bf16(kf, qf[s], S, 0, 0, 0); }
                __builtin_amdgcn_s_setprio(0);
                float kp[16], G[4];
                const bool diag = (kt == ktd);
                if (diag) {
#pragma unroll
                    for (int gq = 0; gq < 4; ++gq) { G[gq] = 1.f;
#pragma unroll
                        for (int e = 0; e < 4; ++e) { const int i = 4 * gq + e;
                            const float E = fast_exp2(fminf(S[i], 120.f)), keep = fast_rcp(1.0f + E); const bool past = (32 * kt + 8 * gq + 4 * h + e) < tq;
                            const float beta = past ? E * keep : 0.f, kk = past ? keep : 1.f;
                            kp[i] = kk; S[i] = beta; G[gq] *= kk; } }
                } else {
#pragma unroll
                    for (int gq = 0; gq < 4; ++gq) { G[gq] = 1.f;
#pragma unroll
                        for (int e = 0; e < 4; ++e) { const int i = 4 * gq + e;
                            const float E = fast_exp2(fminf(S[i], 120.f)), keep = fast_rcp(1.0f + E);
                            kp[i] = keep; S[i] = E * keep; G[gq] *= keep; } }
                }
                float PG[4];
#pragma unroll
                for (int gq = 0; gq < 4; ++gq) PG[gq] = xor32_get(G[gq], h);
                float hi = 1.f;
                float wv[16];
#pragma unroll
                for (int gq = 3; gq >= 0; --gq) { float run = R * hi * (h ? 1.f : PG[gq]);
#pragma unroll
                    for (int e = 3; e >= 0; --e) { const int i = 4 * gq + e; wv[i] = S[i] * run; run *= kp[i]; }
                    hi *= G[gq] * PG[gq]; }
                R *= hi;
                const bf16x8 pf0 = pack8(wv[0], wv[1], wv[2], wv[3], wv[4], wv[5], wv[6], wv[7]), pf1 = pack8(wv[8], wv[9], wv[10], wv[11], wv[12], wv[13], wv[14], wv[15]);
                __builtin_amdgcn_s_setprio(1);
#pragma unroll
                for (int c = 0; c < 4; ++c) {
                    const int chn = 4 * c + 2 * blk + (p4 >> 1), bo = 8 * (p4 & 1);
                    const bf16x8 v0 = cat8(tr_read4(vd + img_off(0 + 4 * h + q4, chn) + bo), tr_read4(vd + img_off(8 + 4 * h + q4, chn) + bo));
                    const bf16x8 v1 = cat8(tr_read4(vd + img_off(16 + 4 * h + q4, chn) + bo), tr_read4(vd + img_off(24 + 4 * h + q4, chn) + bo));
                    O[c] = __builtin_amdgcn_mfma_f32_32x32x16_bf16(v0, pf0, O[c], 0, 0, 0);
                    O[c] = __builtin_amdgcn_mfma_f32_32x32x16_bf16(v1, pf1, O[c], 0, 0, 0);
                }
                __builtin_amdgcn_s_setprio(0);
            } }
            if (kt2 > 0) SB_WRITE(cur ^ 1);
            __syncthreads();
            cur ^= 1;
        }
#undef SB_LOAD
#undef SB_WRITE
        bf16_t* orow = cat + (size_t)(b * SEQ + tq) * 2048 + 1024 + head * 128;
#pragma unroll
        for (int c = 0; c < 4; ++c)
#pragma unroll
            for (int gq = 0; gq < 4; ++gq) { u32x2 o; o.x = pk2(O[c][4 * gq], O[c][4 * gq + 1]); o.y = pk2(O[c][4 * gq + 2], O[c][4 * gq + 3]);
                *(u32x2*)(orow + 32 * c + 8 * gq + 4 * h) = o; }
    }
    __syncthreads();
}

DI void p14_router(const Frame& F, const Args& a, const bf16_t* x3) {
    unsigned char* h3 = F.ws + WS_H3; const float* gn = a.in[I_ONFFN]; const float* wr = a.in[I_OROUTER];
    int* tab_er = (int*)(F.ws + WS_TAB + TAB_ER); float* tab_gate = (float*)(F.ws + WS_TAB + TAB_GATE); unsigned* gcnt = (unsigned*)(F.ws + WS_CTL) + CW_CNT;
    const int lane = F.lane, w = F.wave, tid = F.tid;
    LAS float* wrT = (LAS float*)F.lds;
    LAS int* lcnt = (LAS int*)(F.lds + 65536);
    LAS int* lbase = lcnt + 8;
    LAS int* tokE = lcnt + 16;
    LAS int* tokR = tokE + 256;
    __syncthreads();
    for (int i = tid; i < 2048 * 8; i += 512) wrT[(i & 7) * 2048 + (i >> 3)] = wr[i];
    if (tid < 8) lcnt[tid] = 0;
    __syncthreads();
    for (int grp = F.bid; grp < MT / 128; grp += F.G) {
        for (int i = 0; i < 16; ++i) {
            const int tl = 16 * w + i, m = grp * 128 + tl;
            const f32x4* gr = (const f32x4*)gn + lane;
            f32x4 v[8]; float s = 0.f; ld_row_bf16(x3 + (size_t)m * DM, lane, v);
#pragma unroll
            for (int j = 0; j < 8; ++j) s += (v[j].x * v[j].x + v[j].y * v[j].y) + (v[j].z * v[j].z + v[j].w * v[j].w);
            const float rstd = 1.0f / sqrtf(wave_sum(s) * (1.f / DM) + EPS);
            unsigned* o4 = (unsigned*)(h3 + (size_t)m * DM) + lane;
#pragma unroll
            for (int j = 0; j < 8; ++j) { const f32x4 gg = gr[64 * j]; v[j].x *= rstd * gg.x; v[j].y *= rstd * gg.y; v[j].z *= rstd * gg.z; v[j].w *= rstd * gg.w;
                o4[64 * j] = pk4_i8(v[j].x * I8_SA, v[j].y * I8_SA, v[j].z * I8_SA, v[j].w * I8_SA); }
            float lg[8];
#pragma unroll
            for (int e = 0; e < 8; ++e) { float acc = 0.f;
#pragma unroll
                for (int j = 0; j < 8; ++j) { const f32x4 ww = *(const LAS f32x4*)(wrT + e * 2048 + 4 * (lane + 64 * j)); acc += (v[j].x * ww.x + v[j].y * ww.y) + (v[j].z * ww.z + v[j].w * ww.w); }
                lg[e] = wave_sum(acc); }
            int i1 = 0; float v1 = lg[0];
#pragma unroll
            for (int e = 1; e < 8; ++e) if (lg[e] > v1) { v1 = lg[e]; i1 = e; }
            int i2 = -1; float v2 = -__builtin_inff();
#pragma unroll
            for (int e = 0; e < 8; ++e) if (e != i1 && lg[e] > v2) { v2 = lg[e]; i2 = e; }
            if (lane == 0) {
                const float g1 = 1.0f / (1.0f + __expf(v2 - v1));
                tab_gate[(size_t)m * 2] = g1; tab_gate[(size_t)m * 2 + 1] = 1.0f - g1;
                tokE[tl * 2] = i1; tokE[tl * 2 + 1] = i2;
                tokR[tl * 2] = __hip_atomic_fetch_add(lcnt + i1, 1, __ATOMIC_RELAXED, __HIP_MEMORY_SCOPE_WORKGROUP);
                tokR[tl * 2 + 1] = __hip_atomic_fetch_add(lcnt + i2, 1, __ATOMIC_RELAXED, __HIP_MEMORY_SCOPE_WORKGROUP);
            }
        }
        __syncthreads();
        if (tid < 8) lbase[tid] = (int)__hip_atomic_fetch_add(gcnt + 64 * tid, (unsigned)lcnt[tid], __ATOMIC_RELAXED, __HIP_MEMORY_SCOPE_AGENT);
        __syncthreads();
        if (tid < 256) { const int e = tokE[tid]; tab_er[((size_t)grp * 128) * 4 + tid * 2] = e; tab_er[((size_t)grp * 128) * 4 + tid * 2 + 1] = lbase[e] + tokR[tid]; }
        __syncthreads();
        if (tid < 8) lcnt[tid] = 0;
        __syncthreads();
    }
}

DI void moe_tiles(const Frame& F, int (&ts)[9], int (&cnt)[8]) {
    const unsigned* gcnt = (const unsigned*)(F.ws + WS_CTL) + CW_CNT;
    ts[0] = 0;
#pragma unroll
    for (int e = 0; e < 8; ++e) { cnt[e] = (int)__builtin_amdgcn_readfirstlane(__hip_atomic_load(gcnt + 64 * e, __ATOMIC_RELAXED, __HIP_MEMORY_SCOPE_AGENT)); ts[e + 1] = ts[e] + ((cnt[e] + 255) >> 8); }
}

DI void p15_gather(const Frame& F) {
    const unsigned char* h3 = F.ws + WS_H3; bf16_t* hs = (bf16_t*)(F.ws + WS_HS);
    const int* tab_er = (const int*)(F.ws + WS_TAB + TAB_ER); int* tab_slot = (int*)(F.ws + WS_TAB + TAB_SLOT);
    int ts[9], cnt[8]; moe_tiles(F, ts, cnt);
    const int lane = F.lane;
    unsigned char* hs8 = (unsigned char*)hs;
    for (int m = F.gw; m < MT; m += F.NGW) {
        const u32x2* src = (const u32x2*)(h3 + (size_t)m * DM) + lane;
        u32x2 q[4];
#pragma unroll
        for (int j = 0; j < 4; ++j) q[j] = src[64 * j];
#pragma unroll
        for (int k = 0; k < 2; ++k) { const int e = tab_er[(size_t)m * 4 + 2 * k], rk = tab_er[(size_t)m * 4 + 2 * k + 1];
            int t0 = 0;
#pragma unroll
            for (int qq = 0; qq < 8; ++qq) t0 = (e == qq) ? ts[qq] : t0;
            const int slot = t0 * 256 + rk;
            u32x2* dst = (u32x2*)(hs8 + (size_t)slot * DM) + lane; dst[0] = q[0]; dst[64] = q[1]; dst[128] = q[2]; dst[192] = q[3];
            if (lane == 0) tab_slot[(size_t)m * 2 + k] = slot; }
    }
    for (int idx = F.gw; idx < 8 * 256; idx += F.NGW) { const int e = idx >> 8, rr = idx & 255; int t0 = 0, t1 = 0, c = 0;
#pragma unroll
        for (int qq = 0; qq < 8; ++qq) { t0 = (e == qq) ? ts[qq] : t0; t1 = (e == qq) ? ts[qq + 1] : t1; c = (e == qq) ? cnt[qq] : c; }
        const int row = t0 * 256 + c + rr;
        if (row < t1 * 256) { u32x2* dst = (u32x2*)(hs8 + (size_t)row * DM) + lane; const u32x2 z = {0u, 0u}; dst[0] = z; dst[64] = z; dst[128] = z; dst[192] = z; } }
}

DI void p22_final(const Frame& F, const Args& a, float* out) {
    const bf16_t* Y = (const bf16_t*)(F.ws + WS_Y); const float* tab_gate = (const float*)(F.ws + WS_TAB + TAB_GATE); const int* tab_slot = (const int*)(F.ws + WS_TAB + TAB_SLOT);
    const float* gn = a.in[I_FNORM]; const int lane = F.lane;
    for (int m = F.gw; m < MT; m += F.NGW) {
        const float g1 = tab_gate[(size_t)m * 2], g2 = tab_gate[(size_t)m * 2 + 1]; const int s1 = tab_slot[(size_t)m * 2], s2 = tab_slot[(size_t)m * 2 + 1];
        f32x4* xr = (f32x4*)(out + (size_t)m * DM) + lane; const u32x2* x3 = (const u32x2*)(F.ws + WS_XR + (size_t)m * DM * 2) + lane; const u32x2* y1 = (const u32x2*)(Y + (size_t)s1 * DM) + lane; const u32x2* y2 = (const u32x2*)(Y + (size_t)s2 * DM) + lane;
        const f32x4* gr = (const f32x4*)gn + lane;
        f32x4 v[8]; float s = 0.f;
#pragma unroll
        for (int j = 0; j < 8; ++j) { const u32x2 xw = x3[64 * j]; v[j].x = bflo(xw.x); v[j].y = bfhi(xw.x); v[j].z = bflo(xw.y); v[j].w = bfhi(xw.y); const u32x2 a1 = y1[64 * j], a2 = y2[64 * j];
            v[j].x += g1 * bflo(a1.x) + g2 * bflo(a2.x); v[j].y += g1 * bfhi(a1.x) + g2 * bfhi(a2.x); v[j].z += g1 * bflo(a1.y) + g2 * bflo(a2.y); v[j].w += g1 * bfhi(a1.y) + g2 * bfhi(a2.y);
            s += (v[j].x * v[j].x + v[j].y * v[j].y) + (v[j].z * v[j].z + v[j].w * v[j].w); }
        const float rstd = 1.0f / sqrtf(wave_sum(s) * (1.f / DM) + EPS);
#pragma unroll
        for (int j = 0; j < 8; ++j) { const f32x4 gg = gr[64 * j]; f32x4 o; o.x = v[j].x * rstd * gg.x; o.y = v[j].y * rstd * gg.y; o.z = v[j].z * rstd * gg.z; o.w = v[j].w * rstd * gg.w; xr[64 * j] = o; }
    }
}

constexpr int N_PHASES = 21;
__global__ void __launch_bounds__(512, 2) fwd(Args args) {
    extern __shared__ __attribute__((aligned(16))) unsigned char lds_raw[];
    Frame F;
    F.lds = (LAS unsigned char*)lds_raw; F.tid = threadIdx.x; F.lane = F.tid & 63; F.wave = __builtin_amdgcn_readfirstlane(F.tid >> 6);
    F.G = gridDim.x; F.bid = blockIdx.x; F.gw = F.bid * 8 + F.wave; F.NGW = F.G * 8; F.ws = args.ws;
    volatile LAS unsigned* MISC = (volatile LAS unsigned*)(F.lds + MISC_OFF);
    if (F.tid < 64) MISC[F.tid] = 0u;
    __syncthreads();
    const int lo = args.ph_lo, hi = args.ph_hi;
    XcdBarrier bar; bar.bar = (unsigned*)(F.ws + WS_CTL) + CW_BAR; bar.x = 0; bar.st = MISC + 8;
    if (hi - lo > 1) bar = xcd_barrier_post((unsigned*)(F.ws + WS_CTL) + CW_BAR, MISC + 8);
#ifdef ONLY_PHASE
#define IN(k) ((k) == ONLY_PHASE && lo <= (k) && (k) < hi)
#else
#define IN(k) (lo <= (k) && (k) < hi)
#endif
#ifndef PROBE_DOUBLE
#define PROBE_DOUBLE -1
#endif
#define REP(k) for (int rep_ = 0; rep_ < ((k) == PROBE_DOUBLE ? 2 : 1); ++rep_)
#ifdef PROBE_WAIT
    unsigned long long wait_acc = 0ull;
#define SEAM(k) do { if (IN(k) && IN((k) + 1)) { const unsigned long long t0_ = __builtin_amdgcn_s_memrealtime(); if ((k) <= 16) xcd_barrier_bg(bar, F, args, MISC); else xcd_barrier(bar); wait_acc += __builtin_amdgcn_s_memrealtime() - t0_; } } while (0)
#else
#define SEAM(k) do { if (IN(k) && IN((k) + 1)) { if ((k) <= 16) xcd_barrier_bg(bar, F, args, MISC); else xcd_barrier(bar); } } while (0)
#endif
    unsigned char* ws = F.ws; float* out = args.out;
    LAS unsigned char* ring = F.lds;

    if (IN(0)) REP(0) { p0_prologue(F, args); } SEAM(0);
#if I8_IN0
    if (IN(1)) REP(1) { pg8::Gemm g{(const bf16_t*)(ws + WS_H0), (const bf16_t*)(ws + WS_WIN0), 1024, 1024, 1024}; pg8::Sched S; S.init(MT / 256, EVEN_INP / 256, F.G, F.bid, 0);
        pg8::EpiStore E{(bf16_t*)(ws + WS_PROJ0), EVEN_INP, 0, 0, I8_OSC, 1}; pg8::gemm_phase<pg8::EpiStore, 2>(ring, g, S, E); } SEAM(1);
#else
    if (IN(1)) REP(1) { pg8::Gemm g{(const bf16_t*)(ws + WS_H0), (const bf16_t*)(ws + WS_WIN0), 2048, 2048, 2048}; pg8::Sched S; S.init(MT / 256, EVEN_INP / 256, F.G, F.bid, 0);
        pg8::EpiStore E{(bf16_t*)(ws + WS_PROJ0), EVEN_INP, 0, 0, 1.0f, 0}; pg8::gemm_phase(ring, g, S, E); } SEAM(1);
#endif
    if (IN(2)) REP(2) { p2_rows(F, args); } SEAM(2);
    if (IN(3)) REP(3) { pg8::Gemm g{(const bf16_t*)(ws + WS_CQN), (const bf16_t*)(ws + WS_WQQ), 512, 512, 512}; pg8::Sched S; S.init(MT / 256, QQ_N / 256, F.G, F.bid, 0);
        pg8::EpiStore E{(bf16_t*)(ws + WS_QQ), QQ_N, 0, 0, 1.0f, 0}; pg8::gemm_phase(ring, g, S, E); } SEAM(3);
    #ifndef NO_P4
    if (IN(4)) REP(4) { p4_indexer(F); } SEAM(4);
#endif
    #ifndef NO_P5
    if (IN(5)) REP(5) { p5_dsa16(F, args); } SEAM(5);
#endif
    if (IN(6)) REP(6) { pg8::Gemm g{(const bf16_t*)(ws + WS_CAT0), (const bf16_t*)(ws + WS_WOUT0), CAT0_K, CAT0_K, CAT0_K}; pg8::Sched S; S.init(MT / 256, DM / 256, F.G, F.bid, 0);
        pg8::EpiResB<true> E{args.in[I_X], (bf16_t*)(ws + WS_XR), DM, 1.0f}; pg8::gemm_phase(ring, g, S, E); } SEAM(6);
#if F8_FFN0
    if (IN(7)) REP(7) { rms_phase_f8_b<F8_FFN0>(F, (const bf16_t*)(ws + WS_XR), args.in[I_ENFFN], ws + WS_H1); } SEAM(7);
#else
    if (IN(7)) REP(7) { rms_phase(F, out, args.in[I_ENFFN], (bf16_t*)(ws + WS_H1)); } SEAM(7);
#endif
#if F8_FFN0
    if (IN(8)) REP(8) { pg8::Gemm g{(const bf16_t*)(ws + WS_H1), (const bf16_t*)(ws + WS_WGU0), 1024, 1024, 1024};     pg8::Sched S; S.init(MT / 256, 2 * DFF / 256, F.G, F.bid, 0);
        pg8::EpiSwiglu E{(bf16_t*)(ws + WS_ACT0), DFF, 0, (F8_FFN0 == 2) ? I8_OSC : F8_OSC, F8_FFN0_DN, F8_FFN0 == 2}; pg8::gemm_phase<pg8::EpiSwiglu, F8_FFN0>(ring, g, S, E); } SEAM(8);
#else
    if (IN(8)) REP(8) { pg8::Gemm g{(const bf16_t*)(ws + WS_H1), (const bf16_t*)(ws + WS_WGU0), 2048, 2048, 2048}; pg8::Sched S; S.init(MT / 256, 2 * DFF / 256, F.G, F.bid, 0);
        pg8::EpiSwiglu E{(bf16_t*)(ws + WS_ACT0), DFF, 0, 1.0f, F8_FFN0_DN, 0}; pg8::gemm_phase(ring, g, S, E); } SEAM(8);
#endif
#if F8_FFN0_DN
    if (IN(9)) REP(9) { pg8::Gemm g{(const bf16_t*)(ws + WS_ACT0), (const bf16_t*)(ws + WS_WDN0), DFF / 2, DFF / 2, DFF / 2}; pg8::Sched S; S.init(MT / 256, DM / 256, F.G, F.bid, 0);
        pg8::EpiResB<false> E{ws + WS_XR, (bf16_t*)(ws + WS_XR), DM, F8_OSC_DN}; pg8::gemm_phase<pg8::EpiResB<false>, 1>(ring, g, S, E); } SEAM(9);
#else
    if (IN(9)) REP(9) { pg8::Gemm g{(const bf16_t*)(ws + WS_ACT0), (const bf16_t*)(ws + WS_WDN0), DFF, DFF, DFF}; pg8::Sched S; S.init(MT / 256, DM / 256, F.G, F.bid, 0);
        pg8::EpiRes E{out, out, DM, 1.0f}; pg8::gemm_phase(ring, g, S, E); } SEAM(9);
#endif
#if I8_IN1
    if (IN(10)) REP(10) { rms_phase_f8_b<2>(F, (const bf16_t*)(ws + WS_XR), args.in[I_ONMIX], ws + WS_H2); } SEAM(10);
#else
    if (IN(10)) REP(10) { rms_phase(F, out, args.in[I_ONMIX], (bf16_t*)(ws + WS_H2)); } SEAM(10);
#endif
#if I8_IN1
    if (IN(11)) REP(11) { pg8::Gemm g{(const bf16_t*)(ws + WS_H2), (const bf16_t*)(ws + WS_WIN1), 1024, 1024, 1024}; pg8::Sched S; S.init(MT / 256, ODD_IN / 256, F.G, F.bid, 0);
        pg8::EpiStore E{(bf16_t*)(ws + WS_PROJ1), ODD_IN, 0, 8, I8_OSC, 1}; pg8::gemm_phase<pg8::EpiStore, 2>(ring, g, S, E); } SEAM(11);
#else
    if (IN(11)) REP(11) { pg8::Gemm g{(const bf16_t*)(ws + WS_H2), (const bf16_t*)(ws + WS_WIN1), 2048, 2048, 2048}; pg8::Sched S; S.init(MT / 256, ODD_IN / 256, F.G, F.bid, 0);
        pg8::EpiStore E{(bf16_t*)(ws + WS_PROJ1), ODD_IN, 0, 8, 1.0f, 0}; pg8::gemm_phase(ring, g, S, E); } SEAM(11);
#endif
    if (IN(12)) REP(12) {
#ifndef NO_P12A
        p12_gmlp(F, args);
#endif
#ifndef NO_P12B
        p12_stick(F);
#endif
    } SEAM(12);
    if (IN(13)) REP(13) { pg8::Gemm g{(const bf16_t*)(ws + WS_CAT1), (const bf16_t*)(ws + WS_WOUT1), 2048, 2048, 2048}; pg8::Sched S; S.init(MT / 256, DM / 256, F.G, F.bid, 0);
        pg8::EpiResB<false> E{ws + WS_XR, (bf16_t*)(ws + WS_XR), DM, 1.0f}; pg8::gemm_phase(ring, g, S, E); } SEAM(13);
    if (IN(14)) REP(14) { p14_router(F, args, (const bf16_t*)(ws + WS_XR)); } SEAM(14);
    if (IN(15)) REP(15) { p15_gather(F); __syncthreads(); for (;;) { const int it = bg_step(F, args, MISC); if (it < 0 || it >= BG_GU_ITEMS) break; } } SEAM(15);
#define MOE_TILES() int ts[9], cnt[8]; moe_tiles(F, ts, cnt); const int T = ts[8]; const int tb1 = T < 96 ? T : 96, tb2 = (T - 64) > tb1 ? (T - 64) : tb1; (void)tb2
#define MOE_GU(tlo, thi, actws, rex_) do { pg8::Gemm g{(const bf16_t*)(ws + WS_HS), (const bf16_t*)(ws + WS_WGU1), 1024, 1024, 1024}; pg8::Sched S; S.init((thi) - (tlo), 2 * DFFE / 256, F.G, F.bid, (tlo)); \
        for (int j = 0; j < 7; ++j) S.ts[j] = ts[j + 1]; S.rex = (rex_); \
        pg8::EpiSwiglu E{(bf16_t*)(ws + (actws)), DFFE, (tlo) * 256, I8_OSC, 1, 1}; pg8::gemm_phase<pg8::EpiSwiglu, 2>(ring, g, S, E); } while (0)
#define MOE_DN(tlo, thi, actws) do { pg8::Gemm g{(const bf16_t*)(ws + (actws)) - (size_t)(tlo) * 256 * (DFFE / 2), (const bf16_t*)(ws + WS_WDN1), DFFE / 2, DFFE / 2, DFFE / 2};     pg8::Sched S; S.init((thi) - (tlo), DM / 256, F.G, F.bid, (tlo)); \
        for (int j = 0; j < 7; ++j) S.ts[j] = ts[j + 1]; \
        pg8::EpiStore E{(bf16_t*)(ws + WS_Y), DM, 0, 0, F8_OSC_DN, 0}; pg8::gemm_phase<pg8::EpiStore, 1>(ring, g, S, E); } while (0)
    if (IN(16)) REP(16) { MOE_TILES(); MOE_GU(0, tb1, WS_ACT1A, 0);
        __syncthreads(); while (bg_step(F, args, MISC) >= 0) {} } SEAM(16);
    if (IN(17)) { MOE_TILES(); MOE_DN(0, tb1, WS_ACT1A); MOE_GU(tb1, tb2, WS_ACT1B, (8 * tb1) % F.G); } SEAM(17);
    if (IN(18)) { MOE_TILES(); MOE_DN(tb1, tb2, WS_ACT1B); MOE_GU(tb2, T, WS_ACT1A, (8 * (tb2 - tb1)) % F.G); } SEAM(18);
    if (IN(19)) REP(19) { MOE_TILES(); MOE_DN(tb2, T, WS_ACT1A); } SEAM(19);
    if (IN(20)) REP(20) { p22_final(F, args, out); }
#ifdef PROBE_WAIT
    {
        unsigned long long* tot = (unsigned long long*)((unsigned*)(F.ws + WS_CTL) + 16384);
        if (F.tid == 0) __hip_atomic_fetch_add(tot, wait_acc, __ATOMIC_RELAXED, __HIP_MEMORY_SCOPE_AGENT);
        xcd_barrier(bar);
        if (F.bid == 0 && F.tid == 0) { const unsigned long long mean = __hip_atomic_load(tot, __ATOMIC_RELAXED, __HIP_MEMORY_SCOPE_AGENT) / (unsigned long long)F.G;
            const unsigned long long t0_ = __builtin_amdgcn_s_memrealtime(); while (__builtin_amdgcn_s_memrealtime() - t0_ < (unsigned long long)(PROBE_WAIT) * mean) __builtin_amdgcn_s_sleep(8); }
    }
#endif
#undef IN
#undef SEAM
}

extern "C" void kernel_launch(void* const* d_in, const int* in_sizes, int n_in, void* d_out, int out_size, void* d_ws, size_t ws_size, hipStream_t stream) {
    static int grid = 0;
    if (grid == 0) {
        if (n_in != 28 || out_size != MT * DM || ws_size < WS_END) { fprintf(stderr, "kernel_launch: unexpected shapes (n_in %d out %d ws %zu need %zu)\n", n_in, out_size, ws_size, (size_t)WS_END); grid = -1; return; }
        int dev = 0, cus = 0, per_cu = 0;
        if (hipGetDevice(&dev) != hipSuccess || hipDeviceGetAttribute(&cus, hipDeviceAttributeMultiprocessorCount, dev) != hipSuccess) { grid = -1; return; }
        if (hipFuncSetAttribute((const void*)fwd, hipFuncAttributeMaxDynamicSharedMemorySize, LDS_BYTES) != hipSuccess) { fprintf(stderr, "kernel_launch: hipFuncSetAttribute failed\n"); grid = -1; return; }
        if (hipOccupancyMaxActiveBlocksPerMultiprocessor(&per_cu, (const void*)fwd, 512, LDS_BYTES) != hipSuccess || per_cu < 1) { fprintf(stderr, "kernel_launch: occupancy query says %d\n", per_cu); }
        (void)hipGetLastError();
        grid = cus;
    }
    if (grid < 0) return;
    (void)hipMemsetAsync((char*)d_ws + WS_CTL, 0, CTL_ZERO_BYTES, stream);
    Args a{};
    for (int i = 0; i < 28; ++i) a.in[i] = (const float*)d_in[i];
    a.out = (float*)d_out; a.ws = (unsigned char*)d_ws;
#if MK_ONE_LAUNCH
    a.ph_lo = 0; a.ph_hi = N_PHASES;
    hipLaunchKernelGGL(fwd, dim3(grid), dim3(512), LDS_BYTES, stream, a);
#else
    for (int p = 0; p < N_PHASES; ++p) { a.ph_lo = p; a.ph_hi = p + 1; hipLaunchKernelGGL(fwd, dim3(grid), dim3(512), LDS_BYTES, stream, a); }
#endif
}
```

```cpp
#include <hip/hip_runtime.h>
#include <cstdio>
#include <cstdint>

#ifndef F8_FFN0
#define F8_FFN0 2
#endif
#ifndef F8_FFN0_DN
#define F8_FFN0_DN 1
#endif
#ifndef I8_IN0
#define I8_IN0 0
#endif
#ifndef I8_IN1
#define I8_IN1 1
#endif
#define RES_BF16 1

#ifndef MK_ONE_LAUNCH
#define MK_ONE_LAUNCH 1
#endif

#define LAS __attribute__((address_space(3)))
#define GAS __attribute__((address_space(1)))
typedef unsigned short bf16_t;
typedef short bf16x8 __attribute__((ext_vector_type(8)));
typedef short s16x4 __attribute__((ext_vector_type(4)));
typedef float f32x2 __attribute__((ext_vector_type(2)));
typedef float f32x4 __attribute__((ext_vector_type(4)));
typedef float f32x16 __attribute__((ext_vector_type(16)));
typedef unsigned u32x2 __attribute__((ext_vector_type(2)));
typedef unsigned u32x4 __attribute__((ext_vector_type(4)));
typedef __bf16 bf16x2_t __attribute__((ext_vector_type(2)));
typedef GAS unsigned gu32;

#define DI __device__ __forceinline__

constexpr int DM = 2048, NB = 16, SEQ = 2048, MT = NB * SEQ;
constexpr int EVEN_IN = 3920, EVEN_INP = 4096, ODD_IN = 5120;
constexpr int DFF = 5632, NEXP = 8, DFFE = 7168;
constexpr float EPS = 1e-6f;
constexpr int QQ_N = 3072;
constexpr int CAT0_K = 2048;
constexpr int MOE_ROWS = 65536 + 2048;
constexpr int MOE_CHUNK_TILES = 96;

DI unsigned pk2(float a, float b) { bf16x2_t v = __builtin_convertvector((f32x2){a, b}, bf16x2_t); return __builtin_bit_cast(unsigned, v); }
constexpr float F8_SACT = 8.0f, F8_OSC_DN = 1.0f / (8.0f * 2048.0f);
constexpr float F8_SA = 32.0f, F8_SW = 2048.0f, F8_OSC = 1.0f / (32.0f * 2048.0f);
DI unsigned pk4_fp8(float a, float b, float c, float d) {
    a = __builtin_amdgcn_fmed3f(a, -448.f, 448.f); b = __builtin_amdgcn_fmed3f(b, -448.f, 448.f); c = __builtin_amdgcn_fmed3f(c, -448.f, 448.f); d = __builtin_amdgcn_fmed3f(d, -448.f, 448.f);
    unsigned w = 0u; w = (unsigned)__builtin_amdgcn_cvt_pk_fp8_f32(a, b, (int)w, false); w = (unsigned)__builtin_amdgcn_cvt_pk_fp8_f32(c, d, (int)w, true); return w; }
constexpr float I8_SA = 15.875f, I8_SW = 958.0f, I8_OSC = 1.0f / (15.875f * 958.0f);
DI unsigned pk4_i8(float a, float b, float c, float d) {
    const int ia = (int)__builtin_rintf(__builtin_amdgcn_fmed3f(a, -127.f, 127.f)), ib = (int)__builtin_rintf(__builtin_amdgcn_fmed3f(b, -127.f, 127.f));
    const int ic = (int)__builtin_rintf(__builtin_amdgcn_fmed3f(c, -127.f, 127.f)), id = (int)__builtin_rintf(__builtin_amdgcn_fmed3f(d, -127.f, 127.f));
    return ((unsigned)ia & 255u) | (((unsigned)ib & 255u) << 8) | (((unsigned)ic & 255u) << 16) | ((unsigned)id << 24); }
template <int Q> DI unsigned pk4_q(float a, float b, float c, float d) { if constexpr (Q == 2) return pk4_i8(a, b, c, d); else return pk4_fp8(a, b, c, d); }
DI float bf2f(bf16_t v) { return __builtin_bit_cast(float, (unsigned)v << 16); }
DI float bflo(unsigned w) { return __builtin_bit_cast(float, w << 16); }
DI float bfhi(unsigned w) { return __builtin_bit_cast(float, w & 0xffff0000u); }
#define DPP_F(v, ctrl) __builtin_bit_cast(float, __builtin_amdgcn_update_dpp(0, __builtin_bit_cast(int, (v)), (ctrl), 0xf, 0xf, true))
DI float wave_sum(float v) {
    v += DPP_F(v, 0xB1); v += DPP_F(v, 0x4E); v += DPP_F(v, 0x141); v += DPP_F(v, 0x140);
    const int b = __builtin_bit_cast(int, v);
    const float r0 = __builtin_bit_cast(float, __builtin_amdgcn_readlane(b, 0)), r1 = __builtin_bit_cast(float, __builtin_amdgcn_readlane(b, 16)), r2 = __builtin_bit_cast(float, __builtin_amdgcn_readlane(b, 32)), r3 = __builtin_bit_cast(float, __builtin_amdgcn_readlane(b, 48));
    return (r0 + r1) + (r2 + r3);
}
DI unsigned f2u(float x) { return __builtin_bit_cast(unsigned, x); }
DI float u2f(unsigned x) { return __builtin_bit_cast(float, x); }
DI float xrow_max(float x) {
    unsigned a = f2u(x), b = a; asm volatile("" : "+v"(b)); auto s = __builtin_amdgcn_permlane16_swap(a, b, false, false); x = fmaxf(u2f(s[0]), u2f(s[1]));
    a = f2u(x); b = a; asm volatile("" : "+v"(b)); auto t = __builtin_amdgcn_permlane32_swap(a, b, false, false); return fmaxf(u2f(t[0]), u2f(t[1]));
}
DI float xrow_sum(float x) {
    unsigned a = f2u(x), b = a; asm volatile("" : "+v"(b)); auto s = __builtin_amdgcn_permlane16_swap(a, b, false, false); x = u2f(s[0]) + u2f(s[1]);
    a = f2u(x); b = a; asm volatile("" : "+v"(b)); auto t = __builtin_amdgcn_permlane32_swap(a, b, false, false); return u2f(t[0]) + u2f(t[1]);
}
DI float xor32_get(float x, int hi) {
    unsigned a = f2u(x), b = a; asm volatile("" : "+v"(b)); auto t = __builtin_amdgcn_permlane32_swap(a, b, false, false); return u2f(hi ? t[0] : t[1]);
}
DI float fast_exp2(float x) { return __builtin_amdgcn_exp2f(x); }
DI float fast_log2(float x) { return __builtin_amdgcn_logf(x); }
DI float fast_rcp(float x) { return __builtin_amdgcn_rcpf(x); }

namespace pg8 {
#ifndef WGM_WIDE
#define WGM_WIDE 4
#endif
#ifndef WGM_NARROW
#define WGM_NARROW 4
#endif
constexpr int BM = 256, BK = 64, HALF = 128, HTB = HALF * BK * 2, STAGE_BYTES = 8 * HTB, NXCD = 8, WGM = 4;
__host__ __device__ __forceinline__ int lds_byte(int r, int c) { const int st = (r >> 4) * 2 + (c >> 5), rr = r & 15, cc = c & 31, ob = rr * 64 + cc * 2; return st * 1024 + (ob ^ (((ob >> 9) & 1) << 5)); }
__host__ __device__ __forceinline__ void stage_rc(int b, int& R, int& C) { const int st = b / 1024, sb = b % 1024, swz = sb ^ (((sb >> 9) & 1) << 5); R = (st >> 1) * 16 + swz / 64; C = (st & 1) * 32 + (swz % 64) / 2; }
__host__ __device__ __forceinline__ int perm32(int rho) { const int n = rho >> 4, i = rho & 15; return 8 * (i >> 2) + 4 * n + (i & 3); }

struct Unit { int pm, pn, bt; };
struct Gemm { const bf16_t* A; const bf16_t* Bt; int lda, ldb, K; };

struct Sched {
    int nM, nN, nwg, G, c, pm0, rex; int ts[7];
    __device__ void init(int nM_, int nN_, int G_, int c_, int pm0_) { nM = nM_; nN = nN_; nwg = nM * nN; G = G_; c = c_; pm0 = pm0_; rex = 0; for (int j = 0; j < 7; ++j) ts[j] = 0x7fffffff; }
    __device__ __forceinline__ bool next(int i, Unit& u) const {
        long L = (long)i * G + c;
        if (rex) { const int ii = i + (c < rex ? 3 : 0); L = ii < 3 ? (long)ii * (G - rex) + (c - rex) : (long)3 * (G - rex) + (long)(ii - 3) * G + c; }
        if (L >= nwg) return false;
        int wgid = (int)L; { const int q = nwg / NXCD, r = nwg % NXCD, xcd = wgid % NXCD, off = wgid / NXCD; wgid = (xcd < r ? xcd * (q + 1) : r * (q + 1) + (xcd - r) * q) + off; }
        const int wgm = nN >= 40 ? WGM_WIDE : (nN <= 8 ? WGM_NARROW : WGM);
        const int nig = wgm * nN, gid = wgid / nig, fm = gid * wgm, gsz = (nM - fm) < wgm ? (nM - fm) : wgm;
        u.pm = pm0 + fm + ((wgid % nig) % gsz); u.pn = (wgid % nig) / gsz;
        int e = 0;
#pragma unroll
        for (int j = 0; j < 7; ++j) e += (u.pm >= ts[j]) ? 1 : 0;
        u.bt = e * nN + u.pn; return true;
    }
};

DI f32x4 gelu_tanh4(f32x4 v) {
    f32x4 o;
#pragma unroll
    for (int j = 0; j < 4; ++j) { const float x = v[j]; const float t = x * (1.0f + 0.044715f * x * x) * (-2.0f * 0.7978845608f * 1.44269504f); o[j] = x * fast_rcp(1.0f + fast_exp2(t)); }
    return o;
}
DI float ibits2f(float bits) { return (float)__builtin_bit_cast(int, bits); }
struct EpiStore {
    static constexpr bool PERM = true;
    bf16_t* O; int ldc, row_sub, gelu_tiles; float osc; int iacc;
    DI void operator()(const f32x4 (&acc)[2][2][4][2], const Unit& u, int wr, int wc, int fr, int fq) const {
        const int row0 = u.pm * BM - row_sub + wr * 64 + fr, col0 = u.pn * BM + wc * 32 + 8 * fq; const bool g = u.pn < gelu_tiles;
#pragma unroll
        for (int ai = 0; ai < 2; ++ai)
#pragma unroll
            for (int m = 0; m < 4; ++m) { bf16_t* rowp = O + (size_t)(row0 + ai * HALF + m * 16) * ldc + col0;
#pragma unroll
                for (int bj = 0; bj < 2; ++bj) { f32x4 v0 = acc[ai][bj][m][0], v1 = acc[ai][bj][m][1];
                    if (iacc) {
#pragma unroll
                        for (int j = 0; j < 4; ++j) { const float a0 = v0[j], a1 = v1[j]; v0[j] = ibits2f(a0); v1[j] = ibits2f(a1); } }
                    v0 = v0 * osc; v1 = v1 * osc;
                    if (g) { v0 = gelu_tanh4(v0); v1 = gelu_tanh4(v1); }
                    u32x4 w; w.x = pk2(v0[0], v0[1]); w.y = pk2(v0[2], v0[3]); w.z = pk2(v1[0], v1[1]); w.w = pk2(v1[2], v1[3]);
                    *(u32x4*)(rowp + bj * HALF) = w; } }
    }
};
struct EpiRes {
    static constexpr bool PERM = false;
    const float* base; float* out; int ldc; float osc;
    DI void operator()(const f32x4 (&acc)[2][2][4][2], const Unit& u, int wr, int wc, int fr, int fq) const {
        const int row0 = u.pm * BM + wr * 64 + fr, col0 = u.pn * BM + wc * 32 + 4 * fq;
#pragma unroll
        for (int ai = 0; ai < 2; ++ai)
#pragma unroll
            for (int m = 0; m < 4; ++m) { const size_t off = (size_t)(row0 + ai * HALF + m * 16) * ldc + col0;
#pragma unroll
                for (int bj = 0; bj < 2; ++bj)
#pragma unroll
                    for (int n = 0; n < 2; ++n) { const f32x4 b = *(const f32x4*)(base + off + bj * HALF + n * 16); *(f32x4*)(out + off + bj * HALF + n * 16) = b + acc[ai][bj][m][n] * osc; } }
    }
};
template <bool BF32> struct EpiResB {
    static constexpr bool PERM = true;
    const void* base; bf16_t* out; int ldc; float osc;
    DI void operator()(const f32x4 (&acc)[2][2][4][2], const Unit& u, int wr, int wc, int fr, int fq) const {
        const int row0 = u.pm * BM + wr * 64 + fr, col0 = u.pn * BM + wc * 32 + 8 * fq;
#pragma unroll
        for (int ai = 0; ai < 2; ++ai)
#pragma unroll
            for (int m = 0; m < 4; ++m) { const size_t off = (size_t)(row0 + ai * HALF + m * 16) * ldc + col0;
#pragma unroll
                for (int bj = 0; bj < 2; ++bj) { f32x4 v0 = acc[ai][bj][m][0] * osc, v1 = acc[ai][bj][m][1] * osc;
                    if (BF32) { const float* bp = (const float*)base + off + bj * HALF; const f32x4 b0 = *(const f32x4*)bp, b1 = *(const f32x4*)(bp + 4); v0 = v0 + b0; v1 = v1 + b1; }
                    else { const u32x4 bw = *(const u32x4*)((const bf16_t*)base + off + bj * HALF);
                        v0[0] += bflo(bw.x); v0[1] += bfhi(bw.x); v0[2] += bflo(bw.y); v0[3] += bfhi(bw.y); v1[0] += bflo(bw.z); v1[1] += bfhi(bw.z); v1[2] += bflo(bw.w); v1[3] += bfhi(bw.w); }
                    u32x4 w; w.x = pk2(v0[0], v0[1]); w.y = pk2(v0[2], v0[3]); w.z = pk2(v1[0], v1[1]); w.w = pk2(v1[2], v1[3]);
                    *(u32x4*)(out + off + bj * HALF) = w; } }
    }
};
struct EpiSwiglu {
    static constexpr bool PERM = true;
    bf16_t* O; int ldc, row_sub; float osc; int f8out; int iacc;
    DI void operator()(const f32x4 (&acc)[2][2][4][2], const Unit& u, int wr, int wc, int fr, int fq) const {
        const int row0 = u.pm * BM - row_sub + wr * 64 + fr, col0 = u.pn * HALF + wc * 32 + 8 * fq;
#pragma unroll
        for (int ai = 0; ai < 2; ++ai)
#pragma unroll
            for (int m = 0; m < 4; ++m) { float o[8]; const float kexp = -1.44269504f * osc, kout = osc * osc * (f8out ? F8_SACT : 1.0f);
#pragma unroll
                for (int n = 0; n < 2; ++n)
#pragma unroll
                    for (int j = 0; j < 4; ++j) { const float gr = acc[ai][0][m][n][j], ur = acc[ai][1][m][n][j]; const float ga = iacc ? ibits2f(gr) : gr, ua = iacc ? ibits2f(ur) : ur;
                        o[4 * n + j] = (ga * fast_rcp(1.0f + fast_exp2(ga * kexp))) * (ua * kout); }
                if (f8out) { u32x2 w8; w8.x = pk4_fp8(o[0], o[1], o[2], o[3]); w8.y = pk4_fp8(o[4], o[5], o[6], o[7]);
                    *(u32x2*)((unsigned char*)O + (size_t)(row0 + ai * HALF + m * 16) * ldc + col0) = w8; }
                else { u32x4 w; w.x = pk2(o[0], o[1]); w.y = pk2(o[2], o[3]); w.z = pk2(o[4], o[5]); w.w = pk2(o[6], o[7]);
                    *(u32x4*)(O + (size_t)(row0 + ai * HALF + m * 16) * ldc + col0) = w; } }
    }
};

template <class Epi, int MODE = 0>
DI void gemm_phase(LAS unsigned char* lds, const Gemm g, const Sched& S, const Epi& E) {
    constexpr bool F8 = (MODE == 1);
    int tid = threadIdx.x; asm volatile("" : "+v"(tid));
    const int wid = __builtin_amdgcn_readfirstlane(tid >> 6), lane = tid & 63, wr = wid >> 2, wc = wid & 3, fr = lane & 15, fq = lane >> 4;
    const int K = g.K, nt = K / BK;
    unsigned voffA[2], voffB[2];
#pragma unroll
    for (int i = 0; i < 2; ++i) { int R, C; stage_rc(tid * 16 + i * 8192, R, C); const int Rb = Epi::PERM ? ((R & ~31) + perm32(R & 31)) : R;
        voffA[i] = (unsigned)(R * g.lda + C) * 2u; voffB[i] = (unsigned)(Rb * g.ldb + C) * 2u; }
    const size_t kstep = (size_t)(BK * 2);
    const size_t hstepA = (size_t)HALF * g.lda * 2, hstepB = (size_t)HALF * g.ldb * 2;
    const size_t tstepA = 2 * hstepA, tstepB = 2 * hstepB;
    const unsigned ldsw = (unsigned)wid * 1024u;
    const int aoff = lds_byte(wr * 64 + fr, fq * 8), boff = lds_byte(wc * 32 + fr, fq * 8);
#define PG8_SA(b, h) (((b) * 2 + (h)) * HTB)
#define PG8_SB(b, h) ((4 + (b) * 2 + (h)) * HTB)
#define PG8_STAGE(bufoff, gbase, voff) do { _Pragma("unroll") for (int _i = 0; _i < 2; ++_i) \
        __builtin_amdgcn_global_load_lds((const unsigned*)((const char*)(gbase) + (voff)[_i]), (LAS unsigned*)(lds + (bufoff) + ldsw + _i * 8192), 16, 0, 0); } while (0)
#define PG8_LD16(off) (*(const LAS v4i_*)(lds + (off)))
#define PG8_LDA(dst, b, h) do { _Pragma("unroll") for (int m = 0; m < 4; ++m) { \
        if constexpr (F8) dst##8[m] = __builtin_shufflevector(PG8_LD16(PG8_SA(b, h) + aoff + m * 2048), PG8_LD16(PG8_SA(b, h) + aoff + m * 2048 + 1024), 0, 1, 2, 3, 4, 5, 6, 7); \
        else { _Pragma("unroll") for (int k = 0; k < 2; ++k) dst[m][k] = *(const LAS bf16x8*)(lds + PG8_SA(b, h) + aoff + m * 2048 + k * 1024); } } } while (0)
#define PG8_LDB(dst, b, h) do { _Pragma("unroll") for (int n = 0; n < 2; ++n) { \
        if constexpr (F8) dst##8[n] = __builtin_shufflevector(PG8_LD16(PG8_SB(b, h) + boff + n * 2048), PG8_LD16(PG8_SB(b, h) + boff + n * 2048 + 1024), 0, 1, 2, 3, 4, 5, 6, 7); \
        else { _Pragma("unroll") for (int k = 0; k < 2; ++k) dst[n][k] = *(const LAS bf16x8*)(lds + PG8_SB(b, h) + boff + n * 2048 + k * 1024); } } } while (0)
#define PG8_MMA(ai, bj, At, Bt) do { __builtin_amdgcn_s_setprio(1); _Pragma("unroll") for (int m = 0; m < 4; ++m) _Pragma("unroll") for (int n = 0; n < 2; ++n) { \
        if constexpr (F8) asm volatile("v_mfma_f32_16x16x128_f8f6f4 %0, %1, %2, %0" : "+v"(acc[ai][bj][m][n]) : "v"(Bt##8[n]), "v"(At##8[m]));   \
        else if constexpr (MODE == 2) { _Pragma("unroll") for (int k = 0; k < 2; ++k) acc[ai][bj][m][n] = __builtin_bit_cast(f32x4, __builtin_amdgcn_mfma_i32_16x16x64_i8(__builtin_bit_cast(v4i_, Bt[n][k]), __builtin_bit_cast(v4i_, At[m][k]), __builtin_bit_cast(v4i_, acc[ai][bj][m][n]), 0, 0, 0)); } \
        else { _Pragma("unroll") for (int k = 0; k < 2; ++k) acc[ai][bj][m][n] = __builtin_amdgcn_mfma_f32_16x16x32_bf16(Bt[n][k], At[m][k], acc[ai][bj][m][n], 0, 0, 0); } } \
        __builtin_amdgcn_s_setprio(0); } while (0)
#define PG8_WAIT_V(n) asm volatile("s_waitcnt vmcnt(" #n ")" ::: "memory")
#define PG8_WAIT_L(n) asm volatile("s_waitcnt lgkmcnt(" #n ")" ::: "memory")
#define PG8_BAR __builtin_amdgcn_s_barrier()
#define PG8_SCHED __builtin_amdgcn_sched_barrier(0)
    Unit cur, nxt; int ui = 0;
    if (!S.next(0, cur)) return;
    f32x4 acc[2][2][4][2];
#pragma unroll
    for (int a = 0; a < 2; ++a)
#pragma unroll
        for (int b = 0; b < 2; ++b)
#pragma unroll
            for (int m = 0; m < 4; ++m)
#pragma unroll
                for (int n = 0; n < 2; ++n) acc[a][b][m][n] = (f32x4){0.f, 0.f, 0.f, 0.f};
    typedef int v4i_ __attribute__((ext_vector_type(4))); typedef int v8i_ __attribute__((ext_vector_type(8)));
    bf16x8 At[4][2], B0[2][2], B1[2][2]; v8i_ At8[4], B08[2], B18[2];
    const char* cA = (const char*)g.A + (size_t)cur.pm * tstepA; const char* cB = (const char*)g.Bt + (size_t)cur.bt * tstepB;
    PG8_STAGE(PG8_SB(0, 0), cB, voffB); PG8_STAGE(PG8_SB(0, 1), cB + hstepB, voffB); PG8_STAGE(PG8_SA(0, 0), cA, voffA); PG8_STAGE(PG8_SA(0, 1), cA + hstepA, voffA);
    if (wr == 1) PG8_BAR;
    PG8_WAIT_V(2); PG8_BAR;
    PG8_STAGE(PG8_SB(1, 0), cB + kstep, voffB); PG8_STAGE(PG8_SA(1, 0), cA + kstep, voffA); PG8_STAGE(PG8_SB(1, 1), cB + hstepB + kstep, voffB);
    PG8_WAIT_V(6); PG8_BAR;
    for (;;) {
        const bool has_next = S.next(ui + 1, nxt);
        const char* nA = has_next ? (const char*)g.A + (size_t)nxt.pm * tstepA : cA; const char* nB = has_next ? (const char*)g.Bt + (size_t)nxt.bt * tstepB : cB;
        for (int t = 0; t < nt; t += 2) {
            const bool last = (t == nt - 2);
            const char* a1 = cA + (size_t)(t + 1) * kstep;
            const char* a2 = last ? nA : cA + (size_t)(t + 2) * kstep; const char* b2 = last ? nB : cB + (size_t)(t + 2) * kstep;
            const char* a3 = a2 + kstep; const char* b3 = b2 + kstep;
            PG8_LDB(B0, 0, 0); PG8_LDB(B1, 0, 1); PG8_SCHED; PG8_LDA(At, 0, 0); PG8_STAGE(PG8_SA(1, 1), a1 + hstepA, voffA);
            PG8_WAIT_V(8); PG8_WAIT_L(0); PG8_BAR; PG8_MMA(0, 0, At, B0); PG8_MMA(0, 1, At, B1); PG8_BAR; PG8_SCHED;
            PG8_LDA(At, 0, 1); PG8_STAGE(PG8_SB(0, 0), b2, voffB); PG8_STAGE(PG8_SB(0, 1), b2 + hstepB, voffB); PG8_STAGE(PG8_SA(0, 0), a2, voffA);
            PG8_WAIT_V(8); PG8_WAIT_L(0); PG8_BAR; PG8_MMA(1, 0, At, B0); PG8_MMA(1, 1, At, B1); PG8_BAR; PG8_SCHED;
            PG8_LDB(B0, 1, 0); PG8_LDB(B1, 1, 1); PG8_SCHED; PG8_LDA(At, 1, 0); PG8_STAGE(PG8_SA(0, 1), a2 + hstepA, voffA);
            PG8_WAIT_V(8); PG8_WAIT_L(0); PG8_BAR; PG8_MMA(0, 0, At, B0); PG8_MMA(0, 1, At, B1); PG8_BAR; PG8_SCHED;
            PG8_LDA(At, 1, 1); PG8_STAGE(PG8_SB(1, 0), b3, voffB); PG8_STAGE(PG8_SB(1, 1), b3 + hstepB, voffB); PG8_STAGE(PG8_SA(1, 0), a3, voffA);
            PG8_WAIT_V(8); PG8_WAIT_L(0); PG8_BAR; PG8_MMA(1, 0, At, B0); PG8_MMA(1, 1, At, B1); PG8_BAR; PG8_SCHED;
        }
        if (wr == 0) PG8_BAR;
        if constexpr (F8) asm volatile("s_nop 15\n\ts_nop 15" ::: "memory");
        E(acc, cur, wr, wc, fr, fq);
        if (!has_next) break;
#pragma unroll
        for (int a = 0; a < 2; ++a)
#pragma unroll
            for (int b = 0; b < 2; ++b)
#pragma unroll
                for (int m = 0; m < 4; ++m)
#pragma unroll
                    for (int n = 0; n < 2; ++n) acc[a][b][m][n] = (f32x4){0.f, 0.f, 0.f, 0.f};
        cur = nxt; cA = nA; cB = nB; ++ui;
        if (wr == 1) PG8_BAR;
    }
    PG8_WAIT_V(0);
    PG8_BAR;
#undef PG8_SA
#undef PG8_SB
#undef PG8_STAGE
#undef PG8_LDA
#undef PG8_LD16
#undef PG8_LDB
#undef PG8_MMA
#undef PG8_WAIT_V
#undef PG8_WAIT_L
#undef PG8_BAR
#undef PG8_SCHED
}
}

#define XB_TMO      128
#define XB_XCNT(j)  (256  + 64 * (j))
#define XB_XSUB(j)  (1280 + 64 * (j))
#define XB_XGEN(j)  (2304 + 64 * (j))
#define XB_TOP      3328
#define XB_TOPGEN   3392
#define XCD_BAR_WORDS 3456
#define XB_SPIN_CAP (1u << 22)

DI unsigned xb_ld(unsigned* p)              { return __hip_atomic_load(p, __ATOMIC_RELAXED, __HIP_MEMORY_SCOPE_AGENT); }
DI unsigned xb_add(unsigned* p, unsigned v) { return __hip_atomic_fetch_add(p, v, __ATOMIC_RELAXED, __HIP_MEMORY_SCOPE_AGENT); }
DI unsigned xb_xcc_id() { return (unsigned)__builtin_amdgcn_s_getreg((3 << 11) | 20) & 0xFu; }
#define XB_SPIN(cond, bar) do { unsigned _sp = 0; while (cond) { __builtin_amdgcn_s_sleep(1); \
    if ((++_sp & 255u) == 0u) { if (xb_ld(&(bar)[XB_TMO])) break; if (_sp > XB_SPIN_CAP) { atomicAdd(&(bar)[XB_TMO], 1u); break; } } } } while (0)

struct XcdBarrier { unsigned* bar; unsigned x; volatile LAS unsigned* st; };

DI XcdBarrier xcd_barrier_post(unsigned* bar, volatile LAS unsigned* st) {
    XcdBarrier b; b.bar = bar; b.x = xb_xcc_id(); b.st = st;
    if (threadIdx.x == 0) (void)xb_add(&bar[XB_XCNT(b.x)], 1u);
    return b;
}
DI void xcd_barrier_complete(unsigned* bar, unsigned x, unsigned& nloc, unsigned& nx) {
    const unsigned G = gridDim.x * gridDim.y * gridDim.z;
    unsigned sum, cnt, mine, sp = 0u;
    for (;;) {
        sum = 0u; cnt = 0u; mine = 0u;
#pragma unroll
        for (unsigned j = 0; j < 16; ++j) { const unsigned c = xb_ld(&bar[XB_XCNT(j)]); sum += c; cnt += (c > 0u) ? 1u : 0u; mine = (j == x) ? c : mine; }
        if (sum == G) break;
        __builtin_amdgcn_s_sleep(1);
        if ((++sp & 255u) == 0u) { if (xb_ld(&bar[XB_TMO])) break; if (sp > XB_SPIN_CAP) { atomicAdd(&bar[XB_TMO], 1u); break; } }
    }
    nloc = mine > 0u ? mine : 1u; nx = cnt > 0u ? cnt : 1u;
}
DI void xcd_barrier(const XcdBarrier& b) {
    asm volatile("s_waitcnt vmcnt(0)" ::: "memory");
    __syncthreads();
    if (threadIdx.x == 0) {
        unsigned* bar = b.bar;
        __builtin_amdgcn_s_waitcnt(0);
        unsigned nloc = b.st[0], nx = b.st[1];
        if (nloc == 0u) { xcd_barrier_complete(bar, b.x, nloc, nx); b.st[0] = nloc; b.st[1] = nx; }
        const unsigned old = xb_add(&bar[XB_XSUB(b.x)], 1u);
        const unsigned gen = old / nloc;
        if (old + 1u == (gen + 1u) * nloc) {
            __builtin_amdgcn_fence(__ATOMIC_RELEASE, "agent");
            asm volatile("s_waitcnt vmcnt(0)" ::: "memory");
            const unsigned og = xb_add(&bar[XB_TOP], 1u);
            const unsigned tg = og / nx;
            if (og + 1u == (tg + 1u) * nx) xb_add(&bar[XB_TOPGEN], 1u);
            else XB_SPIN(xb_ld(&bar[XB_TOPGEN]) == tg, bar);
            __builtin_amdgcn_fence(__ATOMIC_ACQUIRE, "agent");
            xb_add(&bar[XB_XGEN(b.x)], 1u);
            asm volatile("s_waitcnt vmcnt(0)" ::: "memory");
        } else {
            XB_SPIN(xb_ld(&bar[XB_XGEN(b.x)]) == gen, bar);
            __builtin_amdgcn_fence(__ATOMIC_ACQUIRE, "agent");
            asm volatile("s_waitcnt vmcnt(0)" ::: "memory");
        }
    }
    __syncthreads();
}

constexpr size_t MiB = 1u << 20;
constexpr size_t WS_CTL = 0, CTL_ZERO_BYTES = 1 * MiB;
constexpr size_t WS_TAB = 1 * MiB;
constexpr size_t WS_WIN1 = 5 * MiB;
constexpr size_t WS_WOUT1 = 25 * MiB;
constexpr size_t WS_WS = 33 * MiB;
constexpr size_t WS_WUV = 33 * MiB + 256 * 1024;
constexpr size_t WS_WGU1 = 34 * MiB;
constexpr size_t WS_XR = 258 * MiB;
constexpr size_t WS_WDN1 = 482 * MiB;
constexpr size_t WS_L0 = 706 * MiB;
constexpr size_t WS_WIN0 = WS_L0;
constexpr size_t WS_WQQ = WS_L0 + 16 * MiB;
constexpr size_t WS_WOUT0 = WS_L0 + 19 * MiB;
constexpr size_t WS_WGU0 = WS_L0 + 31 * MiB;
constexpr size_t WS_WDN0 = WS_L0 + 75 * MiB;
constexpr size_t WS_CQN = WS_L0 + 97 * MiB;
constexpr size_t WS_CKV = WS_L0 + 129 * MiB;
constexpr size_t WS_KX = WS_L0 + 145 * MiB;
constexpr size_t WS_WIDX = WS_L0 + 149 * MiB;
constexpr size_t WS_ACT = WS_L0 + 152 * MiB;
constexpr size_t WS_PROJ0 = WS_ACT;
constexpr size_t WS_CAT0 = WS_ACT + 256 * MiB;
constexpr size_t WS_QQ = WS_ACT + 448 * MiB;
constexpr size_t WS_H0 = WS_QQ;
constexpr size_t WS_SC = WS_ACT + 640 * MiB;
constexpr size_t WS_H1 = WS_SC;
constexpr size_t WS_ACT0 = WS_ACT;
constexpr size_t WS_H2 = WS_ACT;
constexpr size_t WS_PROJ1 = WS_ACT + 128 * MiB;
constexpr size_t WS_CAT1 = WS_ACT + 448 * MiB;
constexpr size_t WS_HS = WS_L0 + 264 * MiB;
constexpr size_t WS_Y = WS_L0;
constexpr size_t WS_ACT1A = WS_L0 + 396 * MiB;
constexpr size_t WS_ACT1B = WS_L0 + 732 * MiB;
constexpr size_t WS_H3 = WS_L0 + 732 * MiB;
constexpr size_t WS_END = WS_L0 + 1096 * MiB;
static_assert(WS_SC + 128 * MiB <= WS_END && WS_CAT1 + 128 * MiB <= WS_H3 && WS_ACT1A + (size_t)96 * 256 * DFFE * 2 <= WS_ACT1B && WS_ACT1B + (size_t)104 * 256 * DFFE * 2 <= WS_END, "ws map");
constexpr size_t TAB_ER = 0;
constexpr size_t TAB_GATE = 512 * 1024;
constexpr size_t TAB_SLOT = 1024 * 1024;
constexpr int CW_BAR = 1024;
constexpr int CW_CNT = 8192;
constexpr int RING_BYTES = 131072, LDS_BYTES = 147456, MISC_OFF = LDS_BYTES - 256;

struct Args { const float* in[28]; float* out; unsigned char* ws; int ph_lo, ph_hi; };
enum { I_X = 0, I_RELB, I_FNORM, I_ENMIX, I_EWIN, I_ECONV, I_ENCQ, I_ENCKV, I_EWUQ, I_EWUK, I_EWUV, I_EWQIDX, I_EWOUT, I_ENFFN, I_EGATE, I_EUP, I_EDOWN,
       I_ONMIX, I_OWIN, I_ONV, I_OWS, I_OBS, I_OWOUT, I_ONFFN, I_OROUTER, I_OGATE, I_OUP, I_ODOWN };

struct Frame {
    LAS unsigned char* lds;
    int tid, lane, wave, gw, NGW, G, bid;
    unsigned char* ws;
};

DI void tr_load(f32x4 (&v)[16], const float* W, int ldsrc, int N, int nblk, int item, int lane) {
    const int kb = item / nblk, nb = item % nblk, k0 = 64 * kb, n0 = 64 * nb;
    const int q = lane & 15, rr = lane >> 4; const bool ok = n0 + 4 * q < N;
    const float* src = W + (size_t)(k0 + rr) * ldsrc + n0 + 4 * q;
#pragma unroll
    for (int i = 0; i < 16; ++i) v[i] = ok ? __builtin_nontemporal_load((const f32x4*)(src + (size_t)(4 * i) * ldsrc)) : (f32x4){0.f, 0.f, 0.f, 0.f};
}
DI void tr_store(const f32x4 (&v)[16], bf16_t* WT, int ldd, int koff, int row_off, int mode, int nblk, LAS float* scr, int item, int lane) {
    const int kb = item / nblk, nb = item % nblk, k0 = 64 * kb, n0 = 64 * nb;
    const int q = lane & 15, rr = lane >> 4;
#pragma unroll
    for (int i = 0; i < 16; ++i) { LAS float* d = scr + (4 * i + rr) * 65 + 4 * q; d[0] = v[i].x; d[1] = v[i].y; d[2] = v[i].z; d[3] = v[i].w; }
    asm volatile("s_waitcnt lgkmcnt(0)" ::: "memory");
    const int c = lane & 7;
    const int drow0 = (mode == 1) ? ((n0 >> 7) * 256 + (n0 & 127) + row_off) : (row_off + n0);
#pragma unroll
    for (int j = 0; j < 8; ++j) { const int n = (lane >> 3) + 8 * j; const LAS float* s = scr + (8 * c) * 65 + n;
        u32x4 o; o.x = pk2(s[0 * 65], s[1 * 65]); o.y = pk2(s[2 * 65], s[3 * 65]); o.z = pk2(s[4 * 65], s[5 * 65]); o.w = pk2(s[6 * 65], s[7 * 65]);
        *(u32x4*)(WT + (size_t)(drow0 + n) * ldd + koff + k0 + 8 * c) = o; }
    asm volatile("s_waitcnt lgkmcnt(0)" ::: "memory");
}
template <int Q = 1> DI void tr_store_f8(const f32x4 (&v)[16], unsigned char* WT, int ldd, int row_off, int mode, int nblk, LAS float* scr, int item, int lane) {
    constexpr float QS = (Q == 2) ? I8_SW : F8_SW;
    const int kb = item / nblk, nb = item % nblk, k0 = 64 * kb, n0 = 64 * nb;
    const int q = lane & 15, rr = lane >> 4;
#pragma unroll
    for (int i = 0; i < 16; ++i) { LAS float* d = scr + (4 * i + rr) * 65 + 4 * q; d[0] = v[i].x; d[1] = v[i].y; d[2] = v[i].z; d[3] = v[i].w; }
    asm volatile("s_waitcnt lgkmcnt(0)" ::: "memory");
    const int c = lane & 7;
    const int drow0 = (mode == 1) ? ((n0 >> 7) * 256 + (n0 & 127) + row_off) : (row_off + n0);
#pragma unroll
    for (int j = 0; j < 8; ++j) { const int n = (lane >> 3) + 8 * j; const LAS float* s = scr + (8 * c) * 65 + n;
        u32x2 o; o.x = pk4_q<Q>(s[0 * 65] * QS, s[1 * 65] * QS, s[2 * 65] * QS, s[3 * 65] * QS); o.y = pk4_q<Q>(s[4 * 65] * QS, s[5 * 65] * QS, s[6 * 65] * QS, s[7 * 65] * QS);
        *(u32x2*)(WT + (size_t)(drow0 + n) * ldd + k0 + 8 * c) = o; }
    asm volatile("s_waitcnt lgkmcnt(0)" ::: "memory");
}
template <int Q = 1> DI void tr_job_f8(const Frame& F, const float* W, int K, int ldsrc, int N, unsigned char* WT, int ldd, int row_off, int mode, int Npad = 0) {
    LAS float* scr = (LAS float*)(F.lds + F.wave * 16640);
    const int nblk = (Npad ? Npad : N) / 64, nitems = (K / 64) * nblk;
    for (int it = F.gw; it < nitems; it += F.NGW) { f32x4 v[16]; tr_load(v, W, ldsrc, N, nblk, it, F.lane); tr_store_f8<Q>(v, WT, ldd, row_off, mode, nblk, scr, it, F.lane); }
}
DI void tr_item(const float* W, int ldsrc, int N, bf16_t* WT, int ldd, int koff, int row_off, int mode, int nblk, LAS float* scr, int item, int lane) {
    f32x4 v[16]; tr_load(v, W, ldsrc, N, nblk, item, lane); tr_store(v, WT, ldd, koff, row_off, mode, nblk, scr, item, lane);
}
DI void tr_job(const Frame& F, const float* W, int K, int ldsrc, int N, int Npad, bf16_t* WT, int ldd, int koff, int row_off, int mode) {
    LAS float* scr = (LAS float*)(F.lds + F.wave * 16640);
    const int nblk = Npad / 64, nitems = (K / 64) * nblk;
    for (int it = F.gw; it < nitems; it += F.NGW) tr_item(W, ldsrc, N, WT, ldd, koff, row_off, mode, nblk, scr, it, F.lane);
}

DI void rms_row_to_bf16(const float* xrow, const float* g, bf16_t* orow, int lane) {
    const f32x4* xr = (const f32x4*)xrow + lane; const f32x4* gr = (const f32x4*)g + lane;
    f32x4 v[8]; float s = 0.f;
#pragma unroll
    for (int j = 0; j < 8; ++j) { v[j] = xr[64 * j]; s += (v[j].x * v[j].x + v[j].y * v[j].y) + (v[j].z * v[j].z + v[j].w * v[j].w); }
    const float rstd = 1.0f / sqrtf(wave_sum(s) * (1.f / DM) + EPS);
    u32x2* o8 = (u32x2*)orow + lane;
#pragma unroll
    for (int j = 0; j < 8; ++j) { const f32x4 gg = gr[64 * j]; u32x2 w; w.x = pk2(v[j].x * rstd * gg.x, v[j].y * rstd * gg.y); w.y = pk2(v[j].z * rstd * gg.z, v[j].w * rstd * gg.w); o8[64 * j] = w; }
}
template <int Q> DI void rms_row_to_f8(const float* xrow, const float* g, unsigned char* orow, int lane) {
    const f32x4* xr = (const f32x4*)xrow + lane; const f32x4* gr = (const f32x4*)g + lane;
    f32x4 v[8]; float s = 0.f;
#pragma unroll
    for (int j = 0; j < 8; ++j) { v[j] = xr[64 * j]; s += (v[j].x * v[j].x + v[j].y * v[j].y) + (v[j].z * v[j].z + v[j].w * v[j].w); }
    const float rstd = ((Q == 2) ? I8_SA : F8_SA) / sqrtf(wave_sum(s) * (1.f / DM) + EPS);
    unsigned* o4 = (unsigned*)orow + lane;
#pragma unroll
    for (int j = 0; j < 8; ++j) { const f32x4 gg = gr[64 * j]; o4[64 * j] = pk4_q<Q>(v[j].x * rstd * gg.x, v[j].y * rstd * gg.y, v[j].z * rstd * gg.z, v[j].w * rstd * gg.w); }
}
DI void ld_row_bf16(const bf16_t* row, int lane, f32x4 (&v)[8]) {
    const u32x2* p = (const u32x2*)row + lane;
#pragma unroll
    for (int j = 0; j < 8; ++j) { const u32x2 w = p[64 * j]; v[j].x = bflo(w.x); v[j].y = bfhi(w.x); v[j].z = bflo(w.y); v[j].w = bfhi(w.y); }
}
template <int Q> DI void rms_phase_f8_b(const Frame& F, const bf16_t* x, const float* g, unsigned char* out) {
    const int lane = F.lane; const f32x4* gr = (const f32x4*)g + lane;
    for (int m = 2 * F.gw; m < MT; m += 2 * F.NGW) {
        f32x4 a[8], b[8]; ld_row_bf16(x + (size_t)m * DM, lane, a); ld_row_bf16(x + (size_t)(m + 1) * DM, lane, b);
        float sa = 0.f, sb = 0.f;
#pragma unroll
        for (int j = 0; j < 8; ++j) { sa += (a[j].x * a[j].x + a[j].y * a[j].y) + (a[j].z * a[j].z + a[j].w * a[j].w); sb += (b[j].x * b[j].x + b[j].y * b[j].y) + (b[j].z * b[j].z + b[j].w * b[j].w); }
        const float qs = (Q == 2) ? I8_SA : F8_SA;
        const float ra = qs / sqrtf(wave_sum(sa) * (1.f / DM) + EPS), rb = qs / sqrtf(wave_sum(sb) * (1.f / DM) + EPS);
        unsigned* o0 = (unsigned*)(out + (size_t)m * DM) + lane; unsigned* o1 = o0 + DM / 4;
#pragma unroll
        for (int j = 0; j < 8; ++j) { const f32x4 gg = gr[64 * j]; o0[64 * j] = pk4_q<Q>(a[j].x * ra * gg.x, a[j].y * ra * gg.y, a[j].z * ra * gg.z, a[j].w * ra * gg.w);
            o1[64 * j] = pk4_q<Q>(b[j].x * rb * gg.x, b[j].y * rb * gg.y, b[j].z * rb * gg.z, b[j].w * rb * gg.w); }
    }
}
template <int Q> DI void rms_phase_f8(const Frame& F, const float* x, const float* g, unsigned char* out) {
    for (int m = F.gw; m < MT; m += F.NGW) rms_row_to_f8<Q>(x + (size_t)m * DM, g, out + (size_t)m * DM, F.lane);
}
DI void rms_phase(const Frame& F, const float* x, const float* g, bf16_t* out) {
    const int lane = F.lane; const f32x4* gr = (const f32x4*)g + lane;
    for (int m = 2 * F.gw; m < MT; m += 2 * F.NGW) {
        const f32x4* x0 = (const f32x4*)(x + (size_t)m * DM) + lane; const f32x4* x1 = x0 + DM / 4;
        f32x4 a[8], b[8]; float sa = 0.f, sb = 0.f;
#pragma unroll
        for (int j = 0; j < 8; ++j) { a[j] = x0[64 * j]; b[j] = x1[64 * j]; }
#pragma unroll
        for (int j = 0; j < 8; ++j) { sa += (a[j].x * a[j].x + a[j].y * a[j].y) + (a[j].z * a[j].z + a[j].w * a[j].w); sb += (b[j].x * b[j].x + b[j].y * b[j].y) + (b[j].z * b[j].z + b[j].w * b[j].w); }
        const float ra = 1.0f / sqrtf(wave_sum(sa) * (1.f / DM) + EPS), rb = 1.0f / sqrtf(wave_sum(sb) * (1.f / DM) + EPS);
        u32x2* o0 = (u32x2*)(out + (size_t)m * DM) + lane; u32x2* o1 = o0 + DM / 4;
#pragma unroll
        for (int j = 0; j < 8; ++j) { const f32x4 gg = gr[64 * j]; u32x2 w; w.x = pk2(a[j].x * ra * gg.x, a[j].y * ra * gg.y); w.y = pk2(a[j].z * ra * gg.z, a[j].w * ra * gg.w); o0[64 * j] = w;
            w.x = pk2(b[j].x * rb * gg.x, b[j].y * rb * gg.y); w.y = pk2(b[j].z * rb * gg.z, b[j].w * rb * gg.w); o1[64 * j] = w; }
    }
}
DI void p0_prologue(const Frame& F, const Args& a) {
    unsigned char* ws = F.ws;
#if I8_IN0
    tr_job_f8<2>(F, a.in[I_EWIN], 2048, EVEN_IN, EVEN_IN, ws + WS_WIN0, 2048, 0, 0, EVEN_INP);
#else
    tr_job(F, a.in[I_EWIN], 2048, EVEN_IN, EVEN_IN, EVEN_INP, (bf16_t*)(ws + WS_WIN0), 2048, 0, 0, 0);
#endif
    tr_job(F, a.in[I_EWQIDX], 512, 1024, 1024, 1024, (bf16_t*)(ws + WS_WQQ), 512, 0, 2048, 0);
    tr_job(F, a.in[I_EWOUT], 2048, 2048, 2048, 2048, (bf16_t*)(ws + WS_WOUT0), CAT0_K, 0, 0, 0);
#if F8_FFN0
    tr_job_f8<F8_FFN0>(F, a.in[I_EGATE], 2048, DFF, DFF, ws + WS_WGU0, 2048, 0, 1);
    tr_job_f8<F8_FFN0>(F, a.in[I_EUP], 2048, DFF, DFF, ws + WS_WGU0, 2048, 128, 1);
#else
    tr_job(F, a.in[I_EGATE], 2048, DFF, DFF, DFF, (bf16_t*)(ws + WS_WGU0), 2048, 0, 0, 1);
    tr_job(F, a.in[I_EUP], 2048, DFF, DFF, DFF, (bf16_t*)(ws + WS_WGU0), 2048, 0, 128, 1);
#endif
#if F8_FFN0_DN
    tr_job_f8(F, a.in[I_EDOWN], DFF, 2048, 2048, ws + WS_WDN0, DFF, 0, 0);
#else
    tr_job(F, a.in[I_EDOWN], DFF, 2048, 2048, 2048, (bf16_t*)(ws + WS_WDN0), DFF, 0, 0, 0);
#endif
#if I8_IN1
    tr_job_f8<2>(F, a.in[I_OWIN], 2048, ODD_IN, ODD_IN, ws + WS_WIN1, 2048, 0, 0);
#else
    tr_job(F, a.in[I_OWIN], 2048, ODD_IN, ODD_IN, ODD_IN, (bf16_t*)(ws + WS_WIN1), 2048, 0, 0, 0);
#endif
    tr_job(F, a.in[I_OWOUT], 2048, 2048, 2048, 2048, (bf16_t*)(ws + WS_WOUT1), 2048, 0, 0, 0);
    const int gt = F.bid * 512 + F.tid, NT = F.G * 512;
    { const float* uq = a.in[I_EWUQ]; const float* uk = a.in[I_EWUK]; bf16_t* o = (bf16_t*)(ws + WS_WQQ);
      for (int i = gt; i < 2048 * 512; i += NT) { const int n = i >> 9, r = i & 511, h = n >> 8, c = n & 255;
          const f32x4* pa = (const f32x4*)(uq + (size_t)r * 1024 + h * 128); const f32x4* pb = (const f32x4*)(uk + (size_t)c * 1024 + h * 128); float s = 0.f;
#pragma unroll 8
          for (int d = 0; d < 32; ++d) { const f32x4 x = pa[d], y = pb[d]; s += (x.x * y.x + x.y * y.y) + (x.z * y.z + x.w * y.w); }
          o[i] = (bf16_t)(pk2(s, 0.f) & 0xffffu); } }
    { const float* uv = a.in[I_EWUV]; bf16_t* o = (bf16_t*)(ws + WS_WUV);
      for (int i = gt; i < 8 * 128 * 256; i += NT) { const int e = i & 7, ln = (i >> 3) & 63, kk = (i >> 9) & 7, dblk = (i >> 12) & 7, hd = i >> 15;
          const int dout = 16 * dblk + (ln & 15), c = 32 * kk + 4 * (ln >> 4) + (e < 4 ? e : 12 + e);
          o[i] = (bf16_t)(pk2(uv[(size_t)c * 1024 + hd * 128 + dout], 0.f) & 0xffffu); } }
    { const float* w = a.in[I_OWS]; bf16_t* o = (bf16_t*)(ws + WS_WS);
      for (int i = gt; i < 8 * 128 * 128; i += NT) { const int t = (i >> 7) & 127, s = i & 127; o[i] = (bf16_t)(pk2(s <= t ? w[i] : 0.f, 0.f) & 0xffffu); } }
#if I8_IN0
    rms_phase_f8<2>(F, a.in[I_X], a.in[I_ENMIX], ws + WS_H0);
#else
    rms_phase(F, a.in[I_X], a.in[I_ENMIX], (bf16_t*)(ws + WS_H0));
#endif
}

constexpr int BG_ITEMS_PER_JOB = 224, BG_NJOBS = 24, BG_NITEMS = BG_ITEMS_PER_JOB * BG_NJOBS, BG_GU_ITEMS = BG_ITEMS_PER_JOB * 16;
constexpr int CW_BGQ = 12288;
constexpr int MISC_BG_STATE = 16, MISC_BG_ITEM = 17, MISC_BG_EMPTY = 18;
DI void bg_item(const Frame& F, const Args& a, int item) {
    const int job = item / BG_ITEMS_PER_JOB, sub = item % BG_ITEMS_PER_JOB;
    LAS float* scr = (LAS float*)(F.lds + F.wave * 16640);
    const int t0 = sub * 16 + F.wave * 2; f32x4 v0[16], v1[16];
    if (job < 16) { const int e = job >> 1, up = job & 1; const float* W = a.in[up ? I_OUP : I_OGATE] + (size_t)e * 2048 * DFFE; unsigned char* WT = F.ws + WS_WGU1 + (size_t)e * 2 * DFFE * 2048;
        tr_load(v0, W, DFFE, DFFE, DFFE / 64, t0, F.lane); tr_load(v1, W, DFFE, DFFE, DFFE / 64, t0 + 1, F.lane);
        tr_store_f8<2>(v0, WT, 2048, up ? 128 : 0, 1, DFFE / 64, scr, t0, F.lane); tr_store_f8<2>(v1, WT, 2048, up ? 128 : 0, 1, DFFE / 64, scr, t0 + 1, F.lane); }
    else { const int e = job - 16; const float* W = a.in[I_ODOWN] + (size_t)e * DFFE * 2048; unsigned char* WT = F.ws + WS_WDN1 + (size_t)e * 2048 * DFFE;
        tr_load(v0, W, 2048, 2048, 32, t0, F.lane); tr_load(v1, W, 2048, 2048, 32, t0 + 1, F.lane);
        tr_store_f8(v0, WT, DFFE, 0, 0, 32, scr, t0, F.lane); tr_store_f8(v1, WT, DFFE, 0, 0, 32, scr, t0 + 1, F.lane); }
}
DI int bg_step(const Frame& F, const Args& a, volatile LAS unsigned* MISC) {
    if (F.tid == 0) { int it = -1;
        if (MISC[MISC_BG_EMPTY] == 0u) { const unsigned q = __hip_atomic_fetch_add((unsigned*)(F.ws + WS_CTL) + CW_BGQ, 1u, __ATOMIC_RELAXED, __HIP_MEMORY_SCOPE_AGENT); if (q < (unsigned)BG_NITEMS) it = (int)q; else MISC[MISC_BG_EMPTY] = 1u; }
        MISC[MISC_BG_ITEM] = (unsigned)it; }
    __syncthreads();
    const int item = (int)MISC[MISC_BG_ITEM];
    if (item >= 0) bg_item(F, a, item);
    __syncthreads();
    return item;
}
DI void xcd_barrier_bg(const XcdBarrier& b, const Frame& F, const Args& a, volatile LAS unsigned* MISC) {
    asm volatile("s_waitcnt vmcnt(0)" ::: "memory");
    __syncthreads();
    unsigned gen = 0u;
    if (threadIdx.x == 0) {
        unsigned* bar = b.bar;
        __builtin_amdgcn_s_waitcnt(0);
        unsigned nloc = b.st[0], nx = b.st[1];
        if (nloc == 0u) { xcd_barrier_complete(bar, b.x, nloc, nx); b.st[0] = nloc; b.st[1] = nx; }
        const unsigned old = xb_add(&bar[XB_XSUB(b.x)], 1u);
        gen = old / nloc;
        if (old + 1u == (gen + 1u) * nloc) {
            __builtin_amdgcn_fence(__ATOMIC_RELEASE, "agent");
            asm volatile("s_waitcnt vmcnt(0)" ::: "memory");
            const unsigned og = xb_add(&bar[XB_TOP], 1u);
            const unsigned tg = og / nx;
            if (og + 1u == (tg + 1u) * nx) xb_add(&bar[XB_TOPGEN], 1u);
            else XB_SPIN(xb_ld(&bar[XB_TOPGEN]) == tg, bar);
            __builtin_amdgcn_fence(__ATOMIC_ACQUIRE, "agent");
            xb_add(&bar[XB_XGEN(b.x)], 1u);
            asm volatile("s_waitcnt vmcnt(0)" ::: "memory");
            MISC[MISC_BG_STATE] = 0u;
        } else MISC[MISC_BG_STATE] = 1u;
    }
    __syncthreads();
    const bool must_wait = MISC[MISC_BG_STATE] != 0u;
    __syncthreads();
    if (must_wait) {
        unsigned spins = 0u;
        for (;;) {
            if (threadIdx.x == 0) { unsigned* bar = b.bar; const bool rel = (xb_ld(&bar[XB_XGEN(b.x)]) != gen) || (xb_ld(&bar[XB_TMO]) != 0u);
                if (!rel && ++spins > XB_SPIN_CAP) atomicAdd(&bar[XB_TMO], 1u);
                MISC[MISC_BG_STATE] = rel ? 0u : 1u; }
            __syncthreads();
            const bool waiting = MISC[MISC_BG_STATE] != 0u;
            __syncthreads();
            if (!waiting) break;
            if (bg_step(F, a, MISC) < 0) __builtin_amdgcn_s_sleep(2);
        }
        if (threadIdx.x == 0) __builtin_amdgcn_fence(__ATOMIC_ACQUIRE, "agent");
        asm volatile("s_waitcnt vmcnt(0)" ::: "memory");
    }
    __syncthreads();
}

DI void p2_rows(const Frame& F, const Args& a) {
    const bf16_t* proj = (const bf16_t*)(F.ws + WS_PROJ0);
    bf16_t* cqn = (bf16_t*)(F.ws + WS_CQN); bf16_t* ckv = (bf16_t*)(F.ws + WS_CKV); bf16_t* kx = (bf16_t*)(F.ws + WS_KX); float* widx = (float*)(F.ws + WS_WIDX);
    bf16_t* cat = (bf16_t*)(F.ws + WS_CAT0);
    const float* gcq = a.in[I_ENCQ]; const float* gckv = a.in[I_ENCKV]; const float* cw = a.in[I_ECONV];
    const int lane = F.lane;
    float w0[2][8], w1[2][8], w2[2][8];
#pragma unroll
    for (int j = 0; j < 2; ++j)
#pragma unroll
        for (int e = 0; e < 8; ++e) { const int c = 512 * j + 8 * lane + e; w0[j][e] = cw[c]; w1[j][e] = cw[1024 + c]; w2[j][e] = cw[2048 + c]; }
    float gq[8], gk[8];
#pragma unroll
    for (int e = 0; e < 8; ++e) { gq[e] = gcq[8 * lane + e]; gk[e] = gckv[8 * (lane & 31) + e]; }
    for (int m = F.gw; m < MT; m += F.NGW) {
        const bf16_t* row = proj + (size_t)m * EVEN_INP;
        const int s = m & (SEQ - 1);
        { const u32x4 v = *(const u32x4*)(row + 3072 + 8 * lane); float f[8] = {bflo(v.x), bfhi(v.x), bflo(v.y), bfhi(v.y), bflo(v.z), bfhi(v.z), bflo(v.w), bfhi(v.w)}; float ss = 0.f;
#pragma unroll
          for (int e = 0; e < 8; ++e) ss += f[e] * f[e];
          const float rstd = 1.0f / sqrtf(wave_sum(ss) * (1.f / 512.f) + EPS);
          u32x4 o; o.x = pk2(f[0] * rstd * gq[0], f[1] * rstd * gq[1]); o.y = pk2(f[2] * rstd * gq[2], f[3] * rstd * gq[3]); o.z = pk2(f[4] * rstd * gq[4], f[5] * rstd * gq[5]); o.w = pk2(f[6] * rstd * gq[6], f[7] * rstd * gq[7]);
          *(u32x4*)(cqn + (size_t)m * 512 + 8 * lane) = o; }
        { const u32x4 v = *(const u32x4*)(row + 3584 + 8 * (lane & 31)); float f[8] = {bflo(v.x), bfhi(v.x), bflo(v.y), bfhi(v.y), bflo(v.z), bfhi(v.z), bflo(v.w), bfhi(v.w)}; float ss = 0.f;
#pragma unroll
          for (int e = 0; e < 8; ++e) ss += f[e] * f[e];
          const float rstd = 1.0f / sqrtf(wave_sum(ss) * (0.5f / 256.f) + EPS);
          u32x4 o; o.x = pk2(f[0] * rstd * gk[0], f[1] * rstd * gk[1]); o.y = pk2(f[2] * rstd * gk[2], f[3] * rstd * gk[3]); o.z = pk2(f[4] * rstd * gk[4], f[5] * rstd * gk[5]); o.w = pk2(f[6] * rstd * gk[6], f[7] * rstd * gk[7]);
          if (lane < 32) *(u32x4*)(ckv + (size_t)m * 256 + 8 * lane) = o; }
        if (lane < 8) *(u32x4*)(kx + (size_t)m * 64 + 8 * lane) = *(const u32x4*)(row + 3840 + 8 * lane);
        if (lane < 16) widx[(size_t)m * 16 + lane] = bf2f(row[3904 + lane]) * (0.125f * 0.25f);
#pragma unroll
        for (int j = 0; j < 2; ++j) { const int c0 = 512 * j + 8 * lane; float acc[8];
            { const u32x4 vc = *(const u32x4*)(row + 1024 + c0), vx = *(const u32x4*)(row + 2048 + c0);
              const float fc[8] = {bflo(vc.x), bfhi(vc.x), bflo(vc.y), bfhi(vc.y), bflo(vc.z), bfhi(vc.z), bflo(vc.w), bfhi(vc.w)}, fx[8] = {bflo(vx.x), bfhi(vx.x), bflo(vx.y), bfhi(vx.y), bflo(vx.z), bfhi(vx.z), bflo(vx.w), bfhi(vx.w)};
#pragma unroll
              for (int e = 0; e < 8; ++e) acc[e] = w2[j][e] * (fc[e] * fx[e]); }
            if (s >= 1) { const bf16_t* r1 = row - EVEN_INP; const u32x4 vc = *(const u32x4*)(r1 + 1024 + c0), vx = *(const u32x4*)(r1 + 2048 + c0);
              const float fc[8] = {bflo(vc.x), bfhi(vc.x), bflo(vc.y), bfhi(vc.y), bflo(vc.z), bfhi(vc.z), bflo(vc.w), bfhi(vc.w)}, fx[8] = {bflo(vx.x), bfhi(vx.x), bflo(vx.y), bfhi(vx.y), bflo(vx.z), bfhi(vx.z), bflo(vx.w), bfhi(vx.w)};
#pragma unroll
              for (int e = 0; e < 8; ++e) acc[e] += w1[j][e] * (fc[e] * fx[e]); }
            if (s >= 2) { const bf16_t* r2 = row - 2 * EVEN_INP; const u32x4 vc = *(const u32x4*)(r2 + 1024 + c0), vx = *(const u32x4*)(r2 + 2048 + c0);
              const float fc[8] = {bflo(vc.x), bfhi(vc.x), bflo(vc.y), bfhi(vc.y), bflo(vc.z), bfhi(vc.z), bflo(vc.w), bfhi(vc.w)}, fx[8] = {bflo(vx.x), bfhi(vx.x), bflo(vx.y), bfhi(vx.y), bflo(vx.z), bfhi(vx.z), bflo(vx.w), bfhi(vx.w)};
#pragma unroll
              for (int e = 0; e < 8; ++e) acc[e] += w0[j][e] * (fc[e] * fx[e]); }
            const u32x4 vb = *(const u32x4*)(row + c0); const float fb[8] = {bflo(vb.x), bfhi(vb.x), bflo(vb.y), bfhi(vb.y), bflo(vb.z), bfhi(vb.z), bflo(vb.w), bfhi(vb.w)};
            u32x4 o; o.x = pk2(fb[0] * acc[0], fb[1] * acc[1]); o.y = pk2(fb[2] * acc[2], fb[3] * acc[3]); o.z = pk2(fb[4] * acc[4], fb[5] * acc[5]); o.w = pk2(fb[6] * acc[6], fb[7] * acc[7]);
            *(u32x4*)(cat + (size_t)m * CAT0_K + c0) = o; }
    }
}

DI unsigned kx_lds_off(int key_local, int ch) { const int R = key_local >> 1, C = ((key_local & 1) << 3) | ch; return (unsigned)(R * 256 + ((C ^ (R & 15)) << 4)); }
DI void p4_indexer(const Frame& F) {
    const bf16_t* qq = (const bf16_t*)(F.ws + WS_QQ); const bf16_t* kx = (const bf16_t*)(F.ws + WS_KX); const float* widx = (const float*)(F.ws + WS_WIDX);
    _Float16* sc = (_Float16*)(F.ws + WS_SC);
    const int lane = F.lane, r = lane & 31, h = lane >> 5, w = F.wave, tid = F.tid;
    LAS unsigned char* kb = F.lds;
    const unsigned st_off = kx_lds_off(tid >> 3, tid & 7);
    unsigned rd_off[4];
#pragma unroll
    for (int s = 0; s < 4; ++s) rd_off[s] = kx_lds_off(r, 2 * s + h);
    const int nunits = NB * (SEQ / 16);
    for (int rd = 0; rd * F.G < nunits; ++rd) {
        const int j = (rd & 1) ? (F.G - 1 - F.bid) : F.bid; const int u = rd * F.G + j; if (u >= nunits) continue;
        const int qg = (SEQ / 16 - 1) - u / NB, b = u % NB;
        const int t0 = qg * 16, t1 = ((t0 >> 7) + 1) << 7;
        const int tq = t0 + 2 * w + (r >> 4), g = r & 15;
        bf16x8 aq[4];
#pragma unroll
        for (int s = 0; s < 4; ++s) aq[s] = *(const bf16x8*)(qq + (size_t)(b * SEQ + tq) * QQ_N + 2048 + g * 64 + 16 * s + 8 * h);
        float wts[16];
#pragma unroll
        for (int i = 0; i < 16; ++i) wts[i] = widx[(size_t)(b * SEQ + t0 + 2 * w + (i >> 3)) * 16 + ((i & 3) + 8 * ((i >> 2) & 1) + 4 * h)];
        const int tme = t0 + 2 * w + h;
        unsigned kv[64];
#pragma unroll
        for (int c = 0; c < 4; ++c) {
            if (512 * c < t1) {
                __syncthreads();
                { const bf16_t* src = kx + (size_t)(b * SEQ + 512 * c) * 64 + tid * 8;
#pragma unroll
                  for (int i = 0; i < 8; ++i) if (512 * c + 64 * i < t1) *(LAS u32x4*)(kb + st_off + 8192 * i) = *(const u32x4*)(src + 4096 * i); }
                __syncthreads();
            }
#pragma unroll
            for (int q = 0; q < 4; ++q) {
                if (512 * c + 128 * q < t1) {
#pragma unroll
                    for (int jj = 0; jj < 4; ++jj) { const int jn = 4 * q + jj, n = 16 * c + jn;
                        f32x16 acc;
#pragma unroll
                        for (int i = 0; i < 16; ++i) acc[i] = 0.f;
#pragma unroll
                        for (int s = 0; s < 4; ++s) { const bf16x8 bk = *(const LAS bf16x8*)(kb + rd_off[s] + 4096 * jn); acc = __builtin_amdgcn_mfma_f32_32x32x16_bf16(aq[s], bk, acc, 0, 0, 0); }
                        float p0 = 0.f, p1 = 0.f;
#pragma unroll
                        for (int i = 0; i < 8; ++i) { p0 += wts[i] * fmaxf(acc[i], 0.f); p1 += wts[8 + i] * fmaxf(acc[8 + i], 0.f); }
                        float tot; { unsigned a = f2u(p0), b = f2u(p1); auto sw = __builtin_amdgcn_permlane32_swap(a, b, false, false); tot = u2f(sw[0]) + u2f(sw[1]); }
                        if (32 * n + r > tme) tot = -__builtin_inff();
                        const unsigned ub = __builtin_bit_cast(unsigned, tot);
                        kv[n] = (ub & 0x80000000u) ? ~ub : (ub | 0x80000000u);
                        __builtin_amdgcn_sched_barrier(0);
                    }
                } else {
#pragma unroll
                    for (int jj = 0; jj < 4; ++jj) kv[16 * c + 4 * q + jj] = 0u;
                }
            }
        }
        unsigned T = 0u;
        if (t1 > 256) {
            unsigned Tlo = 0u, Thi = 0u; bool dlo = false, dhi = false;
            for (int bit = 31; bit >= 0; --bit) { const unsigned clo = Tlo | (1u << bit), chi = Thi | (1u << bit); const unsigned cand = h ? chi : clo; int cnt = 0;
#pragma unroll
                for (int n = 0; n < 64; ++n) cnt += (kv[n] >= cand) ? 1 : 0;
                cnt += __builtin_amdgcn_update_dpp(0, cnt, 0xB1, 0xf, 0xf, true);
                cnt += __builtin_amdgcn_update_dpp(0, cnt, 0x4E, 0xf, 0xf, true);
                cnt += __builtin_amdgcn_update_dpp(0, cnt, 0x141, 0xf, 0xf, true);
                cnt += __builtin_amdgcn_update_dpp(0, cnt, 0x140, 0xf, 0xf, true);
                const int nlo = __builtin_amdgcn_readlane(cnt, 0) + __builtin_amdgcn_readlane(cnt, 16), nhi = __builtin_amdgcn_readlane(cnt, 32) + __builtin_amdgcn_readlane(cnt, 48);
                if (!dlo) { Tlo = (nlo >= 256) ? clo : Tlo; dlo = (nlo == 256); }
                if (!dhi) { Thi = (nhi >= 256) ? chi : Thi; dhi = (nhi == 256); }
                if (dlo && dhi) break; }
            T = h ? Thi : Tlo;
        }
        _Float16* orow = sc + (size_t)(b * SEQ + tme) * SEQ;
#pragma unroll
        for (int q = 0; q < 16; ++q) if (128 * q < t1) {
#pragma unroll
            for (int jj = 0; jj < 4; ++jj) { const int n = 4 * q + jj; const unsigned k = kv[n]; const bool sel = (k >= T) && (k > 0x007fffffu);
                const unsigned ub = (k & 0x80000000u) ? (k ^ 0x80000000u) : ~k; const float v = sel ? __builtin_bit_cast(float, ub) * 1.44269504f : -__builtin_inff();
                orow[32 * n + r] = (_Float16)v; } }
    }
    __syncthreads();
}

DI unsigned kv_off(int row, int ch) { return (unsigned)(512 * row + 16 * (ch ^ (2 * (row & 7)))); }
DI s16x4 tr_read4(const LAS unsigned char* p) { return __builtin_amdgcn_ds_read_tr16_b64_v4i16((LAS s16x4*)p); }
DI bf16x8 cat8(s16x4 a, s16x4 b) { bf16x8 v; v[0] = a[0]; v[1] = a[1]; v[2] = a[2]; v[3] = a[3]; v[4] = b[0]; v[5] = b[1]; v[6] = b[2]; v[7] = b[3]; return v; }
DI bf16x8 pack8(float a0, float a1, float a2, float a3, float a4, float a5, float a6, float a7) { u32x4 w; w.x = pk2(a0, a1); w.y = pk2(a2, a3); w.z = pk2(a4, a5); w.w = pk2(a6, a7); return __builtin_bit_cast(bf16x8, w); }
DI void p5_dsa(const Frame& F, const Args& a) {
    const bf16_t* qq = (const bf16_t*)(F.ws + WS_QQ); const bf16_t* ckv = (const bf16_t*)(F.ws + WS_CKV); const _Float16* sc = (const _Float16*)(F.ws + WS_SC);
    bf16_t* cat = (bf16_t*)(F.ws + WS_CAT0); const bf16_t* wuv = (const bf16_t*)(F.ws + WS_WUV);
    const int lane = F.lane, r = lane & 31, h = lane >> 5, tid = F.tid, dh = F.wave & 1;
    const int q4 = (lane & 15) >> 2, p4 = lane & 3, blk = (lane >> 4) & 1;
    LAS unsigned char* kvb = F.lds;
    LAS unsigned char* scb = F.lds + 32768;
    LAS float* lut = (LAS float*)(F.lds + 40960);
    __syncthreads();
    for (int i = tid; i < 8 * 129; i += 512) { const int hd = i / 129, d = i % 129; int bk = d;
        if (d >= 16) { bk = 16 + (int)(logf((float)d / 16.0f) / 2.0794415416798357f * 16.0f); bk = bk > 31 ? 31 : bk; }
        lut[hd * 132 + d] = a.in[I_RELB][bk * 8 + hd] * 1.44269504f; }
    __syncthreads();
    const float SC2 = 0.08838834764831845f * 1.44269504f;
    const int nunits = NB * (SEQ / 32) * 2;
    for (int rd = 0; rd * F.G < nunits; ++rd) {
        const int j = (rd & 1) ? (F.G - 1 - F.bid) : F.bid; const int u = rd * F.G + j; if (u >= nunits) continue;
        const int hg = u & 1, u2 = u >> 1, head = 4 * hg + (F.wave >> 1);
        const int qt = (SEQ / 32 - 1) - u2 / NB, b = u2 % NB, q0 = qt * 32, nkt = qt + 1, tq = q0 + r;
        bf16x8 qf[16];
#pragma unroll
        for (int s = 0; s < 16; ++s) qf[s] = *(const bf16x8*)(qq + (size_t)(b * SEQ + tq) * QQ_N + head * 256 + 16 * s + 8 * h);
        f32x16 O[4];
#pragma unroll
        for (int c = 0; c < 4; ++c)
#pragma unroll
            for (int i = 0; i < 16; ++i) O[c][i] = 0.f;
        float m_run = -__builtin_inff(), l_run = 0.f;
        u32x4 st0, st1; u32x2 st2 = {0u, 0u};
        const int skey0 = tid >> 5, sch = tid & 31, sq = tid >> 3, spc = tid & 7;
#define DSA_LOAD(kt) do { const bf16_t* src = ckv + (size_t)(b * SEQ + 32 * (kt)) * 256; st0 = *(const u32x4*)(src + (size_t)skey0 * 256 + 8 * sch); st1 = *(const u32x4*)(src + (size_t)(skey0 + 16) * 256 + 8 * sch); \
        if (tid < 256) st2 = *(const u32x2*)(sc + (size_t)(b * SEQ + q0 + sq) * SEQ + 32 * (kt) + 4 * spc); } while (0)
#define DSA_WRITE(bufi) do { LAS unsigned char* kd_ = kvb + (bufi) * 16384; *(LAS u32x4*)(kd_ + kv_off(skey0, sch)) = st0; *(LAS u32x4*)(kd_ + kv_off(skey0 + 16, sch)) = st1; \
        if (tid < 256) *(LAS u32x2*)(scb + (bufi) * 2304 + sq * 72 + spc * 8) = st2; } while (0)
        __syncthreads();
        DSA_LOAD(0); DSA_WRITE(0);
        __syncthreads();
        for (int kt = 0; kt < nkt; ++kt) {
            const int cur = kt & 1;
            if (kt + 1 < nkt) DSA_LOAD(kt + 1);
            const LAS unsigned char* kd = kvb + cur * 16384; const LAS unsigned char* sd = scb + cur * 2304;
            f32x16 S;
#pragma unroll
            for (int i = 0; i < 16; ++i) S[i] = 0.f;
#pragma unroll
            for (int s = 0; s < 16; ++s) { const bf16x8 kf = *(const LAS bf16x8*)(kd + kv_off(r, 2 * s + h)); S = __builtin_amdgcn_mfma_f32_32x32x16_bf16(kf, qf[s], S, 0, 0, 0); if ((s & 3) == 3) __builtin_amdgcn_sched_barrier(0); }
            float mx = -__builtin_inff();
            const bool far = (32 * kt + 31 + 128 <= q0);
            const float bfar = lut[head * 132 + 128];
#pragma unroll
            for (int gq = 0; gq < 4; ++gq) { const u32x2 iw = *(const LAS u32x2*)(sd + r * 72 + (2 * gq + h) * 8);
                const _Float16 h0 = __builtin_bit_cast(_Float16, (unsigned short)(iw.x & 0xffffu)), h1 = __builtin_bit_cast(_Float16, (unsigned short)(iw.x >> 16)), h2 = __builtin_bit_cast(_Float16, (unsigned short)(iw.y & 0xffffu)), h3 = __builtin_bit_cast(_Float16, (unsigned short)(iw.y >> 16));
                const float idx[4] = {(float)h0, (float)h1, (float)h2, (float)h3};
                if (far) {
#pragma unroll
                    for (int e = 0; e < 4; ++e) { const int i = 4 * gq + e; const float x = S[i] * SC2 + idx[e]; S[i] = x; mx = fmaxf(mx, x); }
                } else {
#pragma unroll
                    for (int e = 0; e < 4; ++e) { const int i = 4 * gq + e, key = 32 * kt + 8 * gq + 4 * h + e; int dist = tq - key; dist = dist < 0 ? 0 : (dist > 128 ? 128 : dist);
                        const float x = S[i] * SC2 + idx[e] + (lut[head * 132 + dist] - bfar); S[i] = x; mx = fmaxf(mx, x); }
                } }
            mx = fmaxf(mx, __shfl_xor(mx, 32));
            const float m_new = fmaxf(m_run, mx), msafe = (m_new == -__builtin_inff()) ? 0.f : m_new, alpha = fast_exp2(m_run - msafe);
            float rs = 0.f;
#pragma unroll
            for (int i = 0; i < 16; ++i) { S[i] = fast_exp2(S[i] - msafe); rs += S[i]; }
            rs += __shfl_xor(rs, 32);
            l_run = l_run * alpha + rs; m_run = m_new;
            if (__builtin_amdgcn_ballot_w64(alpha != 1.0f) != 0ull) {
#pragma unroll
                for (int c = 0; c < 4; ++c)
#pragma unroll
                    for (int i = 0; i < 16; ++i) O[c][i] *= alpha;
            }
            const bf16x8 pf0 = pack8(S[0], S[1], S[2], S[3], S[4], S[5], S[6], S[7]), pf1 = pack8(S[8], S[9], S[10], S[11], S[12], S[13], S[14], S[15]);
#pragma unroll
            for (int c = 0; c < 4; ++c) {
                const int chn = 4 * (4 * dh + c) + 2 * blk + (p4 >> 1), bo = 8 * (p4 & 1);
                const bf16x8 v0 = cat8(tr_read4(kd + kv_off(0 + 4 * h + q4, chn) + bo), tr_read4(kd + kv_off(8 + 4 * h + q4, chn) + bo));
                const bf16x8 v1 = cat8(tr_read4(kd + kv_off(16 + 4 * h + q4, chn) + bo), tr_read4(kd + kv_off(24 + 4 * h + q4, chn) + bo));
                O[c] = __builtin_amdgcn_mfma_f32_32x32x16_bf16(v0, pf0, O[c], 0, 0, 0);
                O[c] = __builtin_amdgcn_mfma_f32_32x32x16_bf16(v1, pf1, O[c], 0, 0, 0);
                __builtin_amdgcn_sched_barrier(0);
            }
            if (kt + 1 < nkt) DSA_WRITE(cur ^ 1);
            __syncthreads();
        }
#undef DSA_LOAD
#undef DSA_WRITE
        const float inv = 1.0f / l_run;
        bf16x8 pf[4][2];
#pragma unroll
        for (int c = 0; c < 4; ++c) { pf[c][0] = pack8(O[c][0] * inv, O[c][1] * inv, O[c][2] * inv, O[c][3] * inv, O[c][4] * inv, O[c][5] * inv, O[c][6] * inv, O[c][7] * inv);
            pf[c][1] = pack8(O[c][8] * inv, O[c][9] * inv, O[c][10] * inv, O[c][11] * inv, O[c][12] * inv, O[c][13] * inv, O[c][14] * inv, O[c][15] * inv); }
        const bf16_t* wu = wuv + (size_t)head * 128 * 256 + (size_t)r * 256 + 128 * dh + 4 * h;
        LAS float* xch = (LAS float*)(F.lds + 49152) + (F.wave >> 1) * 4096;
#pragma unroll
        for (int db = 0; db < 4; ++db) { f32x16 D;
#pragma unroll
            for (int i = 0; i < 16; ++i) D[i] = 0.f;
#pragma unroll
            for (int c = 0; c < 4; ++c)
#pragma unroll
                for (int s2 = 0; s2 < 2; ++s2) { const bf16_t* p = wu + (size_t)(32 * db) * 256 + 32 * c + 16 * s2;
                    const u32x2 lo = *(const u32x2*)p, hi = *(const u32x2*)(p + 8); u32x4 w; w.x = lo.x; w.y = lo.y; w.z = hi.x; w.w = hi.y;
                    D = __builtin_amdgcn_mfma_f32_32x32x16_bf16(__builtin_bit_cast(bf16x8, w), pf[c][s2], D, 0, 0, 0); }
            if (dh) {
#pragma unroll
                for (int i = 0; i < 16; ++i) xch[(db * 16 + i) * 64 + lane] = D[i];
            } else O[db] = D; }
        __syncthreads();
        if (!dh) { bf16_t* orow = cat + (size_t)(b * SEQ + tq) * CAT0_K + 1024 + head * 128;
#pragma unroll
            for (int db = 0; db < 4; ++db)
#pragma unroll
                for (int gq = 0; gq < 4; ++gq) { float v[4];
#pragma unroll
                    for (int e = 0; e < 4; ++e) v[e] = O[db][4 * gq + e] + xch[(db * 16 + 4 * gq + e) * 64 + lane];
                    u32x2 w; w.x = pk2(v[0], v[1]); w.y = pk2(v[2], v[3]); *(u32x2*)(orow + 32 * db + 8 * gq + 4 * h) = w; } }
    }
    __syncthreads();
}

DI void p5_dsa16(const Frame& F, const Args& a) {
    const bf16_t* qq = (const bf16_t*)(F.ws + WS_QQ); const bf16_t* ckv = (const bf16_t*)(F.ws + WS_CKV); const _Float16* sc = (const _Float16*)(F.ws + WS_SC);
    bf16_t* cat = (bf16_t*)(F.ws + WS_CAT0); const bf16_t* wuv = (const bf16_t*)(F.ws + WS_WUV);
    const int lane = F.lane, c16 = lane & 15, g = lane >> 4, tid = F.tid, qh = F.wave & 1;
    const int q4 = c16 >> 2, p4 = lane & 3;
    LAS unsigned char* kvb = F.lds;
    LAS unsigned char* scb = F.lds + 65536;
    LAS float* lut = (LAS float*)(F.lds + 75776);
    __syncthreads();
    for (int i = tid; i < 8 * 129; i += 512) { const int hd = i / 129, d = i % 129; int bk = d;
        if (d >= 16) { bk = 16 + (int)(logf((float)d / 16.0f) / 2.0794415416798357f * 16.0f); bk = bk > 31 ? 31 : bk; }
        lut[hd * 132 + d] = a.in[I_RELB][bk * 8 + hd] * 1.44269504f; }
    __syncthreads();
    const float SC2 = 0.08838834764831845f * 1.44269504f;
    unsigned kro[2][8], tro[2][16];
#pragma unroll
    for (int s = 0; s < 8; ++s) { kro[0][s] = kv_off(c16, 4 * s + g); kro[1][s] = kv_off(16 + c16, 4 * s + g); }
#pragma unroll
    for (int db = 0; db < 16; ++db) { tro[0][db] = kv_off(4 * g + q4, 2 * db + (p4 >> 1)) + 8 * (p4 & 1); tro[1][db] = kv_off(16 + 4 * g + q4, 2 * db + (p4 >> 1)) + 8 * (p4 & 1); }
    const int nunits = NB * (SEQ / 32) * 2;
    for (int rd = 0; rd * F.G < nunits; ++rd) {
        const int j = (rd & 1) ? (F.G - 1 - F.bid) : F.bid; const int u = rd * F.G + j; if (u >= nunits) continue;
        const int hg = u & 1, u2 = u >> 1, head = 4 * hg + (F.wave >> 1);
        const int qt = (SEQ / 32 - 1) - u2 / NB, b = u2 % NB, q0 = qt * 32, nk2 = (qt >> 1) + 1, tq = q0 + 16 * qh + c16;
        bf16x8 qf[8];
#pragma unroll
        for (int s = 0; s < 8; ++s) qf[s] = *(const bf16x8*)(qq + (size_t)(b * SEQ + tq) * QQ_N + head * 256 + 32 * s + 8 * g);
        f32x4 O[16];
#pragma unroll
        for (int db = 0; db < 16; ++db) O[db] = (f32x4){0.f, 0.f, 0.f, 0.f};
        float m_run = -__builtin_inff(), l_run = 0.f;
        u32x4 st[4]; u32x2 st2;
        const int skey0 = tid >> 5, sch = tid & 31, sq = tid >> 4, spc = tid & 15;
        unsigned wo[4];
#pragma unroll
        for (int i = 0; i < 4; ++i) wo[i] = (unsigned)((i >> 1) * 16384) + kv_off(skey0 + 16 * (i & 1), sch);
        const unsigned wo2 = sq * 136 + spc * 8;
#define DSA_LOAD(k2) do { const bf16_t* src = ckv + (size_t)(b * SEQ + 64 * (k2)) * 256 + (size_t)skey0 * 256 + 8 * sch; \
        _Pragma("unroll") for (int i = 0; i < 4; ++i) st[i] = *(const u32x4*)(src + (size_t)(16 * i) * 256); \
        st2 = *(const u32x2*)(sc + (size_t)(b * SEQ + q0 + sq) * SEQ + 64 * (k2) + 4 * spc); } while (0)
#define DSA_WRITE(bufi) do { LAS unsigned char* kd_ = kvb + (bufi) * 32768; _Pragma("unroll") for (int i = 0; i < 4; ++i) *(LAS u32x4*)(kd_ + wo[i]) = st[i]; \
        *(LAS u32x2*)(scb + (bufi) * 4352 + wo2) = st2; } while (0)
        __syncthreads();
        DSA_LOAD(0); DSA_WRITE(0);
        __syncthreads();
        for (int k2 = 0; k2 < nk2; ++k2) {
            const int cur = k2 & 1;
            if (k2 + 1 < nk2) DSA_LOAD(k2 + 1);
            const LAS unsigned char* kd = kvb + cur * 32768; const LAS unsigned char* sd = scb + cur * 4352 + (16 * qh + c16) * 136 + 8 * g;
            f32x4 S[4];
#pragma unroll
            for (int i = 0; i < 4; ++i) S[i] = (f32x4){0.f, 0.f, 0.f, 0.f};
            __builtin_amdgcn_s_setprio(1);
#pragma unroll
            for (int sp = 0; sp < 4; ++sp) {
                bf16x8 kf[8];
#pragma unroll
                for (int t = 0; t < 8; ++t) { const int s = 2 * sp + (t >> 2), i = t & 3; kf[t] = *(const LAS bf16x8*)(kd + (i >> 1) * 16384 + kro[i & 1][s]); }
                __builtin_amdgcn_sched_barrier(0);
#pragma unroll
                for (int t = 0; t < 8; ++t) { const int s = 2 * sp + (t >> 2), i = t & 3; S[i] = __builtin_amdgcn_mfma_f32_16x16x32_bf16(kf[t], qf[s], S[i], 0, 0, 0); }
                __builtin_amdgcn_sched_barrier(0);
            }
            __builtin_amdgcn_s_setprio(0);
            float x[16];
#pragma unroll
            for (int i = 0; i < 4; ++i) { const u32x2 iw = *(const LAS u32x2*)(sd + 32 * i);
                const _Float16 h0 = __builtin_bit_cast(_Float16, (unsigned short)(iw.x & 0xffffu)), h1 = __builtin_bit_cast(_Float16, (unsigned short)(iw.x >> 16)), h2 = __builtin_bit_cast(_Float16, (unsigned short)(iw.y & 0xffffu)), h3 = __builtin_bit_cast(_Float16, (unsigned short)(iw.y >> 16));
                x[4 * i] = S[i][0] * SC2 + (float)h0; x[4 * i + 1] = S[i][1] * SC2 + (float)h1; x[4 * i + 2] = S[i][2] * SC2 + (float)h2; x[4 * i + 3] = S[i][3] * SC2 + (float)h3; }
            const float bfar = lut[head * 132 + 128];
            if (!(64 * k2 + 63 + 128 <= q0)) {
#pragma unroll
                for (int e = 0; e < 16; ++e) { const int key = 64 * k2 + 16 * (e >> 2) + 4 * g + (e & 3); int dist = tq - key; dist = dist < 0 ? 0 : (dist > 128 ? 128 : dist); x[e] += lut[head * 132 + dist] - bfar; }
            }
            float mx = x[0];
#pragma unroll
            for (int e = 1; e < 16; ++e) mx = fmaxf(mx, x[e]);
            mx = xrow_max(mx);
            const float m_new = fmaxf(m_run, mx), msafe = (m_new == -__builtin_inff()) ? 0.f : m_new, alpha = fast_exp2(m_run - msafe);
            float rs = 0.f;
#pragma unroll
            for (int e = 0; e < 16; ++e) { x[e] = fast_exp2(x[e] - msafe); rs += x[e]; }
            rs = xrow_sum(rs);
            l_run = l_run * alpha + rs; m_run = m_new;
            if (__builtin_amdgcn_ballot_w64(alpha != 1.0f) != 0ull) {
#pragma unroll
                for (int db = 0; db < 16; ++db) O[db] = O[db] * alpha;
            }
            const bf16x8 pf0 = pack8(x[0], x[1], x[2], x[3], x[4], x[5], x[6], x[7]), pf1 = pack8(x[8], x[9], x[10], x[11], x[12], x[13], x[14], x[15]);
            __builtin_amdgcn_s_setprio(1);
#pragma unroll
            for (int dq = 0; dq < 4; ++dq) {
                bf16x8 v0[4], v1[4];
#pragma unroll
                for (int t = 0; t < 4; ++t) { const int db = 4 * dq + t; v0[t] = cat8(tr_read4(kd + tro[0][db]), tr_read4(kd + tro[1][db])); v1[t] = cat8(tr_read4(kd + 16384 + tro[0][db]), tr_read4(kd + 16384 + tro[1][db])); }
                __builtin_amdgcn_sched_barrier(0);
#pragma unroll
                for (int t = 0; t < 4; ++t) { const int db = 4 * dq + t; O[db] = __builtin_amdgcn_mfma_f32_16x16x32_bf16(v0[t], pf0, O[db], 0, 0, 0); }
#pragma unroll
                for (int t = 0; t < 4; ++t) { const int db = 4 * dq + t; O[db] = __builtin_amdgcn_mfma_f32_16x16x32_bf16(v1[t], pf1, O[db], 0, 0, 0); }
                __builtin_amdgcn_sched_barrier(0);
            }
            __builtin_amdgcn_s_setprio(0);
            if (k2 + 1 < nk2) DSA_WRITE(cur ^ 1);
            __syncthreads();
        }
#undef DSA_LOAD
#undef DSA_WRITE
        const float inv = 1.0f / l_run;
        bf16x8 of[8];
#pragma unroll
        for (int kk = 0; kk < 8; ++kk) of[kk] = pack8(O[2 * kk][0] * inv, O[2 * kk][1] * inv, O[2 * kk][2] * inv, O[2 * kk][3] * inv, O[2 * kk + 1][0] * inv, O[2 * kk + 1][1] * inv, O[2 * kk + 1][2] * inv, O[2 * kk + 1][3] * inv);
        const u32x4* wf = (const u32x4*)wuv + (size_t)head * 4096 + lane;
        bf16_t* orow = cat + (size_t)(b * SEQ + tq) * CAT0_K + 1024 + head * 128 + 4 * g;
#pragma unroll
        for (int dp = 0; dp < 4; ++dp) {
            u32x4 wa[16];
#pragma unroll
            for (int i = 0; i < 16; ++i) wa[i] = wf[(size_t)(16 * dp + i) * 64];
#pragma unroll
            for (int d2 = 0; d2 < 2; ++d2) { f32x4 D = {0.f, 0.f, 0.f, 0.f};
#pragma unroll
                for (int kk = 0; kk < 8; ++kk) D = __builtin_amdgcn_mfma_f32_16x16x32_bf16(__builtin_bit_cast(bf16x8, wa[8 * d2 + kk]), of[kk], D, 0, 0, 0);
                u32x2 w; w.x = pk2(D[0], D[1]); w.y = pk2(D[2], D[3]); *(u32x2*)(orow + 16 * (2 * dp + d2)) = w; } }
    }
    __syncthreads();
}

DI unsigned img_off(int row, int ch) { return (unsigned)(256 * row + 16 * (ch ^ (((row & 3) << 2) | ((row >> 2) & 3)))); }
DI void p12_gmlp(const Frame& F, const Args& a) {
    const bf16_t* proj = (const bf16_t*)(F.ws + WS_PROJ1); const bf16_t* wsm = (const bf16_t*)(F.ws + WS_WS); bf16_t* cat = (bf16_t*)(F.ws + WS_CAT1);
    const float* gv = a.in[I_ONV]; const float* bs = a.in[I_OBS];
    const int lane = F.lane, r = lane & 31, h = lane >> 5, w = F.wave, tid = F.tid;
    const int q4 = (lane & 15) >> 2, p4 = lane & 3, blk = (lane >> 4) & 1;
    LAS unsigned char* img = F.lds;
    LAS float* rs = (LAS float*)(F.lds + 32768);
    for (int u = F.bid; u < NB * (SEQ / 128); u += F.G) {
        const int b = u / (SEQ / 128), ch0 = u % (SEQ / 128); const size_t row0 = (size_t)b * SEQ + (size_t)ch0 * 128;
        __syncthreads();
        for (int i = 0; i < 16; ++i) { const int s = 16 * w + i; const bf16_t* vr = proj + (row0 + s) * ODD_IN + 1024; float ss = 0.f;
#pragma unroll
            for (int jj = 0; jj < 2; ++jj) { const u32x4 v = *(const u32x4*)(vr + 512 * jj + 8 * lane); const float f[8] = {bflo(v.x), bfhi(v.x), bflo(v.y), bfhi(v.y), bflo(v.z), bfhi(v.z), bflo(v.w), bfhi(v.w)};
#pragma unroll
                for (int e = 0; e < 8; ++e) ss += f[e] * f[e]; }
            ss = wave_sum(ss); if (lane == 0) rs[s] = 1.0f / sqrtf(ss * (1.f / 1024.f) + EPS); }
        __syncthreads();
        for (int g = 0; g < 8; ++g) {
#pragma unroll
            for (int i = 0; i < 4; ++i) { const int p = tid + 512 * i, s = p >> 4, chk = p & 15;
                const u32x4 v = *(const u32x4*)(proj + (row0 + s) * ODD_IN + 1024 + g * 128 + 8 * chk); const float rr = rs[s];
                const f32x4 g0 = *(const f32x4*)(gv + g * 128 + 8 * chk), g1 = *(const f32x4*)(gv + g * 128 + 8 * chk + 4);
                u32x4 o; o.x = pk2(bflo(v.x) * rr * g0.x, bfhi(v.x) * rr * g0.y); o.y = pk2(bflo(v.y) * rr * g0.z, bfhi(v.y) * rr * g0.w); o.z = pk2(bflo(v.z) * rr * g1.x, bfhi(v.z) * rr * g1.y); o.w = pk2(bflo(v.w) * rr * g1.z, bfhi(v.w) * rr * g1.w);
                *(LAS u32x4*)(img + (s >> 5) * 8192 + img_off(s & 31, chk)) = o; }
            __syncthreads();
            const int tb = w & 3, t = 32 * tb + r;
#pragma unroll
            for (int cc = 0; cc < 2; ++cc) { const int cb = 2 * (w >> 2) + cc;
                f32x16 D;
#pragma unroll
                for (int i = 0; i < 16; ++i) D[i] = 0.f;
                bf16x8 wfr[8];
#pragma unroll
                for (int ks = 0; ks < 8; ++ks) wfr[ks] = *(const bf16x8*)(wsm + (size_t)g * 16384 + (size_t)t * 128 + 16 * ks + 8 * h);
#pragma unroll
                for (int ks = 0; ks < 8; ++ks) if (ks <= 2 * tb + 1) {
                    const LAS unsigned char* im = img + (ks >> 1) * 8192; const int k2 = ks & 1;
                    const int chn = 4 * cb + 2 * blk + (p4 >> 1), bo = 8 * (p4 & 1);
                    const bf16x8 af = cat8(tr_read4(im + img_off(16 * k2 + 8 * h + 0 + q4, chn) + bo), tr_read4(im + img_off(16 * k2 + 8 * h + 4 + q4, chn) + bo));
                    D = __builtin_amdgcn_mfma_f32_32x32x16_bf16(af, wfr[ks], D, 0, 0, 0);
                }
                const float bias = bs[g * 128 + t];
                const bf16_t* urow = proj + (row0 + t) * ODD_IN + g * 128 + 32 * cb; bf16_t* orow = cat + (row0 + t) * 2048 + g * 128 + 32 * cb;
#pragma unroll
                for (int gq = 0; gq < 4; ++gq) { const u32x2 uu = *(const u32x2*)(urow + 8 * gq + 4 * h);
                    u32x2 o; o.x = pk2(bflo(uu.x) * (D[4 * gq] + bias), bfhi(uu.x) * (D[4 * gq + 1] + bias)); o.y = pk2(bflo(uu.y) * (D[4 * gq + 2] + bias), bfhi(uu.y) * (D[4 * gq + 3] + bias));
                    *(u32x2*)(orow + 8 * gq + 4 * h) = o; }
            }
            __syncthreads();
        }
    }
    __syncthreads();
}

DI bf16x8 scale_bf16x8(bf16x8 v, float sc) { const u32x4 w = __builtin_bit_cast(u32x4, v); u32x4 o;
    o.x = pk2(bflo(w.x) * sc, bfhi(w.x) * sc); o.y = pk2(bflo(w.y) * sc, bfhi(w.y) * sc); o.z = pk2(bflo(w.z) * sc, bfhi(w.z) * sc); o.w = pk2(bflo(w.w) * sc, bfhi(w.w) * sc); return __builtin_bit_cast(bf16x8, o); }
DI void p12_stick(const Frame& F) {
    const bf16_t* proj = (const bf16_t*)(F.ws + WS_PROJ1); bf16_t* cat = (bf16_t*)(F.ws + WS_CAT1);
    const int lane = F.lane, r = lane & 31, h = lane >> 5, w = F.wave, tid = F.tid;
    const int q4 = (lane & 15) >> 2, p4 = lane & 3, blk = (lane >> 4) & 1;
    LAS unsigned char* kb = F.lds;
    LAS unsigned char* vb = F.lds + 32768;
    const float SC2 = 0.08838834764831845f * 1.44269504f;
    const int nunits = NB * 8 * (SEQ / 256);
    for (int rd = 0; rd * F.G < nunits; ++rd) {
        const int j = (rd & 1) ? (F.G - 1 - F.bid) : F.bid; const int u = rd * F.G + j; if (u >= nunits) continue;
        const int qb = (SEQ / 256 - 1) - u / (NB * 8), bh = u % (NB * 8), b = bh >> 3, head = bh & 7;
        const int Q0 = qb * 256, tq = Q0 + 32 * w + r, ktd = (Q0 >> 5) + w, kt2_hi = (Q0 >> 6) + 3;
        const bf16_t* base = proj + (size_t)b * SEQ * ODD_IN + head * 128;
        bf16x8 qf[8];
#pragma unroll
        for (int s = 0; s < 8; ++s) qf[s] = scale_bf16x8(*(const bf16x8*)(base + (size_t)tq * ODD_IN + 2048 + 16 * s + 8 * h), SC2);
        f32x16 O[4];
#pragma unroll
        for (int c = 0; c < 4; ++c)
#pragma unroll
            for (int i = 0; i < 16; ++i) O[c][i] = 0.f;
        float R = 1.f;
        u32x4 st0, st1, st2, st3; const int skey = tid >> 4, sch = tid & 15;
#define SB_LOAD(kt2_) do { const bf16_t* src = base + (size_t)(64 * (kt2_) + skey) * ODD_IN + 8 * sch; st0 = *(const u32x4*)(src + 3072); st1 = *(const u32x4*)(src + 4096); \
        st2 = *(const u32x4*)(src + (size_t)32 * ODD_IN + 3072); st3 = *(const u32x4*)(src + (size_t)32 * ODD_IN + 4096); } while (0)
#define SB_WRITE(bufi) do { const unsigned o_ = (bufi) * 16384 + img_off(skey, sch); *(LAS u32x4*)(kb + o_) = st0; *(LAS u32x4*)(vb + o_) = st1; *(LAS u32x4*)(kb + o_ + 8192) = st2; *(LAS u32x4*)(vb + o_ + 8192) = st3; } while (0)
        __syncthreads();
        SB_LOAD(kt2_hi); SB_WRITE(0);
        __syncthreads();
        int cur = 0;
        for (int kt2 = kt2_hi; kt2 >= 0; --kt2) {
            if (kt2 > 0) SB_LOAD(kt2 - 1);
#pragma unroll
            for (int sub = 1; sub >= 0; --sub) { const int kt = 2 * kt2 + sub;
            if (kt <= ktd) {
                const LAS unsigned char* kd = kb + cur * 16384 + sub * 8192; const LAS unsigned char* vd = vb + cur * 16384 + sub * 8192;
                f32x16 S;
#pragma unroll
                for (int i = 0; i < 16; ++i) S[i] = 0.f;
                __builtin_amdgcn_s_setprio(1);
#pragma unroll
                for (int s = 0; s < 8; ++s) { const bf16x8 kf = *(const LAS bf16x8*)(kd + img_off(r, 2 * s + h)); S = __builtin_amdgcn_mfma_f32_32x32x16_bf16(kf, qf[s], S, 0, 0, 0); }
                __builtin_amdgcn_s_setprio(0);
                float kp[16], G[4];
                const bool diag = (kt == ktd);
                if (diag) {
#pragma unroll
                    for (int gq = 0; gq < 4; ++gq) { G[gq] = 1.f;
#pragma unroll
                        for (int e = 0; e < 4; ++e) { const int i = 4 * gq + e;
                            const float E = fast_exp2(fminf(S[i], 120.f)), keep = fast_rcp(1.0f + E); const bool past = (32 * kt + 8 * gq + 4 * h + e) < tq;
                            const float beta = past ? E * keep : 0.f, kk = past ? keep : 1.f;
                            kp[i] = kk; S[i] = beta; G[gq] *= kk; } }
                } else {
#pragma unroll
                    for (int gq = 0; gq < 4; ++gq) { G[gq] = 1.f;
#pragma unroll
                        for (int e = 0; e < 4; ++e) { const int i = 4 * gq + e;
                            const float E = fast_exp2(fminf(S[i], 120.f)), keep = fast_rcp(1.0f + E);
                            kp[i] = keep; S[i] = E * keep; G[gq] *= keep; } }
                }
                float PG[4];
#pragma unroll
                for (int gq = 0; gq < 4; ++gq) PG[gq] = xor32_get(G[gq], h);
                float hi = 1.f;
                float wv[16];
#pragma unroll
                for (int gq = 3; gq >= 0; --gq) { float run = R * hi * (h ? 1.f : PG[gq]);
#pragma unroll
                    for (int e = 3; e >= 0; --e) { const int i = 4 * gq + e; wv[i] = S[i] * run; run *= kp[i]; }
                    hi *= G[gq] * PG[gq]; }
                R *= hi;
                const bf16x8 pf0 = pack8(wv[0], wv[1], wv[2], wv[3], wv[4], wv[5], wv[6], wv[7]), pf1 = pack8(wv[8], wv[9], wv[10], wv[11], wv[12], wv[13], wv[14], wv[15]);
                __builtin_amdgcn_s_setprio(1);
#pragma unroll
                for (int c = 0; c < 4; ++c) {
                    const int chn = 4 * c + 2 * blk + (p4 >> 1), bo = 8 * (p4 & 1);
                    const bf16x8 v0 = cat8(tr_read4(vd + img_off(0 + 4 * h + q4, chn) + bo), tr_read4(vd + img_off(8 + 4 * h + q4, chn) + bo));
                    const bf16x8 v1 = cat8(tr_read4(vd + img_off(16 + 4 * h + q4, chn) + bo), tr_read4(vd + img_off(24 + 4 * h + q4, chn) + bo));
                    O[c] = __builtin_amdgcn_mfma_f32_32x32x16_bf16(v0, pf0, O[c], 0, 0, 0);
                    O[c] = __builtin_amdgcn_mfma_f32_32x32x16_bf16(v1, pf1, O[c], 0, 0, 0);
                }
                __builtin_amdgcn_s_setprio(0);
            } }
            if (kt2 > 0) SB_WRITE(cur ^ 1);
            __syncthreads();
            cur ^= 1;
        }
#undef SB_LOAD
#undef SB_WRITE
        bf16_t* orow = cat + (size_t)(b * SEQ + tq) * 2048 + 1024 + head * 128;
#pragma unroll
        for (int c = 0; c < 4; ++c)
#pragma unroll
            for (int gq = 0; gq < 4; ++gq) { u32x2 o; o.x = pk2(O[c][4 * gq], O[c][4 * gq + 1]); o.y = pk2(O[c][4 * gq + 2], O[c][4 * gq + 3]);
                *(u32x2*)(orow + 32 * c + 8 * gq + 4 * h) = o; }
    }
    __syncthreads();
}

DI void p14_router(const Frame& F, const Args& a, const bf16_t* x3) {
    unsigned char* h3 = F.ws + WS_H3; const float* gn = a.in[I_ONFFN]; const float* wr = a.in[I_OROUTER];
    int* tab_er = (int*)(F.ws + WS_TAB + TAB_ER); float* tab_gate = (float*)(F.ws + WS_TAB + TAB_GATE); unsigned* gcnt = (unsigned*)(F.ws + WS_CTL) + CW_CNT;
    const int lane = F.lane, w = F.wave, tid = F.tid;
    LAS float* wrT = (LAS float*)F.lds;
    LAS int* lcnt = (LAS int*)(F.lds + 65536);
    LAS int* lbase = lcnt + 8;
    LAS int* tokE = lcnt + 16;
    LAS int* tokR = tokE + 256;
    __syncthreads();
    for (int i = tid; i < 2048 * 8; i += 512) wrT[(i & 7) * 2048 + (i >> 3)] = wr[i];
    if (tid < 8) lcnt[tid] = 0;
    __syncthreads();
    for (int grp = F.bid; grp < MT / 128; grp += F.G) {
        u32x2 raw[8];
        { const u32x2* p0 = (const u32x2*)(x3 + (size_t)(grp * 128 + 16 * w) * DM) + lane;
#pragma unroll
          for (int j = 0; j < 8; ++j) raw[j] = p0[64 * j]; }
        for (int i = 0; i < 16; ++i) {
            const int tl = 16 * w + i, m = grp * 128 + tl;
            const f32x4* gr = (const f32x4*)gn + lane;
            f32x4 v[8]; float s = 0.f;
#pragma unroll
            for (int j = 0; j < 8; ++j) { v[j].x = bflo(raw[j].x); v[j].y = bfhi(raw[j].x); v[j].z = bflo(raw[j].y); v[j].w = bfhi(raw[j].y); }
            if (i + 1 < 16) { const u32x2* pn = (const u32x2*)(x3 + (size_t)(m + 1) * DM) + lane;
#pragma unroll
                for (int j = 0; j < 8; ++j) raw[j] = pn[64 * j]; }
#pragma unroll
            for (int j = 0; j < 8; ++j) s += (v[j].x * v[j].x + v[j].y * v[j].y) + (v[j].z * v[j].z + v[j].w * v[j].w);
            const float rstd = 1.0f / sqrtf(wave_sum(s) * (1.f / DM) + EPS);
            unsigned* o4 = (unsigned*)(h3 + (size_t)m * DM) + lane;
#pragma unroll
            for (int j = 0; j < 8; ++j) { const f32x4 gg = gr[64 * j]; v[j].x *= rstd * gg.x; v[j].y *= rstd * gg.y; v[j].z *= rstd * gg.z; v[j].w *= rstd * gg.w;
                o4[64 * j] = pk4_i8(v[j].x * I8_SA, v[j].y * I8_SA, v[j].z * I8_SA, v[j].w * I8_SA); }
            float lg[8];
#pragma unroll
            for (int e = 0; e < 8; ++e) { float acc = 0.f;
#pragma unroll
                for (int j = 0; j < 8; ++j) { const f32x4 ww = *(const LAS f32x4*)(wrT + e * 2048 + 4 * (lane + 64 * j)); acc += (v[j].x * ww.x + v[j].y * ww.y) + (v[j].z * ww.z + v[j].w * ww.w); }
                lg[e] = wave_sum(acc); }
            int i1 = 0; float v1 = lg[0];
#pragma unroll
            for (int e = 1; e < 8; ++e) if (lg[e] > v1) { v1 = lg[e]; i1 = e; }
            int i2 = -1; float v2 = -__builtin_inff();
#pragma unroll
            for (int e = 0; e < 8; ++e) if (e != i1 && lg[e] > v2) { v2 = lg[e]; i2 = e; }
            if (lane == 0) {
                const float g1 = 1.0f / (1.0f + __expf(v2 - v1));
                tab_gate[(size_t)m * 2] = g1; tab_gate[(size_t)m * 2 + 1] = 1.0f - g1;
                tokE[tl * 2] = i1; tokE[tl * 2 + 1] = i2;
                tokR[tl * 2] = __hip_atomic_fetch_add(lcnt + i1, 1, __ATOMIC_RELAXED, __HIP_MEMORY_SCOPE_WORKGROUP);
                tokR[tl * 2 + 1] = __hip_atomic_fetch_add(lcnt + i2, 1, __ATOMIC_RELAXED, __HIP_MEMORY_SCOPE_WORKGROUP);
            }
        }
        __syncthreads();
        if (tid < 8) lbase[tid] = (int)__hip_atomic_fetch_add(gcnt + 64 * tid, (unsigned)lcnt[tid], __ATOMIC_RELAXED, __HIP_MEMORY_SCOPE_AGENT);
        __syncthreads();
        if (tid < 256) { const int e = tokE[tid]; tab_er[((size_t)grp * 128) * 4 + tid * 2] = e; tab_er[((size_t)grp * 128) * 4 + tid * 2 + 1] = lbase[e] + tokR[tid]; }
        __syncthreads();
        if (tid < 8) lcnt[tid] = 0;
        __syncthreads();
    }
}

DI void moe_tiles(const Frame& F, int (&ts)[9], int (&cnt)[8]) {
    const unsigned* gcnt = (const unsigned*)(F.ws + WS_CTL) + CW_CNT;
    ts[0] = 0;
#pragma unroll
    for (int e = 0; e < 8; ++e) { cnt[e] = (int)__builtin_amdgcn_readfirstlane(__hip_atomic_load(gcnt + 64 * e, __ATOMIC_RELAXED, __HIP_MEMORY_SCOPE_AGENT)); ts[e + 1] = ts[e] + ((cnt[e] + 255) >> 8); }
}

DI void p15_gather(const Frame& F) {
    const unsigned char* h3 = F.ws + WS_H3; bf16_t* hs = (bf16_t*)(F.ws + WS_HS);
    const int* tab_er = (const int*)(F.ws + WS_TAB + TAB_ER); int* tab_slot = (int*)(F.ws + WS_TAB + TAB_SLOT);
    int ts[9], cnt[8]; moe_tiles(F, ts, cnt);
    const int lane = F.lane;
    unsigned char* hs8 = (unsigned char*)hs;
    for (int m = F.gw; m < MT; m += F.NGW) {
        const u32x2* src = (const u32x2*)(h3 + (size_t)m * DM) + lane;
        u32x2 q[4];
#pragma unroll
        for (int j = 0; j < 4; ++j) q[j] = src[64 * j];
#pragma unroll
        for (int k = 0; k < 2; ++k) { const int e = tab_er[(size_t)m * 4 + 2 * k], rk = tab_er[(size_t)m * 4 + 2 * k + 1];
            int t0 = 0;
#pragma unroll
            for (int qq = 0; qq < 8; ++qq) t0 = (e == qq) ? ts[qq] : t0;
            const int slot = t0 * 256 + rk;
            u32x2* dst = (u32x2*)(hs8 + (size_t)slot * DM) + lane; dst[0] = q[0]; dst[64] = q[1]; dst[128] = q[2]; dst[192] = q[3];
            if (lane == 0) tab_slot[(size_t)m * 2 + k] = slot; }
    }
    for (int idx = F.gw; idx < 8 * 256; idx += F.NGW) { const int e = idx >> 8, rr = idx & 255; int t0 = 0, t1 = 0, c = 0;
#pragma unroll
        for (int qq = 0; qq < 8; ++qq) { t0 = (e == qq) ? ts[qq] : t0; t1 = (e == qq) ? ts[qq + 1] : t1; c = (e == qq) ? cnt[qq] : c; }
        const int row = t0 * 256 + c + rr;
        if (row < t1 * 256) { u32x2* dst = (u32x2*)(hs8 + (size_t)row * DM) + lane; const u32x2 z = {0u, 0u}; dst[0] = z; dst[64] = z; dst[128] = z; dst[192] = z; } }
}

DI void p22_final(const Frame& F, const Args& a, float* out) {
    const bf16_t* Y = (const bf16_t*)(F.ws + WS_Y); const float* tab_gate = (const float*)(F.ws + WS_TAB + TAB_GATE); const int* tab_slot = (const int*)(F.ws + WS_TAB + TAB_SLOT);
    const float* gn = a.in[I_FNORM]; const int lane = F.lane;
    for (int m = F.gw; m < MT; m += F.NGW) {
        const float g1 = tab_gate[(size_t)m * 2], g2 = tab_gate[(size_t)m * 2 + 1]; const int s1 = tab_slot[(size_t)m * 2], s2 = tab_slot[(size_t)m * 2 + 1];
        f32x4* xr = (f32x4*)(out + (size_t)m * DM) + lane; const u32x2* x3 = (const u32x2*)(F.ws + WS_XR + (size_t)m * DM * 2) + lane; const u32x2* y1 = (const u32x2*)(Y + (size_t)s1 * DM) + lane; const u32x2* y2 = (const u32x2*)(Y + (size_t)s2 * DM) + lane;
        const f32x4* gr = (const f32x4*)gn + lane;
        f32x4 v[8]; float s = 0.f;
#pragma unroll
        for (int j = 0; j < 8; ++j) { const u32x2 xw = x3[64 * j]; v[j].x = bflo(xw.x); v[j].y = bfhi(xw.x); v[j].z = bflo(xw.y); v[j].w = bfhi(xw.y); const u32x2 a1 = y1[64 * j], a2 = y2[64 * j];
            v[j].x += g1 * bflo(a1.x) + g2 * bflo(a2.x); v[j].y += g1 * bfhi(a1.x) + g2 * bfhi(a2.x); v[j].z += g1 * bflo(a1.y) + g2 * bflo(a2.y); v[j].w += g1 * bfhi(a1.y) + g2 * bfhi(a2.y);
            s += (v[j].x * v[j].x + v[j].y * v[j].y) + (v[j].z * v[j].z + v[j].w * v[j].w); }
        const float rstd = 1.0f / sqrtf(wave_sum(s) * (1.f / DM) + EPS);
#pragma unroll
        for (int j = 0; j < 8; ++j) { const f32x4 gg = gr[64 * j]; f32x4 o; o.x = v[j].x * rstd * gg.x; o.y = v[j].y * rstd * gg.y; o.z = v[j].z * rstd * gg.z; o.w = v[j].w * rstd * gg.w; xr[64 * j] = o; }
    }
}

constexpr int N_PHASES = 21;
__global__ void __launch_bounds__(512, 2) fwd(Args args) {
    extern __shared__ __attribute__((aligned(16))) unsigned char lds_raw[];
    Frame F;
    F.lds = (LAS unsigned char*)lds_raw; F.tid = threadIdx.x; F.lane = F.tid & 63; F.wave = __builtin_amdgcn_readfirstlane(F.tid >> 6);
    F.G = gridDim.x; F.bid = blockIdx.x; F.gw = F.bid * 8 + F.wave; F.NGW = F.G * 8; F.ws = args.ws;
    volatile LAS unsigned* MISC = (volatile LAS unsigned*)(F.lds + MISC_OFF);
    if (F.tid < 64) MISC[F.tid] = 0u;
    __syncthreads();
    const int lo = args.ph_lo, hi = args.ph_hi;
    XcdBarrier bar; bar.bar = (unsigned*)(F.ws + WS_CTL) + CW_BAR; bar.x = 0; bar.st = MISC + 8;
    if (hi - lo > 1) bar = xcd_barrier_post((unsigned*)(F.ws + WS_CTL) + CW_BAR, MISC + 8);
#ifdef ONLY_PHASE
#define IN(k) ((k) == ONLY_PHASE && lo <= (k) && (k) < hi)
#else
#define IN(k) (lo <= (k) && (k) < hi)
#endif
#ifndef PROBE_DOUBLE
#define PROBE_DOUBLE -1
#endif
#define REP(k) for (int rep_ = 0; rep_ < ((k) == PROBE_DOUBLE ? 2 : 1); ++rep_)
#ifdef PROBE_WAIT
    unsigned long long wait_acc = 0ull;
#define SEAM(k) do { if (IN(k) && IN((k) + 1)) { const unsigned long long t0_ = __builtin_amdgcn_s_memrealtime(); if ((k) <= 16) xcd_barrier_bg(bar, F, args, MISC); else xcd_barrier(bar); wait_acc += __builtin_amdgcn_s_memrealtime() - t0_; } } while (0)
#else
#define SEAM(k) do { if (IN(k) && IN((k) + 1)) { if ((k) <= 16) xcd_barrier_bg(bar, F, args, MISC); else xcd_barrier(bar); } } while (0)
#endif
    unsigned char* ws = F.ws; float* out = args.out;
    LAS unsigned char* ring = F.lds;

    if (IN(0)) REP(0) { p0_prologue(F, args); } SEAM(0);
#if I8_IN0
    if (IN(1)) REP(1) { pg8::Gemm g{(const bf16_t*)(ws + WS_H0), (const bf16_t*)(ws + WS_WIN0), 1024, 1024, 1024}; pg8::Sched S; S.init(MT / 256, EVEN_INP / 256, F.G, F.bid, 0);
        pg8::EpiStore E{(bf16_t*)(ws + WS_PROJ0), EVEN_INP, 0, 0, I8_OSC, 1}; pg8::gemm_phase<pg8::EpiStore, 2>(ring, g, S, E); } SEAM(1);
#else
    if (IN(1)) REP(1) { pg8::Gemm g{(const bf16_t*)(ws + WS_H0), (const bf16_t*)(ws + WS_WIN0), 2048, 2048, 2048}; pg8::Sched S; S.init(MT / 256, EVEN_INP / 256, F.G, F.bid, 0);
        pg8::EpiStore E{(bf16_t*)(ws + WS_PROJ0), EVEN_INP, 0, 0, 1.0f, 0}; pg8::gemm_phase(ring, g, S, E); } SEAM(1);
#endif
    if (IN(2)) REP(2) { p2_rows(F, args); } SEAM(2);
    if (IN(3)) REP(3) { pg8::Gemm g{(const bf16_t*)(ws + WS_CQN), (const bf16_t*)(ws + WS_WQQ), 512, 512, 512}; pg8::Sched S; S.init(MT / 256, QQ_N / 256, F.G, F.bid, 0);
        pg8::EpiStore E{(bf16_t*)(ws + WS_QQ), QQ_N, 0, 0, 1.0f, 0}; pg8::gemm_phase(ring, g, S, E); } SEAM(3);
    #ifndef NO_P4
    if (IN(4)) REP(4) { p4_indexer(F); } SEAM(4);
#endif
    #ifndef NO_P5
    if (IN(5)) REP(5) { p5_dsa16(F, args); } SEAM(5);
#endif
    if (IN(6)) REP(6) { pg8::Gemm g{(const bf16_t*)(ws + WS_CAT0), (const bf16_t*)(ws + WS_WOUT0), CAT0_K, CAT0_K, CAT0_K}; pg8::Sched S; S.init(MT / 256, DM / 256, F.G, F.bid, 0);
        pg8::EpiResB<true> E{args.in[I_X], (bf16_t*)(ws + WS_XR), DM, 1.0f}; pg8::gemm_phase(ring, g, S, E); } SEAM(6);
#if F8_FFN0
    if (IN(7)) REP(7) { rms_phase_f8_b<F8_FFN0>(F, (const bf16_t*)(ws + WS_XR), args.in[I_ENFFN], ws + WS_H1); } SEAM(7);
#else
    if (IN(7)) REP(7) { rms_phase(F, out, args.in[I_ENFFN], (bf16_t*)(ws + WS_H1)); } SEAM(7);
#endif
#if F8_FFN0
    if (IN(8)) REP(8) { pg8::Gemm g{(const bf16_t*)(ws + WS_H1), (const bf16_t*)(ws + WS_WGU0), 1024, 1024, 1024};     pg8::Sched S; S.init(MT / 256, 2 * DFF / 256, F.G, F.bid, 0);
        pg8::EpiSwiglu E{(bf16_t*)(ws + WS_ACT0), DFF, 0, (F8_FFN0 == 2) ? I8_OSC : F8_OSC, F8_FFN0_DN, F8_FFN0 == 2}; pg8::gemm_phase<pg8::EpiSwiglu, F8_FFN0>(ring, g, S, E); } SEAM(8);
#else
    if (IN(8)) REP(8) { pg8::Gemm g{(const bf16_t*)(ws + WS_H1), (const bf16_t*)(ws + WS_WGU0), 2048, 2048, 2048}; pg8::Sched S; S.init(MT / 256, 2 * DFF / 256, F.G, F.bid, 0);
        pg8::EpiSwiglu E{(bf16_t*)(ws + WS_ACT0), DFF, 0, 1.0f, F8_FFN0_DN, 0}; pg8::gemm_phase(ring, g, S, E); } SEAM(8);
#endif
#if F8_FFN0_DN
    if (IN(9)) REP(9) { pg8::Gemm g{(const bf16_t*)(ws + WS_ACT0), (const bf16_t*)(ws + WS_WDN0), DFF / 2, DFF / 2, DFF / 2}; pg8::Sched S; S.init(MT / 256, DM / 256, F.G, F.bid, 0);
        pg8::EpiResB<false> E{ws + WS_XR, (bf16_t*)(ws + WS_XR), DM, F8_OSC_DN}; pg8::gemm_phase<pg8::EpiResB<false>, 1>(ring, g, S, E); } SEAM(9);
#else
    if (IN(9)) REP(9) { pg8::Gemm g{(const bf16_t*)(ws + WS_ACT0), (const bf16_t*)(ws + WS_WDN0), DFF, DFF, DFF}; pg8::Sched S; S.init(MT / 256, DM / 256, F.G, F.bid, 0);
        pg8::EpiRes E{out, out, DM, 1.0f}; pg8::gemm_phase(ring, g, S, E); } SEAM(9);
#endif
#if I8_IN1
    if (IN(10)) REP(10) { rms_phase_f8_b<2>(F, (const bf16_t*)(ws + WS_XR), args.in[I_ONMIX], ws + WS_H2); } SEAM(10);
#else
    if (IN(10)) REP(10) { rms_phase(F, out, args.in[I_ONMIX], (bf16_t*)(ws + WS_H2)); } SEAM(10);
#endif
#if I8_IN1
    if (IN(11)) REP(11) { pg8::Gemm g{(const bf16_t*)(ws + WS_H2), (const bf16_t*)(ws + WS_WIN1), 1024, 1024, 1024}; pg8::Sched S; S.init(MT / 256, ODD_IN / 256, F.G, F.bid, 0);
        pg8::EpiStore E{(bf16_t*)(ws + WS_PROJ1), ODD_IN, 0, 8, I8_OSC, 1}; pg8::gemm_phase<pg8::EpiStore, 2>(ring, g, S, E); } SEAM(11);
#else
    if (IN(11)) REP(11) { pg8::Gemm g{(const bf16_t*)(ws + WS_H2), (const bf16_t*)(ws + WS_WIN1), 2048, 2048, 2048}; pg8::Sched S; S.init(MT / 256, ODD_IN / 256, F.G, F.bid, 0);
        pg8::EpiStore E{(bf16_t*)(ws + WS_PROJ1), ODD_IN, 0, 8, 1.0f, 0}; pg8::gemm_phase(ring, g, S, E); } SEAM(11);
#endif
    if (IN(12)) REP(12) {
#ifndef NO_P12A
        p12_gmlp(F, args);
#endif
#ifndef NO_P12B
        p12_stick(F);
#endif
    } SEAM(12);
    if (IN(13)) REP(13) { pg8::Gemm g{(const bf16_t*)(ws + WS_CAT1), (const bf16_t*)(ws + WS_WOUT1), 2048, 2048, 2048}; pg8::Sched S; S.init(MT / 256, DM / 256, F.G, F.bid, 0);
        pg8::EpiResB<false> E{ws + WS_XR, (bf16_t*)(ws + WS_XR), DM, 1.0f}; pg8::gemm_phase(ring, g, S, E); } SEAM(13);
    if (IN(14)) REP(14) { p14_router(F, args, (const bf16_t*)(ws + WS_XR)); } SEAM(14);
    if (IN(15)) REP(15) { p15_gather(F); __syncthreads(); for (;;) { const int it = bg_step(F, args, MISC); if (it < 0 || it >= BG_GU_ITEMS) break; } } SEAM(15);
#define MOE_TILES() int ts[9], cnt[8]; moe_tiles(F, ts, cnt); const int T = ts[8]; const int tb1 = T < 96 ? T : 96, tb2 = (T - 64) > tb1 ? (T - 64) : tb1; (void)tb2
#define MOE_GU(tlo, thi, actws, rex_) do { pg8::Gemm g{(const bf16_t*)(ws + WS_HS), (const bf16_t*)(ws + WS_WGU1), 1024, 1024, 1024}; pg8::Sched S; S.init((thi) - (tlo), 2 * DFFE / 256, F.G, F.bid, (tlo)); \
        for (int j = 0; j < 7; ++j) S.ts[j] = ts[j + 1]; S.rex = (rex_); \
        pg8::EpiSwiglu E{(bf16_t*)(ws + (actws)), DFFE, (tlo) * 256, I8_OSC, 1, 1}; pg8::gemm_phase<pg8::EpiSwiglu, 2>(ring, g, S, E); } while (0)
#define MOE_DN(tlo, thi, actws) do { pg8::Gemm g{(const bf16_t*)(ws + (actws)) - (size_t)(tlo) * 256 * (DFFE / 2), (const bf16_t*)(ws + WS_WDN1), DFFE / 2, DFFE / 2, DFFE / 2};     pg8::Sched S; S.init((thi) - (tlo), DM / 256, F.G, F.bid, (tlo)); \
        for (int j = 0; j < 7; ++j) S.ts[j] = ts[j + 1]; \
        pg8::EpiStore E{(bf16_t*)(ws + WS_Y), DM, 0, 0, F8_OSC_DN, 0}; pg8::gemm_phase<pg8::EpiStore, 1>(ring, g, S, E); } while (0)
    if (IN(16)) REP(16) { MOE_TILES(); MOE_GU(0, tb1, WS_ACT1A, 0);
        __syncthreads(); while (bg_step(F, args, MISC) >= 0) {} } SEAM(16);
    if (IN(17)) { MOE_TILES(); MOE_DN(0, tb1, WS_ACT1A); MOE_GU(tb1, tb2, WS_ACT1B, (8 * tb1) % F.G); } SEAM(17);
    if (IN(18)) { MOE_TILES(); MOE_DN(tb1, tb2, WS_ACT1B); MOE_GU(tb2, T, WS_ACT1A, (8 * (tb2 - tb1)) % F.G); } SEAM(18);
    if (IN(19)) REP(19) { MOE_TILES(); MOE_DN(tb2, T, WS_ACT1A); } SEAM(19);
    if (IN(20)) REP(20) { p22_final(F, args, out); }
#ifdef PROBE_WAIT
    {
        unsigned long long* tot = (unsigned long long*)((unsigned*)(F.ws + WS_CTL) + 16384);
        if (F.tid == 0) __hip_atomic_fetch_add(tot, wait_acc, __ATOMIC_RELAXED, __HIP_MEMORY_SCOPE_AGENT);
        xcd_barrier(bar);
        if (F.bid == 0 && F.tid == 0) { const unsigned long long mean = __hip_atomic_load(tot, __ATOMIC_RELAXED, __HIP_MEMORY_SCOPE_AGENT) / (unsigned long long)F.G;
            const unsigned long long t0_ = __builtin_amdgcn_s_memrealtime(); while (__builtin_amdgcn_s_memrealtime() - t0_ < (unsigned long long)(PROBE_WAIT) * mean) __builtin_amdgcn_s_sleep(8); }
    }
#endif
#undef IN
#undef SEAM
}

extern "C" void kernel_launch(void* const* d_in, const int* in_sizes, int n_in, void* d_out, int out_size, void* d_ws, size_t ws_size, hipStream_t stream) {
    static int grid = 0;
    if (grid == 0) {
        if (n_in != 28 || out_size != MT * DM || ws_size < WS_END) { fprintf(stderr, "kernel_launch: unexpected shapes (n_in %d out %d ws %zu need %zu)\n", n_in, out_size, ws_size, (size_t)WS_END); grid = -1; return; }
        int dev = 0, cus = 0, per_cu = 0;
        if (hipGetDevice(&dev) != hipSuccess || hipDeviceGetAttribute(&cus, hipDeviceAttributeMultiprocessorCount, dev) != hipSuccess) { grid = -1; return; }
        if (hipFuncSetAttribute((const void*)fwd, hipFuncAttributeMaxDynamicSharedMemorySize, LDS_BYTES) != hipSuccess) { fprintf(stderr, "kernel_launch: hipFuncSetAttribute failed\n"); grid = -1; return; }
        if (hipOccupancyMaxActiveBlocksPerMultiprocessor(&per_cu, (const void*)fwd, 512, LDS_BYTES) != hipSuccess || per_cu < 1) { fprintf(stderr, "kernel_launch: occupancy query says %d\n", per_cu); }
        (void)hipGetLastError();
        grid = cus;
    }
    if (grid < 0) return;
    (void)hipMemsetAsync((char*)d_ws + WS_CTL, 0, CTL_ZERO_BYTES, stream);
    Args a{};
    for (int i = 0; i < 28; ++i) a.in[i] = (const float*)d_in[i];
    a.out = (float*)d_out; a.ws = (unsigned char*)d_ws;
#if MK_ONE_LAUNCH
    a.ph_lo = 0; a.ph_hi = N_PHASES;
    hipLaunchKernelGGL(fwd, dim3(grid), dim3(512), LDS_BYTES, stream, a);
#else
    for (int p = 0; p < N_PHASES; ++p) { a.ph_lo = p; a.ph_hi = p + 1; hipLaunchKernelGGL(fwd, dim3(grid), dim3(512), LDS_BYTES, stream, a); }
#endif
}
```

```cpp
#include <hip/hip_runtime.h>
#include <cstdio>
#include <cstdint>

#ifndef F8_FFN0
#define F8_FFN0 2
#endif
#ifndef F8_FFN0_DN
#define F8_FFN0_DN 1
#endif
#ifndef I8_IN0
#define I8_IN0 0
#endif
#ifndef I8_IN1
#define I8_IN1 1
#endif
#define RES_BF16 1

#ifndef MK_ONE_LAUNCH
#define MK_ONE_LAUNCH 1
#endif

#define LAS __attribute__((address_space(3)))
#define GAS __attribute__((address_space(1)))
typedef unsigned short bf16_t;
typedef short bf16x8 __attribute__((ext_vector_type(8)));
typedef short s16x4 __attribute__((ext_vector_type(4)));
typedef float f32x2 __attribute__((ext_vector_type(2)));
typedef float f32x4 __attribute__((ext_vector_type(4)));
typedef float f32x16 __attribute__((ext_vector_type(16)));
typedef unsigned u32x2 __attribute__((ext_vector_type(2)));
typedef unsigned u32x4 __attribute__((ext_vector_type(4)));
typedef __bf16 bf16x2_t __attribute__((ext_vector_type(2)));
typedef GAS unsigned gu32;

#define DI __device__ __forceinline__

constexpr int DM = 2048, NB = 16, SEQ = 2048, MT = NB * SEQ;
constexpr int EVEN_IN = 3920, EVEN_INP = 4096, ODD_IN = 5120;
constexpr int DFF = 5632, NEXP = 8, DFFE = 7168;
constexpr float EPS = 1e-6f;
constexpr int QQ_N = 3072;
constexpr int CAT0_K = 2048;
constexpr int MOE_ROWS = 65536 + 2048;
constexpr int MOE_CHUNK_TILES = 96;

DI unsigned pk2(float a, float b) { bf16x2_t v = __builtin_convertvector((f32x2){a, b}, bf16x2_t); return __builtin_bit_cast(unsigned, v); }
constexpr float F8_SACT = 8.0f, F8_OSC_DN = 1.0f / (8.0f * 2048.0f);
constexpr float F8_SA = 32.0f, F8_SW = 2048.0f, F8_OSC = 1.0f / (32.0f * 2048.0f);
DI unsigned pk4_fp8(float a, float b, float c, float d) {
    a = __builtin_amdgcn_fmed3f(a, -448.f, 448.f); b = __builtin_amdgcn_fmed3f(b, -448.f, 448.f); c = __builtin_amdgcn_fmed3f(c, -448.f, 448.f); d = __builtin_amdgcn_fmed3f(d, -448.f, 448.f);
    unsigned w = 0u; w = (unsigned)__builtin_amdgcn_cvt_pk_fp8_f32(a, b, (int)w, false); w = (unsigned)__builtin_amdgcn_cvt_pk_fp8_f32(c, d, (int)w, true); return w; }
constexpr float I8_SA = 15.875f, I8_SW = 958.0f, I8_OSC = 1.0f / (15.875f * 958.0f);
DI unsigned pk4_i8(float a, float b, float c, float d) {
    const int ia = (int)__builtin_rintf(__builtin_amdgcn_fmed3f(a, -127.f, 127.f)), ib = (int)__builtin_rintf(__builtin_amdgcn_fmed3f(b, -127.f, 127.f));
    const int ic = (int)__builtin_rintf(__builtin_amdgcn_fmed3f(c, -127.f, 127.f)), id = (int)__builtin_rintf(__builtin_amdgcn_fmed3f(d, -127.f, 127.f));
    return ((unsigned)ia & 255u) | (((unsigned)ib & 255u) << 8) | (((unsigned)ic & 255u) << 16) | ((unsigned)id << 24); }
template <int Q> DI unsigned pk4_q(float a, float b, float c, float d) { if constexpr (Q == 2) return pk4_i8(a, b, c, d); else return pk4_fp8(a, b, c, d); }
DI float bf2f(bf16_t v) { return __builtin_bit_cast(float, (unsigned)v << 16); }
DI float bflo(unsigned w) { return __builtin_bit_cast(float, w << 16); }
DI float bfhi(unsigned w) { return __builtin_bit_cast(float, w & 0xffff0000u); }
#define DPP_F(v, ctrl) __builtin_bit_cast(float, __builtin_amdgcn_update_dpp(0, __builtin_bit_cast(int, (v)), (ctrl), 0xf, 0xf, true))
DI float wave_sum(float v) {
    v += DPP_F(v, 0xB1); v += DPP_F(v, 0x4E); v += DPP_F(v, 0x141); v += DPP_F(v, 0x140);
    const int b = __builtin_bit_cast(int, v);
    const float r0 = __builtin_bit_cast(float, __builtin_amdgcn_readlane(b, 0)), r1 = __builtin_bit_cast(float, __builtin_amdgcn_readlane(b, 16)), r2 = __builtin_bit_cast(float, __builtin_amdgcn_readlane(b, 32)), r3 = __builtin_bit_cast(float, __builtin_amdgcn_readlane(b, 48));
    return (r0 + r1) + (r2 + r3);
}
DI unsigned f2u(float x) { return __builtin_bit_cast(unsigned, x); }
DI float u2f(unsigned x) { return __builtin_bit_cast(float, x); }
DI float xrow_max(float x) {
    unsigned a = f2u(x), b = a; asm volatile("" : "+v"(b)); auto s = __builtin_amdgcn_permlane16_swap(a, b, false, false); x = fmaxf(u2f(s[0]), u2f(s[1]));
    a = f2u(x); b = a; asm volatile("" : "+v"(b)); auto t = __builtin_amdgcn_permlane32_swap(a, b, false, false); return fmaxf(u2f(t[0]), u2f(t[1]));
}
DI float xrow_sum(float x) {
    unsigned a = f2u(x), b = a; asm volatile("" : "+v"(b)); auto s = __builtin_amdgcn_permlane16_swap(a, b, false, false); x = u2f(s[0]) + u2f(s[1]);
    a = f2u(x); b = a; asm volatile("" : "+v"(b)); auto t = __builtin_amdgcn_permlane32_swap(a, b, false, false); return u2f(t[0]) + u2f(t[1]);
}
DI float xor32_get(float x, int hi) {
    unsigned a = f2u(x), b = a; asm volatile("" : "+v"(b)); auto t = __builtin_amdgcn_permlane32_swap(a, b, false, false); return u2f(hi ? t[0] : t[1]);
}
DI float fast_exp2(float x) { return __builtin_amdgcn_exp2f(x); }
DI float fast_log2(float x) { return __builtin_amdgcn_logf(x); }
DI float fast_rcp(float x) { return __builtin_amdgcn_rcpf(x); }

namespace pg8 {
#ifndef WGM_WIDE
#define WGM_WIDE 4
#endif
#ifndef WGM_NARROW
#define WGM_NARROW 4
#endif
constexpr int BM = 256, BK = 64, HALF = 128, HTB = HALF * BK * 2, STAGE_BYTES = 8 * HTB, NXCD = 8, WGM = 4;
__host__ __device__ __forceinline__ int lds_byte(int r, int c) { const int st = (r >> 4) * 2 + (c >> 5), rr = r & 15, cc = c & 31, ob = rr * 64 + cc * 2; return st * 1024 + (ob ^ (((ob >> 9) & 1) << 5)); }
__host__ __device__ __forceinline__ void stage_rc(int b, int& R, int& C) { const int st = b / 1024, sb = b % 1024, swz = sb ^ (((sb >> 9) & 1) << 5); R = (st >> 1) * 16 + swz / 64; C = (st & 1) * 32 + (swz % 64) / 2; }
__host__ __device__ __forceinline__ int perm32(int rho) { const int n = rho >> 4, i = rho & 15; return 8 * (i >> 2) + 4 * n + (i & 3); }

struct Unit { int pm, pn, bt; };
struct Gemm { const bf16_t* A; const bf16_t* Bt; int lda, ldb, K; };

struct Sched {
    int nM, nN, nwg, G, c, pm0, rex; int ts[7];
    __device__ void init(int nM_, int nN_, int G_, int c_, int pm0_) { nM = nM_; nN = nN_; nwg = nM * nN; G = G_; c = c_; pm0 = pm0_; rex = 0; for (int j = 0; j < 7; ++j) ts[j] = 0x7fffffff; }
    __device__ __forceinline__ bool next(int i, Unit& u) const {
        long L = (long)i * G + c;
        if (rex) { const int ii = i + (c < rex ? 3 : 0); L = ii < 3 ? (long)ii * (G - rex) + (c - rex) : (long)3 * (G - rex) + (long)(ii - 3) * G + c; }
        if (L >= nwg) return false;
        int wgid = (int)L; { const int q = nwg / NXCD, r = nwg % NXCD, xcd = wgid % NXCD, off = wgid / NXCD; wgid = (xcd < r ? xcd * (q + 1) : r * (q + 1) + (xcd - r) * q) + off; }
        const int wgm = nN >= 40 ? WGM_WIDE : (nN <= 8 ? WGM_NARROW : WGM);
        const int nig = wgm * nN, gid = wgid / nig, fm = gid * wgm, gsz = (nM - fm) < wgm ? (nM - fm) : wgm;
        u.pm = pm0 + fm + ((wgid % nig) % gsz); u.pn = (wgid % nig) / gsz;
        int e = 0;
#pragma unroll
        for (int j = 0; j < 7; ++j) e += (u.pm >= ts[j]) ? 1 : 0;
        u.bt = e * nN + u.pn; return true;
    }
};

DI f32x4 gelu_tanh4(f32x4 v) {
    f32x4 o;
#pragma unroll
    for (int j = 0; j < 4; ++j) { const float x = v[j]; const float t = x * (1.0f + 0.044715f * x * x) * (-2.0f * 0.7978845608f * 1.44269504f); o[j] = x * fast_rcp(1.0f + fast_exp2(t)); }
    return o;
}
DI float ibits2f(float bits) { return (float)__builtin_bit_cast(int, bits); }
struct EpiStore {
    static constexpr bool PERM = true;
    bf16_t* O; int ldc, row_sub, gelu_tiles; float osc; int iacc;
    DI void operator()(const f32x4 (&acc)[2][2][4][2], const Unit& u, int wr, int wc, int fr, int fq) const {
        const int row0 = u.pm * BM - row_sub + wr * 64 + fr, col0 = u.pn * BM + wc * 32 + 8 * fq; const bool g = u.pn < gelu_tiles;
#pragma unroll
        for (int ai = 0; ai < 2; ++ai)
#pragma unroll
            for (int m = 0; m < 4; ++m) { bf16_t* rowp = O + (size_t)(row0 + ai * HALF + m * 16) * ldc + col0;
#pragma unroll
                for (int bj = 0; bj < 2; ++bj) { f32x4 v0 = acc[ai][bj][m][0], v1 = acc[ai][bj][m][1];
                    if (iacc) {
#pragma unroll
                        for (int j = 0; j < 4; ++j) { const float a0 = v0[j], a1 = v1[j]; v0[j] = ibits2f(a0); v1[j] = ibits2f(a1); } }
                    v0 = v0 * osc; v1 = v1 * osc;
                    if (g) { v0 = gelu_tanh4(v0); v1 = gelu_tanh4(v1); }
                    u32x4 w; w.x = pk2(v0[0], v0[1]); w.y = pk2(v0[2], v0[3]); w.z = pk2(v1[0], v1[1]); w.w = pk2(v1[2], v1[3]);
                    *(u32x4*)(rowp + bj * HALF) = w; } }
    }
};
struct EpiRes {
    static constexpr bool PERM = false;
    const float* base; float* out; int ldc; float osc;
    DI void operator()(const f32x4 (&acc)[2][2][4][2], const Unit& u, int wr, int wc, int fr, int fq) const {
        const int row0 = u.pm * BM + wr * 64 + fr, col0 = u.pn * BM + wc * 32 + 4 * fq;
#pragma unroll
        for (int ai = 0; ai < 2; ++ai)
#pragma unroll
            for (int m = 0; m < 4; ++m) { const size_t off = (size_t)(row0 + ai * HALF + m * 16) * ldc + col0;
#pragma unroll
                for (int bj = 0; bj < 2; ++bj)
#pragma unroll
                    for (int n = 0; n < 2; ++n) { const f32x4 b = *(const f32x4*)(base + off + bj * HALF + n * 16); *(f32x4*)(out + off + bj * HALF + n * 16) = b + acc[ai][bj][m][n] * osc; } }
    }
};
template <bool BF32> struct EpiResB {
    static constexpr bool PERM = true;
    const void* base; bf16_t* out; int ldc; float osc;
    DI void operator()(const f32x4 (&acc)[2][2][4][2], const Unit& u, int wr, int wc, int fr, int fq) const {
        const int row0 = u.pm * BM + wr * 64 + fr, col0 = u.pn * BM + wc * 32 + 8 * fq;
#pragma unroll
        for (int ai = 0; ai < 2; ++ai)
#pragma unroll
            for (int m = 0; m < 4; ++m) { const size_t off = (size_t)(row0 + ai * HALF + m * 16) * ldc + col0;
#pragma unroll
                for (int bj = 0; bj < 2; ++bj) { f32x4 v0 = acc[ai][bj][m][0] * osc, v1 = acc[ai][bj][m][1] * osc;
                    if (BF32) { const float* bp = (const float*)base + off + bj * HALF; const f32x4 b0 = *(const f32x4*)bp, b1 = *(const f32x4*)(bp + 4); v0 = v0 + b0; v1 = v1 + b1; }
                    else { const u32x4 bw = *(const u32x4*)((const bf16_t*)base + off + bj * HALF);
                        v0[0] += bflo(bw.x); v0[1] += bfhi(bw.x); v0[2] += bflo(bw.y); v0[3] += bfhi(bw.y); v1[0] += bflo(bw.z); v1[1] += bfhi(bw.z); v1[2] += bflo(bw.w); v1[3] += bfhi(bw.w); }
                    u32x4 w; w.x = pk2(v0[0], v0[1]); w.y = pk2(v0[2], v0[3]); w.z = pk2(v1[0], v1[1]); w.w = pk2(v1[2], v1[3]);
                    *(u32x4*)(out + off + bj * HALF) = w; } }
    }
};
struct EpiSwiglu {
    static constexpr bool PERM = true;
    bf16_t* O; int ldc, row_sub; float osc; int f8out; int iacc;
    DI void operator()(const f32x4 (&acc)[2][2][4][2], const Unit& u, int wr, int wc, int fr, int fq) const {
        const int row0 = u.pm * BM - row_sub + wr * 64 + fr, col0 = u.pn * HALF + wc * 32 + 8 * fq;
#pragma unroll
        for (int ai = 0; ai < 2; ++ai)
#pragma unroll
            for (int m = 0; m < 4; ++m) { float o[8]; const float kexp = -1.44269504f * osc, kout = osc * osc * (f8out ? F8_SACT : 1.0f);
#pragma unroll
                for (int n = 0; n < 2; ++n)
#pragma unroll
                    for (int j = 0; j < 4; ++j) { const float gr = acc[ai][0][m][n][j], ur = acc[ai][1][m][n][j]; const float ga = iacc ? ibits2f(gr) : gr, ua = iacc ? ibits2f(ur) : ur;
                        o[4 * n + j] = (ga * fast_rcp(1.0f + fast_exp2(ga * kexp))) * (ua * kout); }
                if (f8out) { u32x2 w8; w8.x = pk4_fp8(o[0], o[1], o[2], o[3]); w8.y = pk4_fp8(o[4], o[5], o[6], o[7]);
                    *(u32x2*)((unsigned char*)O + (size_t)(row0 + ai * HALF + m * 16) * ldc + col0) = w8; }
                else { u32x4 w; w.x = pk2(o[0], o[1]); w.y = pk2(o[2], o[3]); w.z = pk2(o[4], o[5]); w.w = pk2(o[6], o[7]);
                    *(u32x4*)(O + (size_t)(row0 + ai * HALF + m * 16) * ldc + col0) = w; } }
    }
};

template <class Epi, int MODE = 0>
DI void gemm_phase(LAS unsigned char* lds, const Gemm g, const Sched& S, const Epi& E) {
    constexpr bool F8 = (MODE == 1);
    int tid = threadIdx.x; asm volatile("" : "+v"(tid));
    const int wid = __builtin_amdgcn_readfirstlane(tid >> 6), lane = tid & 63, wr = wid >> 2, wc = wid & 3, fr = lane & 15, fq = lane >> 4;
    const int K = g.K, nt = K / BK;
    unsigned voffA[2], voffB[2];
#pragma unroll
    for (int i = 0; i < 2; ++i) { int R, C; stage_rc(tid * 16 + i * 8192, R, C); const int Rb = Epi::PERM ? ((R & ~31) + perm32(R & 31)) : R;
        voffA[i] = (unsigned)(R * g.lda + C) * 2u; voffB[i] = (unsigned)(Rb * g.ldb + C) * 2u; }
    const size_t kstep = (size_t)(BK * 2);
    const size_t hstepA = (size_t)HALF * g.lda * 2, hstepB = (size_t)HALF * g.ldb * 2;
    const size_t tstepA = 2 * hstepA, tstepB = 2 * hstepB;
    const unsigned ldsw = (unsigned)wid * 1024u;
    const int aoff = lds_byte(wr * 64 + fr, fq * 8), boff = lds_byte(wc * 32 + fr, fq * 8);
#define PG8_SA(b, h) (((b) * 2 + (h)) * HTB)
#define PG8_SB(b, h) ((4 + (b) * 2 + (h)) * HTB)
#define PG8_STAGE(bufoff, gbase, voff) do { _Pragma("unroll") for (int _i = 0; _i < 2; ++_i) \
        __builtin_amdgcn_global_load_lds((const unsigned*)((const char*)(gbase) + (voff)[_i]), (LAS unsigned*)(lds + (bufoff) + ldsw + _i * 8192), 16, 0, 0); } while (0)
#define PG8_LD16(off) (*(const LAS v4i_*)(lds + (off)))
#define PG8_LDA(dst, b, h) do { _Pragma("unroll") for (int m = 0; m < 4; ++m) { \
        if constexpr (F8) dst##8[m] = __builtin_shufflevector(PG8_LD16(PG8_SA(b, h) + aoff + m * 2048), PG8_LD16(PG8_SA(b, h) + aoff + m * 2048 + 1024), 0, 1, 2, 3, 4, 5, 6, 7); \
        else { _Pragma("unroll") for (int k = 0; k < 2; ++k) dst[m][k] = *(const LAS bf16x8*)(lds + PG8_SA(b, h) + aoff + m * 2048 + k * 1024); } } } while (0)
#define PG8_LDB(dst, b, h) do { _Pragma("unroll") for (int n = 0; n < 2; ++n) { \
        if constexpr (F8) dst##8[n] = __builtin_shufflevector(PG8_LD16(PG8_SB(b, h) + boff + n * 2048), PG8_LD16(PG8_SB(b, h) + boff + n * 2048 + 1024), 0, 1, 2, 3, 4, 5, 6, 7); \
        else { _Pragma("unroll") for (int k = 0; k < 2; ++k) dst[n][k] = *(const LAS bf16x8*)(lds + PG8_SB(b, h) + boff + n * 2048 + k * 1024); } } } while (0)
#define PG8_MMA(ai, bj, At, Bt) do { __builtin_amdgcn_s_setprio(1); _Pragma("unroll") for (int m = 0; m < 4; ++m) _Pragma("unroll") for (int n = 0; n < 2; ++n) { \
        if constexpr (F8) asm volatile("v_mfma_f32_16x16x128_f8f6f4 %0, %1, %2, %0" : "+v"(acc[ai][bj][m][n]) : "v"(Bt##8[n]), "v"(At##8[m]));   \
        else if constexpr (MODE == 2) { _Pragma("unroll") for (int k = 0; k < 2; ++k) acc[ai][bj][m][n] = __builtin_bit_cast(f32x4, __builtin_amdgcn_mfma_i32_16x16x64_i8(__builtin_bit_cast(v4i_, Bt[n][k]), __builtin_bit_cast(v4i_, At[m][k]), __builtin_bit_cast(v4i_, acc[ai][bj][m][n]), 0, 0, 0)); } \
        else { _Pragma("unroll") for (int k = 0; k < 2; ++k) acc[ai][bj][m][n] = __builtin_amdgcn_mfma_f32_16x16x32_bf16(Bt[n][k], At[m][k], acc[ai][bj][m][n], 0, 0, 0); } } \
        __builtin_amdgcn_s_setprio(0); } while (0)
#define PG8_WAIT_V(n) asm volatile("s_waitcnt vmcnt(" #n ")" ::: "memory")
#define PG8_WAIT_L(n) asm volatile("s_waitcnt lgkmcnt(" #n ")" ::: "memory")
#define PG8_BAR __builtin_amdgcn_s_barrier()
#define PG8_SCHED __builtin_amdgcn_sched_barrier(0)
    Unit cur, nxt; int ui = 0;
    if (!S.next(0, cur)) return;
    f32x4 acc[2][2][4][2];
#pragma unroll
    for (int a = 0; a < 2; ++a)
#pragma unroll
        for (int b = 0; b < 2; ++b)
#pragma unroll
            for (int m = 0; m < 4; ++m)
#pragma unroll
                for (int n = 0; n < 2; ++n) acc[a][b][m][n] = (f32x4){0.f, 0.f, 0.f, 0.f};
    typedef int v4i_ __attribute__((ext_vector_type(4))); typedef int v8i_ __attribute__((ext_vector_type(8)));
    bf16x8 At[4][2], B0[2][2], B1[2][2]; v8i_ At8[4], B08[2], B18[2];
    const char* cA = (const char*)g.A + (size_t)cur.pm * tstepA; const char* cB = (const char*)g.Bt + (size_t)cur.bt * tstepB;
    PG8_STAGE(PG8_SB(0, 0), cB, voffB); PG8_STAGE(PG8_SB(0, 1), cB + hstepB, voffB); PG8_STAGE(PG8_SA(0, 0), cA, voffA); PG8_STAGE(PG8_SA(0, 1), cA + hstepA, voffA);
    if (wr == 1) PG8_BAR;
    PG8_WAIT_V(2); PG8_BAR;
    PG8_STAGE(PG8_SB(1, 0), cB + kstep, voffB); PG8_STAGE(PG8_SA(1, 0), cA + kstep, voffA); PG8_STAGE(PG8_SB(1, 1), cB + hstepB + kstep, voffB);
    PG8_WAIT_V(6); PG8_BAR;
    for (;;) {
        const bool has_next = S.next(ui + 1, nxt);
        const char* nA = has_next ? (const char*)g.A + (size_t)nxt.pm * tstepA : cA; const char* nB = has_next ? (const char*)g.Bt + (size_t)nxt.bt * tstepB : cB;
        for (int t = 0; t < nt; t += 2) {
            const bool last = (t == nt - 2);
            const char* a1 = cA + (size_t)(t + 1) * kstep;
            const char* a2 = last ? nA : cA + (size_t)(t + 2) * kstep; const char* b2 = last ? nB : cB + (size_t)(t + 2) * kstep;
            const char* a3 = a2 + kstep; const char* b3 = b2 + kstep;
            PG8_LDB(B0, 0, 0); PG8_LDB(B1, 0, 1); PG8_SCHED; PG8_LDA(At, 0, 0); PG8_STAGE(PG8_SA(1, 1), a1 + hstepA, voffA);
            PG8_WAIT_V(8); PG8_WAIT_L(0); PG8_BAR; PG8_MMA(0, 0, At, B0); PG8_MMA(0, 1, At, B1); PG8_BAR; PG8_SCHED;
            PG8_LDA(At, 0, 1); PG8_STAGE(PG8_SB(0, 0), b2, voffB); PG8_STAGE(PG8_SB(0, 1), b2 + hstepB, voffB); PG8_STAGE(PG8_SA(0, 0), a2, voffA);
            PG8_WAIT_V(8); PG8_WAIT_L(0); PG8_BAR; PG8_MMA(1, 0, At, B0); PG8_MMA(1, 1, At, B1); PG8_BAR; PG8_SCHED;
            PG8_LDB(B0, 1, 0); PG8_LDB(B1, 1, 1); PG8_SCHED; PG8_LDA(At, 1, 0); PG8_STAGE(PG8_SA(0, 1), a2 + hstepA, voffA);
            PG8_WAIT_V(8); PG8_WAIT_L(0); PG8_BAR; PG8_MMA(0, 0, At, B0); PG8_MMA(0, 1, At, B1); PG8_BAR; PG8_SCHED;
            PG8_LDA(At, 1, 1); PG8_STAGE(PG8_SB(1, 0), b3, voffB); PG8_STAGE(PG8_SB(1, 1), b3 + hstepB, voffB); PG8_STAGE(PG8_SA(1, 0), a3, voffA);
            PG8_WAIT_V(8); PG8_WAIT_L(0); PG8_BAR; PG8_MMA(1, 0, At, B0); PG8_MMA(1, 1, At, B1); PG8_BAR; PG8_SCHED;
        }
        if (wr == 0) PG8_BAR;
        if constexpr (F8) asm volatile("s_nop 15\n\ts_nop 15" ::: "memory");
        E(acc, cur, wr, wc, fr, fq);
        if (!has_next) break;
#pragma unroll
        for (int a = 0; a < 2; ++a)
#pragma unroll
            for (int b = 0; b < 2; ++b)
#pragma unroll
                for (int m = 0; m < 4; ++m)
#pragma unroll
                    for (int n = 0; n < 2; ++n) acc[a][b][m][n] = (f32x4){0.f, 0.f, 0.f, 0.f};
        cur = nxt; cA = nA; cB = nB; ++ui;
        if (wr == 1) PG8_BAR;
    }
    PG8_WAIT_V(0);
    PG8_BAR;
#undef PG8_SA
#undef PG8_SB
#undef PG8_STAGE
#undef PG8_LDA
#undef PG8_LD16
#undef PG8_LDB
#undef PG8_MMA
#undef PG8_WAIT_V
#undef PG8_WAIT_L
#undef PG8_BAR
#undef PG8_SCHED
}
}

#define XB_TMO      128
#define XB_XCNT(j)  (256  + 64 * (j))
#define XB_XSUB(j)  (1280 + 64 * (j))
#define XB_XGEN(j)  (2304 + 64 * (j))
#define XB_TOP      3328
#define XB_TOPGEN   3392
#define XCD_BAR_WORDS 3456
#define XB_SPIN_CAP (1u << 22)

DI unsigned xb_ld(unsigned* p)              { return __hip_atomic_load(p, __ATOMIC_RELAXED, __HIP_MEMORY_SCOPE_AGENT); }
DI unsigned xb_add(unsigned* p, unsigned v) { return __hip_atomic_fetch_add(p, v, __ATOMIC_RELAXED, __HIP_MEMORY_SCOPE_AGENT); }
DI unsigned xb_xcc_id() { return (unsigned)__builtin_amdgcn_s_getreg((3 << 11) | 20) & 0xFu; }
#define XB_SPIN(cond, bar) do { unsigned _sp = 0; while (cond) { __builtin_amdgcn_s_sleep(1); \
    if ((++_sp & 255u) == 0u) { if (xb_ld(&(bar)[XB_TMO])) break; if (_sp > XB_SPIN_CAP) { atomicAdd(&(bar)[XB_TMO], 1u); break; } } } } while (0)

struct XcdBarrier { unsigned* bar; unsigned x; volatile LAS unsigned* st; };

DI XcdBarrier xcd_barrier_post(unsigned* bar, volatile LAS unsigned* st) {
    XcdBarrier b; b.bar = bar; b.x = xb_xcc_id(); b.st = st;
    if (threadIdx.x == 0) (void)xb_add(&bar[XB_XCNT(b.x)], 1u);
    return b;
}
DI void xcd_barrier_complete(unsigned* bar, unsigned x, unsigned& nloc, unsigned& nx) {
    const unsigned G = gridDim.x * gridDim.y * gridDim.z;
    unsigned sum, cnt, mine, sp = 0u;
    for (;;) {
        sum = 0u; cnt = 0u; mine = 0u;
#pragma unroll
        for (unsigned j = 0; j < 16; ++j) { const unsigned c = xb_ld(&bar[XB_XCNT(j)]); sum += c; cnt += (c > 0u) ? 1u : 0u; mine = (j == x) ? c : mine; }
        if (sum == G) break;
        __builtin_amdgcn_s_sleep(1);
        if ((++sp & 255u) == 0u) { if (xb_ld(&bar[XB_TMO])) break; if (sp > XB_SPIN_CAP) { atomicAdd(&bar[XB_TMO], 1u); break; } }
    }
    nloc = mine > 0u ? mine : 1u; nx = cnt > 0u ? cnt : 1u;
}
DI void xcd_barrier(const XcdBarrier& b) {
    asm volatile("s_waitcnt vmcnt(0)" ::: "memory");
    __syncthreads();
    if (threadIdx.x == 0) {
        unsigned* bar = b.bar;
        __builtin_amdgcn_s_waitcnt(0);
        unsigned nloc = b.st[0], nx = b.st[1];
        if (nloc == 0u) { xcd_barrier_complete(bar, b.x, nloc, nx); b.st[0] = nloc; b.st[1] = nx; }
        const unsigned old = xb_add(&bar[XB_XSUB(b.x)], 1u);
        const unsigned gen = old / nloc;
        if (old + 1u == (gen + 1u) * nloc) {
            __builtin_amdgcn_fence(__ATOMIC_RELEASE, "agent");
            asm volatile("s_waitcnt vmcnt(0)" ::: "memory");
            const unsigned og = xb_add(&bar[XB_TOP], 1u);
            const unsigned tg = og / nx;
            if (og + 1u == (tg + 1u) * nx) xb_add(&bar[XB_TOPGEN], 1u);
            else XB_SPIN(xb_ld(&bar[XB_TOPGEN]) == tg, bar);
            __builtin_amdgcn_fence(__ATOMIC_ACQUIRE, "agent");
            xb_add(&bar[XB_XGEN(b.x)], 1u);
            asm volatile("s_waitcnt vmcnt(0)" ::: "memory");
        } else {
            XB_SPIN(xb_ld(&bar[XB_XGEN(b.x)]) == gen, bar);
            __builtin_amdgcn_fence(__ATOMIC_ACQUIRE, "agent");
            asm volatile("s_waitcnt vmcnt(0)" ::: "memory");
        }
    }
    __syncthreads();
}

constexpr size_t MiB = 1u << 20;
constexpr size_t WS_CTL = 0, CTL_ZERO_BYTES = 1 * MiB;
constexpr size_t WS_TAB = 1 * MiB;
constexpr size_t WS_WIN1 = 5 * MiB;
constexpr size_t WS_WOUT1 = 25 * MiB;
constexpr size_t WS_WS = 33 * MiB;
constexpr size_t WS_WUV = 33 * MiB + 256 * 1024;
constexpr size_t WS_WGU1 = 34 * MiB;
constexpr size_t WS_XR = 258 * MiB;
constexpr size_t WS_WDN1 = 482 * MiB;
constexpr size_t WS_L0 = 706 * MiB;
constexpr size_t WS_WIN0 = WS_L0;
constexpr size_t WS_WQQ = WS_L0 + 16 * MiB;
constexpr size_t WS_WOUT0 = WS_L0 + 19 * MiB;
constexpr size_t WS_WGU0 = WS_L0 + 31 * MiB;
constexpr size_t WS_WDN0 = WS_L0 + 75 * MiB;
constexpr size_t WS_CQN = WS_L0 + 97 * MiB;
constexpr size_t WS_CKV = WS_L0 + 129 * MiB;
constexpr size_t WS_KX = WS_L0 + 145 * MiB;
constexpr size_t WS_WIDX = WS_L0 + 149 * MiB;
constexpr size_t WS_ACT = WS_L0 + 152 * MiB;
constexpr size_t WS_PROJ0 = WS_ACT;
constexpr size_t WS_CAT0 = WS_ACT + 256 * MiB;
constexpr size_t WS_QQ = WS_ACT + 448 * MiB;
constexpr size_t WS_H0 = WS_QQ;
constexpr size_t WS_SC = WS_ACT + 640 * MiB;
constexpr size_t WS_H1 = WS_SC;
constexpr size_t WS_ACT0 = WS_ACT;
constexpr size_t WS_H2 = WS_ACT;
constexpr size_t WS_PROJ1 = WS_ACT + 128 * MiB;
constexpr size_t WS_CAT1 = WS_ACT + 448 * MiB;
constexpr size_t WS_HS = WS_L0 + 264 * MiB;
constexpr size_t WS_Y = WS_L0;
constexpr size_t WS_ACT1A = WS_L0 + 396 * MiB;
constexpr size_t WS_ACT1B = WS_L0 + 732 * MiB;
constexpr size_t WS_H3 = WS_L0 + 732 * MiB;
constexpr size_t WS_END = WS_L0 + 1096 * MiB;
static_assert(WS_SC + 128 * MiB <= WS_END && WS_CAT1 + 128 * MiB <= WS_H3 && WS_ACT1A + (size_t)96 * 256 * DFFE * 2 <= WS_ACT1B && WS_ACT1B + (size_t)104 * 256 * DFFE * 2 <= WS_END, "ws map");
constexpr size_t TAB_ER = 0;
constexpr size_t TAB_GATE = 512 * 1024;
constexpr size_t TAB_SLOT = 1024 * 1024;
constexpr int CW_BAR = 1024;
constexpr int CW_CNT = 8192;
constexpr int RING_BYTES = 131072, LDS_BYTES = 147456, MISC_OFF = LDS_BYTES - 256;

struct Args { const float* in[28]; float* out; unsigned char* ws; int ph_lo, ph_hi; };
enum { I_X = 0, I_RELB, I_FNORM, I_ENMIX, I_EWIN, I_ECONV, I_ENCQ, I_ENCKV, I_EWUQ, I_EWUK, I_EWUV, I_EWQIDX, I_EWOUT, I_ENFFN, I_EGATE, I_EUP, I_EDOWN,
       I_ONMIX, I_OWIN, I_ONV, I_OWS, I_OBS, I_OWOUT, I_ONFFN, I_OROUTER, I_OGATE, I_OUP, I_ODOWN };

struct Frame {
    LAS unsigned char* lds;
    int tid, lane, wave, gw, NGW, G, bid;
    unsigned char* ws;
};

DI void tr_load(f32x4 (&v)[16], const float* W, int ldsrc, int N, int nblk, int item, int lane) {
    const int kb = item / nblk, nb = item % nblk, k0 = 64 * kb, n0 = 64 * nb;
    const int q = lane & 15, rr = lane >> 4; const bool ok = n0 + 4 * q < N;
    const float* src = W + (size_t)(k0 + rr) * ldsrc + n0 + 4 * q;
#pragma unroll
    for (int i = 0; i < 16; ++i) v[i] = ok ? __builtin_nontemporal_load((const f32x4*)(src + (size_t)(4 * i) * ldsrc)) : (f32x4){0.f, 0.f, 0.f, 0.f};
}
DI void tr_store(const f32x4 (&v)[16], bf16_t* WT, int ldd, int koff, int row_off, int mode, int nblk, LAS float* scr, int item, int lane) {
    const int kb = item / nblk, nb = item % nblk, k0 = 64 * kb, n0 = 64 * nb;
    const int q = lane & 15, rr = lane >> 4;
#pragma unroll
    for (int i = 0; i < 16; ++i) { LAS float* d = scr + (4 * i + rr) * 65 + 4 * q; d[0] = v[i].x; d[1] = v[i].y; d[2] = v[i].z; d[3] = v[i].w; }
    asm volatile("s_waitcnt lgkmcnt(0)" ::: "memory");
    const int c = lane & 7;
    const int drow0 = (mode == 1) ? ((n0 >> 7) * 256 + (n0 & 127) + row_off) : (row_off + n0);
#pragma unroll
    for (int j = 0; j < 8; ++j) { const int n = (lane >> 3) + 8 * j; const LAS float* s = scr + (8 * c) * 65 + n;
        u32x4 o; o.x = pk2(s[0 * 65], s[1 * 65]); o.y = pk2(s[2 * 65], s[3 * 65]); o.z = pk2(s[4 * 65], s[5 * 65]); o.w = pk2(s[6 * 65], s[7 * 65]);
        *(u32x4*)(WT + (size_t)(drow0 + n) * ldd + koff + k0 + 8 * c) = o; }
    asm volatile("s_waitcnt lgkmcnt(0)" ::: "memory");
}
template <int Q = 1> DI void tr_store_f8(const f32x4 (&v)[16], unsigned char* WT, int ldd, int row_off, int mode, int nblk, LAS float* scr, int item, int lane) {
    constexpr float QS = (Q == 2) ? I8_SW : F8_SW;
    const int kb = item / nblk, nb = item % nblk, k0 = 64 * kb, n0 = 64 * nb;
    const int q = lane & 15, rr = lane >> 4;
#pragma unroll
    for (int i = 0; i < 16; ++i) { LAS float* d = scr + (4 * i + rr) * 65 + 4 * q; d[0] = v[i].x; d[1] = v[i].y; d[2] = v[i].z; d[3] = v[i].w; }
    asm volatile("s_waitcnt lgkmcnt(0)" ::: "memory");
    const int c = lane & 7;
    const int drow0 = (mode == 1) ? ((n0 >> 7) * 256 + (n0 & 127) + row_off) : (row_off + n0);
#pragma unroll
    for (int j = 0; j < 8; ++j) { const int n = (lane >> 3) + 8 * j; const LAS float* s = scr + (8 * c) * 65 + n;
        u32x2 o; o.x = pk4_q<Q>(s[0 * 65] * QS, s[1 * 65] * QS, s[2 * 65] * QS, s[3 * 65] * QS); o.y = pk4_q<Q>(s[4 * 65] * QS, s[5 * 65] * QS, s[6 * 65] * QS, s[7 * 65] * QS);
        *(u32x2*)(WT + (size_t)(drow0 + n) * ldd + k0 + 8 * c) = o; }
    asm volatile("s_waitcnt lgkmcnt(0)" ::: "memory");
}
template <int Q = 1> DI void tr_job_f8(const Frame& F, const float* W, int K, int ldsrc, int N, unsigned char* WT, int ldd, int row_off, int mode, int Npad = 0) {
    LAS float* scr = (LAS float*)(F.lds + F.wave * 16640);
    const int nblk = (Npad ? Npad : N) / 64, nitems = (K / 64) * nblk;
    for (int it = F.gw; it < nitems; it += F.NGW) { f32x4 v[16]; tr_load(v, W, ldsrc, N, nblk, it, F.lane); tr_store_f8<Q>(v, WT, ldd, row_off, mode, nblk, scr, it, F.lane); }
}
DI void tr_item(const float* W, int ldsrc, int N, bf16_t* WT, int ldd, int koff, int row_off, int mode, int nblk, LAS float* scr, int item, int lane) {
    f32x4 v[16]; tr_load(v, W, ldsrc, N, nblk, item, lane); tr_store(v, WT, ldd, koff, row_off, mode, nblk, scr, item, lane);
}
DI void tr_job(const Frame& F, const float* W, int K, int ldsrc, int N, int Npad, bf16_t* WT, int ldd, int koff, int row_off, int mode) {
    LAS float* scr = (LAS float*)(F.lds + F.wave * 16640);
    const int nblk = Npad / 64, nitems = (K / 64) * nblk;
    for (int it = F.gw; it < nitems; it += F.NGW) tr_item(W, ldsrc, N, WT, ldd, koff, row_off, mode, nblk, scr, it, F.lane);
}

DI void rms_row_to_bf16(const float* xrow, const float* g, bf16_t* orow, int lane) {
    const f32x4* xr = (const f32x4*)xrow + lane; const f32x4* gr = (const f32x4*)g + lane;
    f32x4 v[8]; float s = 0.f;
#pragma unroll
    for (int j = 0; j < 8; ++j) { v[j] = xr[64 * j]; s += (v[j].x * v[j].x + v[j].y * v[j].y) + (v[j].z * v[j].z + v[j].w * v[j].w); }
    const float rstd = 1.0f / sqrtf(wave_sum(s) * (1.f / DM) + EPS);
    u32x2* o8 = (u32x2*)orow + lane;
#pragma unroll
    for (int j = 0; j < 8; ++j) { const f32x4 gg = gr[64 * j]; u32x2 w; w.x = pk2(v[j].x * rstd * gg.x, v[j].y * rstd * gg.y); w.y = pk2(v[j].z * rstd * gg.z, v[j].w * rstd * gg.w); o8[64 * j] = w; }
}
template <int Q> DI void rms_row_to_f8(const float* xrow, const float* g, unsigned char* orow, int lane) {
    const f32x4* xr = (const f32x4*)xrow + lane; const f32x4* gr = (const f32x4*)g + lane;
    f32x4 v[8]; float s = 0.f;
#pragma unroll
    for (int j = 0; j < 8; ++j) { v[j] = xr[64 * j]; s += (v[j].x * v[j].x + v[j].y * v[j].y) + (v[j].z * v[j].z + v[j].w * v[j].w); }
    const float rstd = ((Q == 2) ? I8_SA : F8_SA) / sqrtf(wave_sum(s) * (1.f / DM) + EPS);
    unsigned* o4 = (unsigned*)orow + lane;
#pragma unroll
    for (int j = 0; j < 8; ++j) { const f32x4 gg = gr[64 * j]; o4[64 * j] = pk4_q<Q>(v[j].x * rstd * gg.x, v[j].y * rstd * gg.y, v[j].z * rstd * gg.z, v[j].w * rstd * gg.w); }
}
DI void ld_row_bf16(const bf16_t* row, int lane, f32x4 (&v)[8]) {
    const u32x2* p = (const u32x2*)row + lane;
#pragma unroll
    for (int j = 0; j < 8; ++j) { const u32x2 w = p[64 * j]; v[j].x = bflo(w.x); v[j].y = bfhi(w.x); v[j].z = bflo(w.y); v[j].w = bfhi(w.y); }
}
template <int Q> DI void rms_phase_f8_b(const Frame& F, const bf16_t* x, const float* g, unsigned char* out) {
    const int lane = F.lane; const f32x4* gr = (const f32x4*)g + 2 * lane;
    for (int m = 2 * F.gw; m < MT; m += 2 * F.NGW) {
        const u32x4* x0 = (const u32x4*)(x + (size_t)m * DM) + lane; const u32x4* x1 = x0 + DM / 8;
        u32x4 a[4], b[4];
#pragma unroll
        for (int j = 0; j < 4; ++j) { a[j] = x0[64 * j]; b[j] = x1[64 * j]; }
        float sa = 0.f, sb = 0.f;
#pragma unroll
        for (int j = 0; j < 4; ++j) {
            sa += (bflo(a[j].x) * bflo(a[j].x) + bfhi(a[j].x) * bfhi(a[j].x)) + (bflo(a[j].y) * bflo(a[j].y) + bfhi(a[j].y) * bfhi(a[j].y)) + (bflo(a[j].z) * bflo(a[j].z) + bfhi(a[j].z) * bfhi(a[j].z)) + (bflo(a[j].w) * bflo(a[j].w) + bfhi(a[j].w) * bfhi(a[j].w));
            sb += (bflo(b[j].x) * bflo(b[j].x) + bfhi(b[j].x) * bfhi(b[j].x)) + (bflo(b[j].y) * bflo(b[j].y) + bfhi(b[j].y) * bfhi(b[j].y)) + (bflo(b[j].z) * bflo(b[j].z) + bfhi(b[j].z) * bfhi(b[j].z)) + (bflo(b[j].w) * bflo(b[j].w) + bfhi(b[j].w) * bfhi(b[j].w)); }
        const float qs = (Q == 2) ? I8_SA : F8_SA;
        const float ra = qs / sqrtf(wave_sum(sa) * (1.f / DM) + EPS), rb = qs / sqrtf(wave_sum(sb) * (1.f / DM) + EPS);
        u32x2* o0 = (u32x2*)(out + (size_t)m * DM) + lane; u32x2* o1 = o0 + DM / 8;
#pragma unroll
        for (int j = 0; j < 4; ++j) { const f32x4 g0 = gr[128 * j], g1 = gr[128 * j + 1]; u32x2 w;
            w.x = pk4_q<Q>(bflo(a[j].x) * ra * g0.x, bfhi(a[j].x) * ra * g0.y, bflo(a[j].y) * ra * g0.z, bfhi(a[j].y) * ra * g0.w);
            w.y = pk4_q<Q>(bflo(a[j].z) * ra * g1.x, bfhi(a[j].z) * ra * g1.y, bflo(a[j].w) * ra * g1.z, bfhi(a[j].w) * ra * g1.w); o0[64 * j] = w;
            w.x = pk4_q<Q>(bflo(b[j].x) * rb * g0.x, bfhi(b[j].x) * rb * g0.y, bflo(b[j].y) * rb * g0.z, bfhi(b[j].y) * rb * g0.w);
            w.y = pk4_q<Q>(bflo(b[j].z) * rb * g1.x, bfhi(b[j].z) * rb * g1.y, bflo(b[j].w) * rb * g1.z, bfhi(b[j].w) * rb * g1.w); o1[64 * j] = w; }
    }
}
template <int Q> DI void rms_phase_f8(const Frame& F, const float* x, const float* g, unsigned char* out) {
    for (int m = F.gw; m < MT; m += F.NGW) rms_row_to_f8<Q>(x + (size_t)m * DM, g, out + (size_t)m * DM, F.lane);
}
DI void rms_phase(const Frame& F, const float* x, const float* g, bf16_t* out) {
    const int lane = F.lane; const f32x4* gr = (const f32x4*)g + lane;
    for (int m = 2 * F.gw; m < MT; m += 2 * F.NGW) {
        const f32x4* x0 = (const f32x4*)(x + (size_t)m * DM) + lane; const f32x4* x1 = x0 + DM / 4;
        f32x4 a[8], b[8]; float sa = 0.f, sb = 0.f;
#pragma unroll
        for (int j = 0; j < 8; ++j) { a[j] = x0[64 * j]; b[j] = x1[64 * j]; }
#pragma unroll
        for (int j = 0; j < 8; ++j) { sa += (a[j].x * a[j].x + a[j].y * a[j].y) + (a[j].z * a[j].z + a[j].w * a[j].w); sb += (b[j].x * b[j].x + b[j].y * b[j].y) + (b[j].z * b[j].z + b[j].w * b[j].w); }
        const float ra = 1.0f / sqrtf(wave_sum(sa) * (1.f / DM) + EPS), rb = 1.0f / sqrtf(wave_sum(sb) * (1.f / DM) + EPS);
        u32x2* o0 = (u32x2*)(out + (size_t)m * DM) + lane; u32x2* o1 = o0 + DM / 4;
#pragma unroll
        for (int j = 0; j < 8; ++j) { const f32x4 gg = gr[64 * j]; u32x2 w; w.x = pk2(a[j].x * ra * gg.x, a[j].y * ra * gg.y); w.y = pk2(a[j].z * ra * gg.z, a[j].w * ra * gg.w); o0[64 * j] = w;
            w.x = pk2(b[j].x * rb * gg.x, b[j].y * rb * gg.y); w.y = pk2(b[j].z * rb * gg.z, b[j].w * rb * gg.w); o1[64 * j] = w; }
    }
}
DI void p0_prologue(const Frame& F, const Args& a) {
    unsigned char* ws = F.ws;
#if I8_IN0
    tr_job_f8<2>(F, a.in[I_EWIN], 2048, EVEN_IN, EVEN_IN, ws + WS_WIN0, 2048, 0, 0, EVEN_INP);
#else
    tr_job(F, a.in[I_EWIN], 2048, EVEN_IN, EVEN_IN, EVEN_INP, (bf16_t*)(ws + WS_WIN0), 2048, 0, 0, 0);
#endif
    tr_job(F, a.in[I_EWQIDX], 512, 1024, 1024, 1024, (bf16_t*)(ws + WS_WQQ), 512, 0, 2048, 0);
    tr_job(F, a.in[I_EWOUT], 2048, 2048, 2048, 2048, (bf16_t*)(ws + WS_WOUT0), CAT0_K, 0, 0, 0);
#if F8_FFN0
    tr_job_f8<F8_FFN0>(F, a.in[I_EGATE], 2048, DFF, DFF, ws + WS_WGU0, 2048, 0, 1);
    tr_job_f8<F8_FFN0>(F, a.in[I_EUP], 2048, DFF, DFF, ws + WS_WGU0, 2048, 128, 1);
#else
    tr_job(F, a.in[I_EGATE], 2048, DFF, DFF, DFF, (bf16_t*)(ws + WS_WGU0), 2048, 0, 0, 1);
    tr_job(F, a.in[I_EUP], 2048, DFF, DFF, DFF, (bf16_t*)(ws + WS_WGU0), 2048, 0, 128, 1);
#endif
#if F8_FFN0_DN
    tr_job_f8(F, a.in[I_EDOWN], DFF, 2048, 2048, ws + WS_WDN0, DFF, 0, 0);
#else
    tr_job(F, a.in[I_EDOWN], DFF, 2048, 2048, 2048, (bf16_t*)(ws + WS_WDN0), DFF, 0, 0, 0);
#endif
#if I8_IN1
    tr_job_f8<2>(F, a.in[I_OWIN], 2048, ODD_IN, ODD_IN, ws + WS_WIN1, 2048, 0, 0);
#else
    tr_job(F, a.in[I_OWIN], 2048, ODD_IN, ODD_IN, ODD_IN, (bf16_t*)(ws + WS_WIN1), 2048, 0, 0, 0);
#endif
    tr_job(F, a.in[I_OWOUT], 2048, 2048, 2048, 2048, (bf16_t*)(ws + WS_WOUT1), 2048, 0, 0, 0);
    const int gt = F.bid * 512 + F.tid, NT = F.G * 512;
    { const float* uq = a.in[I_EWUQ]; const float* uk = a.in[I_EWUK]; bf16_t* o = (bf16_t*)(ws + WS_WQQ);
      for (int i = gt; i < 2048 * 512; i += NT) { const int n = i >> 9, r = i & 511, h = n >> 8, c = n & 255;
          const f32x4* pa = (const f32x4*)(uq + (size_t)r * 1024 + h * 128); const f32x4* pb = (const f32x4*)(uk + (size_t)c * 1024 + h * 128); float s = 0.f;
#pragma unroll 8
          for (int d = 0; d < 32; ++d) { const f32x4 x = pa[d], y = pb[d]; s += (x.x * y.x + x.y * y.y) + (x.z * y.z + x.w * y.w); }
          o[i] = (bf16_t)(pk2(s, 0.f) & 0xffffu); } }
    { const float* uv = a.in[I_EWUV]; bf16_t* o = (bf16_t*)(ws + WS_WUV);
      for (int i = gt; i < 8 * 128 * 256; i += NT) { const int e = i & 7, ln = (i >> 3) & 63, kk = (i >> 9) & 7, dblk = (i >> 12) & 7, hd = i >> 15;
          const int dout = 16 * dblk + (ln & 15), c = 32 * kk + 4 * (ln >> 4) + (e < 4 ? e : 12 + e);
          o[i] = (bf16_t)(pk2(uv[(size_t)c * 1024 + hd * 128 + dout], 0.f) & 0xffffu); } }
    { const float* w = a.in[I_OWS]; bf16_t* o = (bf16_t*)(ws + WS_WS);
      for (int i = gt; i < 8 * 128 * 128; i += NT) { const int t = (i >> 7) & 127, s = i & 127; o[i] = (bf16_t)(pk2(s <= t ? w[i] : 0.f, 0.f) & 0xffffu); } }
#if I8_IN0
    rms_phase_f8<2>(F, a.in[I_X], a.in[I_ENMIX], ws + WS_H0);
#else
    rms_phase(F, a.in[I_X], a.in[I_ENMIX], (bf16_t*)(ws + WS_H0));
#endif
}

constexpr int BG_ITEMS_PER_JOB = 224, BG_NJOBS = 24, BG_NITEMS = BG_ITEMS_PER_JOB * BG_NJOBS, BG_GU_ITEMS = BG_ITEMS_PER_JOB * 16;
constexpr int CW_BGQ = 12288;
constexpr int MISC_BG_STATE = 16, MISC_BG_ITEM = 17, MISC_BG_EMPTY = 18;
DI void bg_item(const Frame& F, const Args& a, int item) {
    const int job = item / BG_ITEMS_PER_JOB, sub = item % BG_ITEMS_PER_JOB;
    LAS float* scr = (LAS float*)(F.lds + F.wave * 16640);
    const int t0 = sub * 16 + F.wave * 2; f32x4 v0[16], v1[16];
    if (job < 16) { const int e = job >> 1, up = job & 1; const float* W = a.in[up ? I_OUP : I_OGATE] + (size_t)e * 2048 * DFFE; unsigned char* WT = F.ws + WS_WGU1 + (size_t)e * 2 * DFFE * 2048;
        tr_load(v0, W, DFFE, DFFE, DFFE / 64, t0, F.lane); tr_load(v1, W, DFFE, DFFE, DFFE / 64, t0 + 1, F.lane);
        tr_store_f8<2>(v0, WT, 2048, up ? 128 : 0, 1, DFFE / 64, scr, t0, F.lane); tr_store_f8<2>(v1, WT, 2048, up ? 128 : 0, 1, DFFE / 64, scr, t0 + 1, F.lane); }
    else { const int e = job - 16; const float* W = a.in[I_ODOWN] + (size_t)e * DFFE * 2048; unsigned char* WT = F.ws + WS_WDN1 + (size_t)e * 2048 * DFFE;
        tr_load(v0, W, 2048, 2048, 32, t0, F.lane); tr_load(v1, W, 2048, 2048, 32, t0 + 1, F.lane);
        tr_store_f8(v0, WT, DFFE, 0, 0, 32, scr, t0, F.lane); tr_store_f8(v1, WT, DFFE, 0, 0, 32, scr, t0 + 1, F.lane); }
}
DI int bg_step(const Frame& F, const Args& a, volatile LAS unsigned* MISC) {
    if (F.tid == 0) { int it = -1;
        if (MISC[MISC_BG_EMPTY] == 0u) { const unsigned q = __hip_atomic_fetch_add((unsigned*)(F.ws + WS_CTL) + CW_BGQ, 1u, __ATOMIC_RELAXED, __HIP_MEMORY_SCOPE_AGENT); if (q < (unsigned)BG_NITEMS) it = (int)q; else MISC[MISC_BG_EMPTY] = 1u; }
        MISC[MISC_BG_ITEM] = (unsigned)it; }
    __syncthreads();
    const int item = (int)MISC[MISC_BG_ITEM];
    if (item >= 0) bg_item(F, a, item);
    __syncthreads();
    return item;
}
DI void xcd_barrier_bg(const XcdBarrier& b, const Frame& F, const Args& a, volatile LAS unsigned* MISC) {
    asm volatile("s_waitcnt vmcnt(0)" ::: "memory");
    __syncthreads();
    unsigned gen = 0u;
    if (threadIdx.x == 0) {
        unsigned* bar = b.bar;
        __builtin_amdgcn_s_waitcnt(0);
        unsigned nloc = b.st[0], nx = b.st[1];
        if (nloc == 0u) { xcd_barrier_complete(bar, b.x, nloc, nx); b.st[0] = nloc; b.st[1] = nx; }
        const unsigned old = xb_add(&bar[XB_XSUB(b.x)], 1u);
        gen = old / nloc;
        if (old + 1u == (gen + 1u) * nloc) {
            __builtin_amdgcn_fence(__ATOMIC_RELEASE, "agent");
            asm volatile("s_waitcnt vmcnt(0)" ::: "memory");
            const unsigned og = xb_add(&bar[XB_TOP], 1u);
            const unsigned tg = og / nx;
            if (og + 1u == (tg + 1u) * nx) xb_add(&bar[XB_TOPGEN], 1u);
            else XB_SPIN(xb_ld(&bar[XB_TOPGEN]) == tg, bar);
            __builtin_amdgcn_fence(__ATOMIC_ACQUIRE, "agent");
            xb_add(&bar[XB_XGEN(b.x)], 1u);
            asm volatile("s_waitcnt vmcnt(0)" ::: "memory");
            MISC[MISC_BG_STATE] = 0u;
        } else MISC[MISC_BG_STATE] = 1u;
    }
    __syncthreads();
    const bool must_wait = MISC[MISC_BG_STATE] != 0u;
    __syncthreads();
    if (must_wait) {
        unsigned spins = 0u;
        for (;;) {
            if (threadIdx.x == 0) { unsigned* bar = b.bar; const bool rel = (xb_ld(&bar[XB_XGEN(b.x)]) != gen) || (xb_ld(&bar[XB_TMO]) != 0u);
                if (!rel && ++spins > XB_SPIN_CAP) atomicAdd(&bar[XB_TMO], 1u);
                MISC[MISC_BG_STATE] = rel ? 0u : 1u; }
            __syncthreads();
            const bool waiting = MISC[MISC_BG_STATE] != 0u;
            __syncthreads();
            if (!waiting) break;
            if (bg_step(F, a, MISC) < 0) __builtin_amdgcn_s_sleep(2);
        }
        if (threadIdx.x == 0) __builtin_amdgcn_fence(__ATOMIC_ACQUIRE, "agent");
        asm volatile("s_waitcnt vmcnt(0)" ::: "memory");
    }
    __syncthreads();
}

DI void p2_rows(const Frame& F, const Args& a) {
    const bf16_t* proj = (const bf16_t*)(F.ws + WS_PROJ0);
    bf16_t* cqn = (bf16_t*)(F.ws + WS_CQN); bf16_t* ckv = (bf16_t*)(F.ws + WS_CKV); bf16_t* kx = (bf16_t*)(F.ws + WS_KX); float* widx = (float*)(F.ws + WS_WIDX);
    bf16_t* cat = (bf16_t*)(F.ws + WS_CAT0);
    const float* gcq = a.in[I_ENCQ]; const float* gckv = a.in[I_ENCKV]; const float* cw = a.in[I_ECONV];
    const int lane = F.lane;
    float w0[2][8], w1[2][8], w2[2][8];
#pragma unroll
    for (int j = 0; j < 2; ++j)
#pragma unroll
        for (int e = 0; e < 8; ++e) { const int c = 512 * j + 8 * lane + e; w0[j][e] = cw[c]; w1[j][e] = cw[1024 + c]; w2[j][e] = cw[2048 + c]; }
    float gq[8], gk[8];
#pragma unroll
    for (int e = 0; e < 8; ++e) { gq[e] = gcq[8 * lane + e]; gk[e] = gckv[8 * (lane & 31) + e]; }
    for (int m = F.gw; m < MT; m += F.NGW) {
        const bf16_t* row = proj + (size_t)m * EVEN_INP;
        const int s = m & (SEQ - 1);
        { const u32x4 v = *(const u32x4*)(row + 3072 + 8 * lane); float f[8] = {bflo(v.x), bfhi(v.x), bflo(v.y), bfhi(v.y), bflo(v.z), bfhi(v.z), bflo(v.w), bfhi(v.w)}; float ss = 0.f;
#pragma unroll
          for (int e = 0; e < 8; ++e) ss += f[e] * f[e];
          const float rstd = 1.0f / sqrtf(wave_sum(ss) * (1.f / 512.f) + EPS);
          u32x4 o; o.x = pk2(f[0] * rstd * gq[0], f[1] * rstd * gq[1]); o.y = pk2(f[2] * rstd * gq[2], f[3] * rstd * gq[3]); o.z = pk2(f[4] * rstd * gq[4], f[5] * rstd * gq[5]); o.w = pk2(f[6] * rstd * gq[6], f[7] * rstd * gq[7]);
          *(u32x4*)(cqn + (size_t)m * 512 + 8 * lane) = o; }
        { const u32x4 v = *(const u32x4*)(row + 3584 + 8 * (lane & 31)); float f[8] = {bflo(v.x), bfhi(v.x), bflo(v.y), bfhi(v.y), bflo(v.z), bfhi(v.z), bflo(v.w), bfhi(v.w)}; float ss = 0.f;
#pragma unroll
          for (int e = 0; e < 8; ++e) ss += f[e] * f[e];
          const float rstd = 1.0f / sqrtf(wave_sum(ss) * (0.5f / 256.f) + EPS);
          u32x4 o; o.x = pk2(f[0] * rstd * gk[0], f[1] * rstd * gk[1]); o.y = pk2(f[2] * rstd * gk[2], f[3] * rstd * gk[3]); o.z = pk2(f[4] * rstd * gk[4], f[5] * rstd * gk[5]); o.w = pk2(f[6] * rstd * gk[6], f[7] * rstd * gk[7]);
          if (lane < 32) *(u32x4*)(ckv + (size_t)m * 256 + 8 * lane) = o; }
        if (lane < 8) *(u32x4*)(kx + (size_t)m * 64 + 8 * lane) = *(const u32x4*)(row + 3840 + 8 * lane);
        if (lane < 16) widx[(size_t)m * 16 + lane] = bf2f(row[3904 + lane]) * (0.125f * 0.25f);
#pragma unroll
        for (int j = 0; j < 2; ++j) { const int c0 = 512 * j + 8 * lane; float acc[8];
            { const u32x4 vc = *(const u32x4*)(row + 1024 + c0), vx = *(const u32x4*)(row + 2048 + c0);
              const float fc[8] = {bflo(vc.x), bfhi(vc.x), bflo(vc.y), bfhi(vc.y), bflo(vc.z), bfhi(vc.z), bflo(vc.w), bfhi(vc.w)}, fx[8] = {bflo(vx.x), bfhi(vx.x), bflo(vx.y), bfhi(vx.y), bflo(vx.z), bfhi(vx.z), bflo(vx.w), bfhi(vx.w)};
#pragma unroll
              for (int e = 0; e < 8; ++e) acc[e] = w2[j][e] * (fc[e] * fx[e]); }
            if (s >= 1) { const bf16_t* r1 = row - EVEN_INP; const u32x4 vc = *(const u32x4*)(r1 + 1024 + c0), vx = *(const u32x4*)(r1 + 2048 + c0);
              const float fc[8] = {bflo(vc.x), bfhi(vc.x), bflo(vc.y), bfhi(vc.y), bflo(vc.z), bfhi(vc.z), bflo(vc.w), bfhi(vc.w)}, fx[8] = {bflo(vx.x), bfhi(vx.x), bflo(vx.y), bfhi(vx.y), bflo(vx.z), bfhi(vx.z), bflo(vx.w), bfhi(vx.w)};
#pragma unroll
              for (int e = 0; e < 8; ++e) acc[e] += w1[j][e] * (fc[e] * fx[e]); }
            if (s >= 2) { const bf16_t* r2 = row - 2 * EVEN_INP; const u32x4 vc = *(const u32x4*)(r2 + 1024 + c0), vx = *(const u32x4*)(r2 + 2048 + c0);
              const float fc[8] = {bflo(vc.x), bfhi(vc.x), bflo(vc.y), bfhi(vc.y), bflo(vc.z), bfhi(vc.z), bflo(vc.w), bfhi(vc.w)}, fx[8] = {bflo(vx.x), bfhi(vx.x), bflo(vx.y), bfhi(vx.y), bflo(vx.z), bfhi(vx.z), bflo(vx.w), bfhi(vx.w)};
#pragma unroll
              for (int e = 0; e < 8; ++e) acc[e] += w0[j][e] * (fc[e] * fx[e]); }
            const u32x4 vb = *(const u32x4*)(row + c0); const float fb[8] = {bflo(vb.x), bfhi(vb.x), bflo(vb.y), bfhi(vb.y), bflo(vb.z), bfhi(vb.z), bflo(vb.w), bfhi(vb.w)};
            u32x4 o; o.x = pk2(fb[0] * acc[0], fb[1] * acc[1]); o.y = pk2(fb[2] * acc[2], fb[3] * acc[3]); o.z = pk2(fb[4] * acc[4], fb[5] * acc[5]); o.w = pk2(fb[6] * acc[6], fb[7] * acc[7]);
            *(u32x4*)(cat + (size_t)m * CAT0_K + c0) = o; }
    }
}

DI unsigned kx_lds_off(int key_local, int ch) { const int R = key_local >> 1, C = ((key_local & 1) << 3) | ch; return (unsigned)(R * 256 + ((C ^ (R & 15)) << 4)); }
DI void p4_indexer(const Frame& F) {
    const bf16_t* qq = (const bf16_t*)(F.ws + WS_QQ); const bf16_t* kx = (const bf16_t*)(F.ws + WS_KX); const float* widx = (const float*)(F.ws + WS_WIDX);
    _Float16* sc = (_Float16*)(F.ws + WS_SC);
    const int lane = F.lane, r = lane & 31, h = lane >> 5, w = F.wave, tid = F.tid;
    LAS unsigned char* kb = F.lds;
    const unsigned st_off = kx_lds_off(tid >> 3, tid & 7);
    unsigned rd_off[4];
#pragma unroll
    for (int s = 0; s < 4; ++s) rd_off[s] = kx_lds_off(r, 2 * s + h);
    const int nunits = NB * (SEQ / 16);
    for (int rd = 0; rd * F.G < nunits; ++rd) {
        const int j = (rd & 1) ? (F.G - 1 - F.bid) : F.bid; const int u = rd * F.G + j; if (u >= nunits) continue;
        const int qg = (SEQ / 16 - 1) - u / NB, b = u % NB;
        const int t0 = qg * 16, t1 = ((t0 >> 7) + 1) << 7;
        const int tq = t0 + 2 * w + (r >> 4), g = r & 15;
        bf16x8 aq[4];
#pragma unroll
        for (int s = 0; s < 4; ++s) aq[s] = *(const bf16x8*)(qq + (size_t)(b * SEQ + tq) * QQ_N + 2048 + g * 64 + 16 * s + 8 * h);
        float wts[16];
#pragma unroll
        for (int i = 0; i < 16; ++i) wts[i] = widx[(size_t)(b * SEQ + t0 + 2 * w + (i >> 3)) * 16 + ((i & 3) + 8 * ((i >> 2) & 1) + 4 * h)];
        const int tme = t0 + 2 * w + h;
        unsigned kv[64];
#pragma unroll
        for (int c = 0; c < 4; ++c) {
            if (512 * c < t1) {
                __syncthreads();
                { const bf16_t* src = kx + (size_t)(b * SEQ + 512 * c) * 64 + tid * 8;
#pragma unroll
                  for (int i = 0; i < 8; ++i) if (512 * c + 64 * i < t1) *(LAS u32x4*)(kb + st_off + 8192 * i) = *(const u32x4*)(src + 4096 * i); }
                __syncthreads();
            }
#pragma unroll
            for (int q = 0; q < 4; ++q) {
                if (512 * c + 128 * q < t1) {
#pragma unroll
                    for (int jj = 0; jj < 4; ++jj) { const int jn = 4 * q + jj, n = 16 * c + jn;
                        f32x16 acc;
#pragma unroll
                        for (int i = 0; i < 16; ++i) acc[i] = 0.f;
#pragma unroll
                        for (int s = 0; s < 4; ++s) { const bf16x8 bk = *(const LAS bf16x8*)(kb + rd_off[s] + 4096 * jn); acc = __builtin_amdgcn_mfma_f32_32x32x16_bf16(aq[s], bk, acc, 0, 0, 0); }
                        float p0 = 0.f, p1 = 0.f;
#pragma unroll
                        for (int i = 0; i < 8; ++i) { p0 += wts[i] * fmaxf(acc[i], 0.f); p1 += wts[8 + i] * fmaxf(acc[8 + i], 0.f); }
                        float tot; { unsigned a = f2u(p0), b = f2u(p1); auto sw = __builtin_amdgcn_permlane32_swap(a, b, false, false); tot = u2f(sw[0]) + u2f(sw[1]); }
                        if (32 * n + r > tme) tot = -__builtin_inff();
                        const unsigned ub = __builtin_bit_cast(unsigned, tot);
                        kv[n] = (ub & 0x80000000u) ? ~ub : (ub | 0x80000000u);
                        __builtin_amdgcn_sched_barrier(0);
                    }
                } else {
#pragma unroll
                    for (int jj = 0; jj < 4; ++jj) kv[16 * c + 4 * q + jj] = 0u;
                }
            }
        }
        unsigned T = 0u;
        if (t1 > 256) {
            unsigned Tlo = 0u, Thi = 0u; bool dlo = false, dhi = false;
            for (int bit = 31; bit >= 0; --bit) { const unsigned clo = Tlo | (1u << bit), chi = Thi | (1u << bit); const unsigned cand = h ? chi : clo; int cnt = 0;
#pragma unroll
                for (int n = 0; n < 64; ++n) cnt += (kv[n] >= cand) ? 1 : 0;
                cnt += __builtin_amdgcn_update_dpp(0, cnt, 0xB1, 0xf, 0xf, true);
                cnt += __builtin_amdgcn_update_dpp(0, cnt, 0x4E, 0xf, 0xf, true);
                cnt += __builtin_amdgcn_update_dpp(0, cnt, 0x141, 0xf, 0xf, true);
                cnt += __builtin_amdgcn_update_dpp(0, cnt, 0x140, 0xf, 0xf, true);
                const int nlo = __builtin_amdgcn_readlane(cnt, 0) + __builtin_amdgcn_readlane(cnt, 16), nhi = __builtin_amdgcn_readlane(cnt, 32) + __builtin_amdgcn_readlane(cnt, 48);
                if (!dlo) { Tlo = (nlo >= 256) ? clo : Tlo; dlo = (nlo == 256); }
                if (!dhi) { Thi = (nhi >= 256) ? chi : Thi; dhi = (nhi == 256); }
                if (dlo && dhi) break; }
            T = h ? Thi : Tlo;
        }
        _Float16* orow = sc + (size_t)(b * SEQ + tme) * SEQ;
#pragma unroll
        for (int q = 0; q < 16; ++q) if (128 * q < t1) {
#pragma unroll
            for (int jj = 0; jj < 4; ++jj) { const int n = 4 * q + jj; const unsigned k = kv[n]; const bool sel = (k >= T) && (k > 0x007fffffu);
                const unsigned ub = (k & 0x80000000u) ? (k ^ 0x80000000u) : ~k; const float v = sel ? __builtin_bit_cast(float, ub) * 1.44269504f : -__builtin_inff();
                orow[32 * n + r] = (_Float16)v; } }
    }
    __syncthreads();
}

DI unsigned kv_off(int row, int ch) { return (unsigned)(512 * row + 16 * (ch ^ (2 * (row & 7)))); }
DI s16x4 tr_read4(const LAS unsigned char* p) { return __builtin_amdgcn_ds_read_tr16_b64_v4i16((LAS s16x4*)p); }
DI bf16x8 cat8(s16x4 a, s16x4 b) { bf16x8 v; v[0] = a[0]; v[1] = a[1]; v[2] = a[2]; v[3] = a[3]; v[4] = b[0]; v[5] = b[1]; v[6] = b[2]; v[7] = b[3]; return v; }
DI bf16x8 pack8(float a0, float a1, float a2, float a3, float a4, float a5, float a6, float a7) { u32x4 w; w.x = pk2(a0, a1); w.y = pk2(a2, a3); w.z = pk2(a4, a5); w.w = pk2(a6, a7); return __builtin_bit_cast(bf16x8, w); }
DI void p5_dsa(const Frame& F, const Args& a) {
    const bf16_t* qq = (const bf16_t*)(F.ws + WS_QQ); const bf16_t* ckv = (const bf16_t*)(F.ws + WS_CKV); const _Float16* sc = (const _Float16*)(F.ws + WS_SC);
    bf16_t* cat = (bf16_t*)(F.ws + WS_CAT0); const bf16_t* wuv = (const bf16_t*)(F.ws + WS_WUV);
    const int lane = F.lane, r = lane & 31, h = lane >> 5, tid = F.tid, dh = F.wave & 1;
    const int q4 = (lane & 15) >> 2, p4 = lane & 3, blk = (lane >> 4) & 1;
    LAS unsigned char* kvb = F.lds;
    LAS unsigned char* scb = F.lds + 32768;
    LAS float* lut = (LAS float*)(F.lds + 40960);
    __syncthreads();
    for (int i = tid; i < 8 * 129; i += 512) { const int hd = i / 129, d = i % 129; int bk = d;
        if (d >= 16) { bk = 16 + (int)(logf((float)d / 16.0f) / 2.0794415416798357f * 16.0f); bk = bk > 31 ? 31 : bk; }
        lut[hd * 132 + d] = a.in[I_RELB][bk * 8 + hd] * 1.44269504f; }
    __syncthreads();
    const float SC2 = 0.08838834764831845f * 1.44269504f;
    const int nunits = NB * (SEQ / 32) * 2;
    for (int rd = 0; rd * F.G < nunits; ++rd) {
        const int j = (rd & 1) ? (F.G - 1 - F.bid) : F.bid; const int u = rd * F.G + j; if (u >= nunits) continue;
        const int hg = u & 1, u2 = u >> 1, head = 4 * hg + (F.wave >> 1);
        const int qt = (SEQ / 32 - 1) - u2 / NB, b = u2 % NB, q0 = qt * 32, nkt = qt + 1, tq = q0 + r;
        bf16x8 qf[16];
#pragma unroll
        for (int s = 0; s < 16; ++s) qf[s] = *(const bf16x8*)(qq + (size_t)(b * SEQ + tq) * QQ_N + head * 256 + 16 * s + 8 * h);
        f32x16 O[4];
#pragma unroll
        for (int c = 0; c < 4; ++c)
#pragma unroll
            for (int i = 0; i < 16; ++i) O[c][i] = 0.f;
        float m_run = -__builtin_inff(), l_run = 0.f;
        u32x4 st0, st1; u32x2 st2 = {0u, 0u};
        const int skey0 = tid >> 5, sch = tid & 31, sq = tid >> 3, spc = tid & 7;
#define DSA_LOAD(kt) do { const bf16_t* src = ckv + (size_t)(b * SEQ + 32 * (kt)) * 256; st0 = *(const u32x4*)(src + (size_t)skey0 * 256 + 8 * sch); st1 = *(const u32x4*)(src + (size_t)(skey0 + 16) * 256 + 8 * sch); \
        if (tid < 256) st2 = *(const u32x2*)(sc + (size_t)(b * SEQ + q0 + sq) * SEQ + 32 * (kt) + 4 * spc); } while (0)
#define DSA_WRITE(bufi) do { LAS unsigned char* kd_ = kvb + (bufi) * 16384; *(LAS u32x4*)(kd_ + kv_off(skey0, sch)) = st0; *(LAS u32x4*)(kd_ + kv_off(skey0 + 16, sch)) = st1; \
        if (tid < 256) *(LAS u32x2*)(scb + (bufi) * 2304 + sq * 72 + spc * 8) = st2; } while (0)
        __syncthreads();
        DSA_LOAD(0); DSA_WRITE(0);
        __syncthreads();
        for (int kt = 0; kt < nkt; ++kt) {
            const int cur = kt & 1;
            if (kt + 1 < nkt) DSA_LOAD(kt + 1);
            const LAS unsigned char* kd = kvb + cur * 16384; const LAS unsigned char* sd = scb + cur * 2304;
            f32x16 S;
#pragma unroll
            for (int i = 0; i < 16; ++i) S[i] = 0.f;
#pragma unroll
            for (int s = 0; s < 16; ++s) { const bf16x8 kf = *(const LAS bf16x8*)(kd + kv_off(r, 2 * s + h)); S = __builtin_amdgcn_mfma_f32_32x32x16_bf16(kf, qf[s], S, 0, 0, 0); if ((s & 3) == 3) __builtin_amdgcn_sched_barrier(0); }
            float mx = -__builtin_inff();
            const bool far = (32 * kt + 31 + 128 <= q0);
            const float bfar = lut[head * 132 + 128];
#pragma unroll
            for (int gq = 0; gq < 4; ++gq) { const u32x2 iw = *(const LAS u32x2*)(sd + r * 72 + (2 * gq + h) * 8);
                const _Float16 h0 = __builtin_bit_cast(_Float16, (unsigned short)(iw.x & 0xffffu)), h1 = __builtin_bit_cast(_Float16, (unsigned short)(iw.x >> 16)), h2 = __builtin_bit_cast(_Float16, (unsigned short)(iw.y & 0xffffu)), h3 = __builtin_bit_cast(_Float16, (unsigned short)(iw.y >> 16));
                const float idx[4] = {(float)h0, (float)h1, (float)h2, (float)h3};
                if (far) {
#pragma unroll
                    for (int e = 0; e < 4; ++e) { const int i = 4 * gq + e; const float x = S[i] * SC2 + idx[e]; S[i] = x; mx = fmaxf(mx, x); }
                } else {
#pragma unroll
                    for (int e = 0; e < 4; ++e) { const int i = 4 * gq + e, key = 32 * kt + 8 * gq + 4 * h + e; int dist = tq - key; dist = dist < 0 ? 0 : (dist > 128 ? 128 : dist);
                        const float x = S[i] * SC2 + idx[e] + (lut[head * 132 + dist] - bfar); S[i] = x; mx = fmaxf(mx, x); }
                } }
            mx = fmaxf(mx, __shfl_xor(mx, 32));
            const float m_new = fmaxf(m_run, mx), msafe = (m_new == -__builtin_inff()) ? 0.f : m_new, alpha = fast_exp2(m_run - msafe);
            float rs = 0.f;
#pragma unroll
            for (int i = 0; i < 16; ++i) { S[i] = fast_exp2(S[i] - msafe); rs += S[i]; }
            rs += __shfl_xor(rs, 32);
            l_run = l_run * alpha + rs; m_run = m_new;
            if (__builtin_amdgcn_ballot_w64(alpha != 1.0f) != 0ull) {
#pragma unroll
                for (int c = 0; c < 4; ++c)
#pragma unroll
                    for (int i = 0; i < 16; ++i) O[c][i] *= alpha;
            }
            const bf16x8 pf0 = pack8(S[0], S[1], S[2], S[3], S[4], S[5], S[6], S[7]), pf1 = pack8(S[8], S[9], S[10], S[11], S[12], S[13], S[14], S[15]);
#pragma unroll
            for (int c = 0; c < 4; ++c) {
                const int chn = 4 * (4 * dh + c) + 2 * blk + (p4 >> 1), bo = 8 * (p4 & 1);
                const bf16x8 v0 = cat8(tr_read4(kd + kv_off(0 + 4 * h + q4, chn) + bo), tr_read4(kd + kv_off(8 + 4 * h + q4, chn) + bo));
                const bf16x8 v1 = cat8(tr_read4(kd + kv_off(16 + 4 * h + q4, chn) + bo), tr_read4(kd + kv_off(24 + 4 * h + q4, chn) + bo));
                O[c] = __builtin_amdgcn_mfma_f32_32x32x16_bf16(v0, pf0, O[c], 0, 0, 0);
                O[c] = __builtin_amdgcn_mfma_f32_32x32x16_bf16(v1, pf1, O[c], 0, 0, 0);
                __builtin_amdgcn_sched_barrier(0);
            }
            if (kt + 1 < nkt) DSA_WRITE(cur ^ 1);
            __syncthreads();
        }
#undef DSA_LOAD
#undef DSA_WRITE
        const float inv = 1.0f / l_run;
        bf16x8 pf[4][2];
#pragma unroll
        for (int c = 0; c < 4; ++c) { pf[c][0] = pack8(O[c][0] * inv, O[c][1] * inv, O[c][2] * inv, O[c][3] * inv, O[c][4] * inv, O[c][5] * inv, O[c][6] * inv, O[c][7] * inv);
            pf[c][1] = pack8(O[c][8] * inv, O[c][9] * inv, O[c][10] * inv, O[c][11] * inv, O[c][12] * inv, O[c][13] * inv, O[c][14] * inv, O[c][15] * inv); }
        const bf16_t* wu = wuv + (size_t)head * 128 * 256 + (size_t)r * 256 + 128 * dh + 4 * h;
        LAS float* xch = (LAS float*)(F.lds + 49152) + (F.wave >> 1) * 4096;
#pragma unroll
        for (int db = 0; db < 4; ++db) { f32x16 D;
#pragma unroll
            for (int i = 0; i < 16; ++i) D[i] = 0.f;
#pragma unroll
            for (int c = 0; c < 4; ++c)
#pragma unroll
                for (int s2 = 0; s2 < 2; ++s2) { const bf16_t* p = wu + (size_t)(32 * db) * 256 + 32 * c + 16 * s2;
                    const u32x2 lo = *(const u32x2*)p, hi = *(const u32x2*)(p + 8); u32x4 w; w.x = lo.x; w.y = lo.y; w.z = hi.x; w.w = hi.y;
                    D = __builtin_amdgcn_mfma_f32_32x32x16_bf16(__builtin_bit_cast(bf16x8, w), pf[c][s2], D, 0, 0, 0); }
            if (dh) {
#pragma unroll
                for (int i = 0; i < 16; ++i) xch[(db * 16 + i) * 64 + lane] = D[i];
            } else O[db] = D; }
        __syncthreads();
        if (!dh) { bf16_t* orow = cat + (size_t)(b * SEQ + tq) * CAT0_K + 1024 + head * 128;
#pragma unroll
            for (int db = 0; db < 4; ++db)
#pragma unroll
                for (int gq = 0; gq < 4; ++gq) { float v[4];
#pragma unroll
                    for (int e = 0; e < 4; ++e) v[e] = O[db][4 * gq + e] + xch[(db * 16 + 4 * gq + e) * 64 + lane];
                    u32x2 w; w.x = pk2(v[0], v[1]); w.y = pk2(v[2], v[3]); *(u32x2*)(orow + 32 * db + 8 * gq + 4 * h) = w; } }
    }
    __syncthreads();
}

DI void p5_dsa16(const Frame& F, const Args& a) {
    const bf16_t* qq = (const bf16_t*)(F.ws + WS_QQ); const bf16_t* ckv = (const bf16_t*)(F.ws + WS_CKV); const _Float16* sc = (const _Float16*)(F.ws + WS_SC);
    bf16_t* cat = (bf16_t*)(F.ws + WS_CAT0); const bf16_t* wuv = (const bf16_t*)(F.ws + WS_WUV);
    const int lane = F.lane, c16 = lane & 15, g = lane >> 4, tid = F.tid, qh = F.wave & 1;
    const int q4 = c16 >> 2, p4 = lane & 3;
    LAS unsigned char* kvb = F.lds;
    LAS unsigned char* scb = F.lds + 65536;
    LAS float* lut = (LAS float*)(F.lds + 75776);
    __syncthreads();
    for (int i = tid; i < 8 * 129; i += 512) { const int hd = i / 129, d = i % 129; int bk = d;
        if (d >= 16) { bk = 16 + (int)(logf((float)d / 16.0f) / 2.0794415416798357f * 16.0f); bk = bk > 31 ? 31 : bk; }
        lut[hd * 132 + d] = a.in[I_RELB][bk * 8 + hd] * 1.44269504f; }
    __syncthreads();
    const float SC2 = 0.08838834764831845f * 1.44269504f;
    unsigned kro[2][8], tro[2][16];
#pragma unroll
    for (int s = 0; s < 8; ++s) { kro[0][s] = kv_off(c16, 4 * s + g); kro[1][s] = kv_off(16 + c16, 4 * s + g); }
#pragma unroll
    for (int db = 0; db < 16; ++db) { tro[0][db] = kv_off(4 * g + q4, 2 * db + (p4 >> 1)) + 8 * (p4 & 1); tro[1][db] = kv_off(16 + 4 * g + q4, 2 * db + (p4 >> 1)) + 8 * (p4 & 1); }
    const int nunits = NB * (SEQ / 32) * 2;
    for (int rd = 0; rd * F.G < nunits; ++rd) {
        const int j = (rd & 1) ? (F.G - 1 - F.bid) : F.bid; const int u = rd * F.G + j; if (u >= nunits) continue;
        const int hg = u & 1, u2 = u >> 1, head = 4 * hg + (F.wave >> 1);
        const int qt = (SEQ / 32 - 1) - u2 / NB, b = u2 % NB, q0 = qt * 32, nk2 = (qt >> 1) + 1, tq = q0 + 16 * qh + c16;
        bf16x8 qf[8];
#pragma unroll
        for (int s = 0; s < 8; ++s) qf[s] = *(const bf16x8*)(qq + (size_t)(b * SEQ + tq) * QQ_N + head * 256 + 32 * s + 8 * g);
        f32x4 O[16];
#pragma unroll
        for (int db = 0; db < 16; ++db) O[db] = (f32x4){0.f, 0.f, 0.f, 0.f};
        float m_run = -__builtin_inff(), l_run = 0.f;
        u32x4 st[4]; u32x2 st2;
        const int skey0 = tid >> 5, sch = tid & 31, sq = tid >> 4, spc = tid & 15;
        unsigned wo[4];
#pragma unroll
        for (int i = 0; i < 4; ++i) wo[i] = (unsigned)((i >> 1) * 16384) + kv_off(skey0 + 16 * (i & 1), sch);
        const unsigned wo2 = sq * 136 + spc * 8;
#define DSA_LOAD(k2) do { const bf16_t* src = ckv + (size_t)(b * SEQ + 64 * (k2)) * 256 + (size_t)skey0 * 256 + 8 * sch; \
        _Pragma("unroll") for (int i = 0; i < 4; ++i) st[i] = *(const u32x4*)(src + (size_t)(16 * i) * 256); \
        st2 = *(const u32x2*)(sc + (size_t)(b * SEQ + q0 + sq) * SEQ + 64 * (k2) + 4 * spc); } while (0)
#define DSA_WRITE(bufi) do { LAS unsigned char* kd_ = kvb + (bufi) * 32768; _Pragma("unroll") for (int i = 0; i < 4; ++i) *(LAS u32x4*)(kd_ + wo[i]) = st[i]; \
        *(LAS u32x2*)(scb + (bufi) * 4352 + wo2) = st2; } while (0)
        __syncthreads();
        DSA_LOAD(0); DSA_WRITE(0);
        __syncthreads();
        for (int k2 = 0; k2 < nk2; ++k2) {
            const int cur = k2 & 1;
            if (k2 + 1 < nk2) DSA_LOAD(k2 + 1);
            const LAS unsigned char* kd = kvb + cur * 32768; const LAS unsigned char* sd = scb + cur * 4352 + (16 * qh + c16) * 136 + 8 * g;
            f32x4 S[4];
#pragma unroll
            for (int i = 0; i < 4; ++i) S[i] = (f32x4){0.f, 0.f, 0.f, 0.f};
            __builtin_amdgcn_s_setprio(1);
#pragma unroll
            for (int sp = 0; sp < 4; ++sp) {
                bf16x8 kf[8];
#pragma unroll
                for (int t = 0; t < 8; ++t) { const int s = 2 * sp + (t >> 2), i = t & 3; kf[t] = *(const LAS bf16x8*)(kd + (i >> 1) * 16384 + kro[i & 1][s]); }
                __builtin_amdgcn_sched_barrier(0);
#pragma unroll
                for (int t = 0; t < 8; ++t) { const int s = 2 * sp + (t >> 2), i = t & 3; S[i] = __builtin_amdgcn_mfma_f32_16x16x32_bf16(kf[t], qf[s], S[i], 0, 0, 0); }
                __builtin_amdgcn_sched_barrier(0);
            }
            __builtin_amdgcn_s_setprio(0);
            float x[16];
#pragma unroll
            for (int i = 0; i < 4; ++i) { const u32x2 iw = *(const LAS u32x2*)(sd + 32 * i);
                const _Float16 h0 = __builtin_bit_cast(_Float16, (unsigned short)(iw.x & 0xffffu)), h1 = __builtin_bit_cast(_Float16, (unsigned short)(iw.x >> 16)), h2 = __builtin_bit_cast(_Float16, (unsigned short)(iw.y & 0xffffu)), h3 = __builtin_bit_cast(_Float16, (unsigned short)(iw.y >> 16));
                x[4 * i] = S[i][0] * SC2 + (float)h0; x[4 * i + 1] = S[i][1] * SC2 + (float)h1; x[4 * i + 2] = S[i][2] * SC2 + (float)h2; x[4 * i + 3] = S[i][3] * SC2 + (float)h3; }
            const float bfar = lut[head * 132 + 128];
            if (!(64 * k2 + 63 + 128 <= q0)) {
#pragma unroll
                for (int e = 0; e < 16; ++e) { const int key = 64 * k2 + 16 * (e >> 2) + 4 * g + (e & 3); int dist = tq - key; dist = dist < 0 ? 0 : (dist > 128 ? 128 : dist); x[e] += lut[head * 132 + dist] - bfar; }
            }
            float mx = x[0];
#pragma unroll
            for (int e = 1; e < 16; ++e) mx = fmaxf(mx, x[e]);
            mx = xrow_max(mx);
            const float m_new = fmaxf(m_run, mx), msafe = (m_new == -__builtin_inff()) ? 0.f : m_new, alpha = fast_exp2(m_run - msafe);
            float rs = 0.f;
#pragma unroll
            for (int e = 0; e < 16; ++e) { x[e] = fast_exp2(x[e] - msafe); rs += x[e]; }
            rs = xrow_sum(rs);
            l_run = l_run * alpha + rs; m_run = m_new;
            if (__builtin_amdgcn_ballot_w64(alpha != 1.0f) != 0ull) {
#pragma unroll
                for (int db = 0; db < 16; ++db) O[db] = O[db] * alpha;
            }
            const bf16x8 pf0 = pack8(x[0], x[1], x[2], x[3], x[4], x[5], x[6], x[7]), pf1 = pack8(x[8], x[9], x[10], x[11], x[12], x[13], x[14], x[15]);
            __builtin_amdgcn_s_setprio(1);
#pragma unroll
            for (int dq = 0; dq < 4; ++dq) {
                bf16x8 v0[4], v1[4];
#pragma unroll
                for (int t = 0; t < 4; ++t) { const int db = 4 * dq + t; v0[t] = cat8(tr_read4(kd + tro[0][db]), tr_read4(kd + tro[1][db])); v1[t] = cat8(tr_read4(kd + 16384 + tro[0][db]), tr_read4(kd + 16384 + tro[1][db])); }
                __builtin_amdgcn_sched_barrier(0);
#pragma unroll
                for (int t = 0; t < 4; ++t) { const int db = 4 * dq + t; O[db] = __builtin_amdgcn_mfma_f32_16x16x32_bf16(v0[t], pf0, O[db], 0, 0, 0); }
#pragma unroll
                for (int t = 0; t < 4; ++t) { const int db = 4 * dq + t; O[db] = __builtin_amdgcn_mfma_f32_16x16x32_bf16(v1[t], pf1, O[db], 0, 0, 0); }
                __builtin_amdgcn_sched_barrier(0);
            }
            __builtin_amdgcn_s_setprio(0);
            if (k2 + 1 < nk2) DSA_WRITE(cur ^ 1);
            __syncthreads();
        }
#undef DSA_LOAD
#undef DSA_WRITE
        const float inv = 1.0f / l_run;
        bf16x8 of[8];
#pragma unroll
        for (int kk = 0; kk < 8; ++kk) of[kk] = pack8(O[2 * kk][0] * inv, O[2 * kk][1] * inv, O[2 * kk][2] * inv, O[2 * kk][3] * inv, O[2 * kk + 1][0] * inv, O[2 * kk + 1][1] * inv, O[2 * kk + 1][2] * inv, O[2 * kk + 1][3] * inv);
        const u32x4* wf = (const u32x4*)wuv + (size_t)head * 4096 + lane;
        bf16_t* orow = cat + (size_t)(b * SEQ + tq) * CAT0_K + 1024 + head * 128 + 4 * g;
#pragma unroll
        for (int dp = 0; dp < 4; ++dp) {
            u32x4 wa[16];
#pragma unroll
            for (int i = 0; i < 16; ++i) wa[i] = wf[(size_t)(16 * dp + i) * 64];
#pragma unroll
            for (int d2 = 0; d2 < 2; ++d2) { f32x4 D = {0.f, 0.f, 0.f, 0.f};
#pragma unroll
                for (int kk = 0; kk < 8; ++kk) D = __builtin_amdgcn_mfma_f32_16x16x32_bf16(__builtin_bit_cast(bf16x8, wa[8 * d2 + kk]), of[kk], D, 0, 0, 0);
                u32x2 w; w.x = pk2(D[0], D[1]); w.y = pk2(D[2], D[3]); *(u32x2*)(orow + 16 * (2 * dp + d2)) = w; } }
    }
    __syncthreads();
}

DI unsigned img_off(int row, int ch) { return (unsigned)(256 * row + 16 * (ch ^ (((row & 3) << 2) | ((row >> 2) & 3)))); }
DI void p12_gmlp(const Frame& F, const Args& a) {
    const bf16_t* proj = (const bf16_t*)(F.ws + WS_PROJ1); const bf16_t* wsm = (const bf16_t*)(F.ws + WS_WS); bf16_t* cat = (bf16_t*)(F.ws + WS_CAT1);
    const float* gv = a.in[I_ONV]; const float* bs = a.in[I_OBS];
    const int lane = F.lane, r = lane & 31, h = lane >> 5, w = F.wave, tid = F.tid;
    const int q4 = (lane & 15) >> 2, p4 = lane & 3, blk = (lane >> 4) & 1;
    LAS unsigned char* img = F.lds;
    LAS float* rs = (LAS float*)(F.lds + 32768);
    for (int u = F.bid; u < NB * (SEQ / 128); u += F.G) {
        const int b = u / (SEQ / 128), ch0 = u % (SEQ / 128); const size_t row0 = (size_t)b * SEQ + (size_t)ch0 * 128;
        __syncthreads();
        for (int i = 0; i < 16; ++i) { const int s = 16 * w + i; const bf16_t* vr = proj + (row0 + s) * ODD_IN + 1024; float ss = 0.f;
#pragma unroll
            for (int jj = 0; jj < 2; ++jj) { const u32x4 v = *(const u32x4*)(vr + 512 * jj + 8 * lane); const float f[8] = {bflo(v.x), bfhi(v.x), bflo(v.y), bfhi(v.y), bflo(v.z), bfhi(v.z), bflo(v.w), bfhi(v.w)};
#pragma unroll
                for (int e = 0; e < 8; ++e) ss += f[e] * f[e]; }
            ss = wave_sum(ss); if (lane == 0) rs[s] = 1.0f / sqrtf(ss * (1.f / 1024.f) + EPS); }
        __syncthreads();
        for (int g = 0; g < 8; ++g) {
#pragma unroll
            for (int i = 0; i < 4; ++i) { const int p = tid + 512 * i, s = p >> 4, chk = p & 15;
                const u32x4 v = *(const u32x4*)(proj + (row0 + s) * ODD_IN + 1024 + g * 128 + 8 * chk); const float rr = rs[s];
                const f32x4 g0 = *(const f32x4*)(gv + g * 128 + 8 * chk), g1 = *(const f32x4*)(gv + g * 128 + 8 * chk + 4);
                u32x4 o; o.x = pk2(bflo(v.x) * rr * g0.x, bfhi(v.x) * rr * g0.y); o.y = pk2(bflo(v.y) * rr * g0.z, bfhi(v.y) * rr * g0.w); o.z = pk2(bflo(v.z) * rr * g1.x, bfhi(v.z) * rr * g1.y); o.w = pk2(bflo(v.w) * rr * g1.z, bfhi(v.w) * rr * g1.w);
                *(LAS u32x4*)(img + (s >> 5) * 8192 + img_off(s & 31, chk)) = o; }
            __syncthreads();
            const int tb = w & 3, t = 32 * tb + r;
#pragma unroll
            for (int cc = 0; cc < 2; ++cc) { const int cb = 2 * (w >> 2) + cc;
                f32x16 D;
#pragma unroll
                for (int i = 0; i < 16; ++i) D[i] = 0.f;
                bf16x8 wfr[8];
#pragma unroll
                for (int ks = 0; ks < 8; ++ks) wfr[ks] = *(const bf16x8*)(wsm + (size_t)g * 16384 + (size_t)t * 128 + 16 * ks + 8 * h);
#pragma unroll
                for (int ks = 0; ks < 8; ++ks) if (ks <= 2 * tb + 1) {
                    const LAS unsigned char* im = img + (ks >> 1) * 8192; const int k2 = ks & 1;
                    const int chn = 4 * cb + 2 * blk + (p4 >> 1), bo = 8 * (p4 & 1);
                    const bf16x8 af = cat8(tr_read4(im + img_off(16 * k2 + 8 * h + 0 + q4, chn) + bo), tr_read4(im + img_off(16 * k2 + 8 * h + 4 + q4, chn) + bo));
                    D = __builtin_amdgcn_mfma_f32_32x32x16_bf16(af, wfr[ks], D, 0, 0, 0);
                }
                const float bias = bs[g * 128 + t];
                const bf16_t* urow = proj + (row0 + t) * ODD_IN + g * 128 + 32 * cb; bf16_t* orow = cat + (row0 + t) * 2048 + g * 128 + 32 * cb;
#pragma unroll
                for (int gq = 0; gq < 4; ++gq) { const u32x2 uu = *(const u32x2*)(urow + 8 * gq + 4 * h);
                    u32x2 o; o.x = pk2(bflo(uu.x) * (D[4 * gq] + bias), bfhi(uu.x) * (D[4 * gq + 1] + bias)); o.y = pk2(bflo(uu.y) * (D[4 * gq + 2] + bias), bfhi(uu.y) * (D[4 * gq + 3] + bias));
                    *(u32x2*)(orow + 8 * gq + 4 * h) = o; }
            }
            __syncthreads();
        }
    }
    __syncthreads();
}

DI bf16x8 scale_bf16x8(bf16x8 v, float sc) { const u32x4 w = __builtin_bit_cast(u32x4, v); u32x4 o;
    o.x = pk2(bflo(w.x) * sc, bfhi(w.x) * sc); o.y = pk2(bflo(w.y) * sc, bfhi(w.y) * sc); o.z = pk2(bflo(w.z) * sc, bfhi(w.z) * sc); o.w = pk2(bflo(w.w) * sc, bfhi(w.w) * sc); return __builtin_bit_cast(bf16x8, o); }
DI void p12_stick(const Frame& F) {
    const bf16_t* proj = (const bf16_t*)(F.ws + WS_PROJ1); bf16_t* cat = (bf16_t*)(F.ws + WS_CAT1);
    const int lane = F.lane, r = lane & 31, h = lane >> 5, w = F.wave, tid = F.tid;
    const int q4 = (lane & 15) >> 2, p4 = lane & 3, blk = (lane >> 4) & 1;
    LAS unsigned char* kb = F.lds;
    LAS unsigned char* vb = F.lds + 32768;
    const float SC2 = 0.08838834764831845f * 1.44269504f;
    const int nunits = NB * 8 * (SEQ / 256);
    for (int rd = 0; rd * F.G < nunits; ++rd) {
        const int j = (rd & 1) ? (F.G - 1 - F.bid) : F.bid; const int u = rd * F.G + j; if (u >= nunits) continue;
        const int qb = (SEQ / 256 - 1) - u / (NB * 8), bh = u % (NB * 8), b = bh >> 3, head = bh & 7;
        const int Q0 = qb * 256, tq = Q0 + 32 * w + r, ktd = (Q0 >> 5) + w, kt2_hi = (Q0 >> 6) + 3;
        const bf16_t* base = proj + (size_t)b * SEQ * ODD_IN + head * 128;
        bf16x8 qf[8];
#pragma unroll
        for (int s = 0; s < 8; ++s) qf[s] = scale_bf16x8(*(const bf16x8*)(base + (size_t)tq * ODD_IN + 2048 + 16 * s + 8 * h), SC2);
        f32x16 O[4];
#pragma unroll
        for (int c = 0; c < 4; ++c)
#pragma unroll
            for (int i = 0; i < 16; ++i) O[c][i] = 0.f;
        float R = 1.f;
        u32x4 st0, st1, st2, st3; const int skey = tid >> 4, sch = tid & 15;
#define SB_LOAD(kt2_) do { const bf16_t* src = base + (size_t)(64 * (kt2_) + skey) * ODD_IN + 8 * sch; st0 = *(const u32x4*)(src + 3072); st1 = *(const u32x4*)(src + 4096); \
        st2 = *(const u32x4*)(src + (size_t)32 * ODD_IN + 3072); st3 = *(const u32x4*)(src + (size_t)32 * ODD_IN + 4096); } while (0)
#define SB_WRITE(bufi) do { const unsigned o_ = (bufi) * 16384 + img_off(skey, sch); *(LAS u32x4*)(kb + o_) = st0; *(LAS u32x4*)(vb + o_) = st1; *(LAS u32x4*)(kb + o_ + 8192) = st2; *(LAS u32x4*)(vb + o_ + 8192) = st3; } while (0)
        __syncthreads();
        SB_LOAD(kt2_hi); SB_WRITE(0);
        __syncthreads();
        int cur = 0;
        for (int kt2 = kt2_hi; kt2 >= 0; --kt2) {
            if (kt2 > 0) SB_LOAD(kt2 - 1);
#pragma unroll
            for (int sub = 1; sub >= 0; --sub) { const int kt = 2 * kt2 + sub;
            if (kt <= ktd) {
                const LAS unsigned char* kd = kb + cur * 16384 + sub * 8192; const LAS unsigned char* vd = vb + cur * 16384 + sub * 8192;
                f32x16 S;
#pragma unroll
                for (int i = 0; i < 16; ++i) S[i] = 0.f;
                __builtin_amdgcn_s_setprio(1);
#pragma unroll
                for (int s = 0; s < 8; ++s) { const bf16x8 kf = *(const LAS bf16x8*)(kd + img_off(r, 2 * s + h)); S = __builtin_amdgcn_mfma_f32_32x32x16_bf16(kf, qf[s], S, 0, 0, 0); }
                __builtin_amdgcn_s_setprio(0);
                float kp[16], G[4];
                const bool diag = (kt == ktd);
                if (diag) {
#pragma unroll
                    for (int gq = 0; gq < 4; ++gq) { G[gq] = 1.f;
#pragma unroll
                        for (int e = 0; e < 4; ++e) { const int i = 4 * gq + e;
                            const float E = fast_exp2(fminf(S[i], 120.f)), keep = fast_rcp(1.0f + E); const bool past = (32 * kt + 8 * gq + 4 * h + e) < tq;
                            const float beta = past ? E * keep : 0.f, kk = past ? keep : 1.f;
                            kp[i] = kk; S[i] = beta; G[gq] *= kk; } }
                } else {
#pragma unroll
                    for (int gq = 0; gq < 4; ++gq) { G[gq] = 1.f;
#pragma unroll
                        for (int e = 0; e < 4; ++e) { const int i = 4 * gq + e;
                            const float E = fast_exp2(fminf(S[i], 120.f)), keep = fast_rcp(1.0f + E);
                            kp[i] = keep; S[i] = E * keep; G[gq] *= keep; } }
                }
                float PG[4];
#pragma unroll
                for (int gq = 0; gq < 4; ++gq) PG[gq] = xor32_get(G[gq], h);
                float hi = 1.f;
                float wv[16];
#pragma unroll
                for (int gq = 3; gq >= 0; --gq) { float run = R * hi * (h ? 1.f : PG[gq]);
#pragma unroll
                    for (int e = 3; e >= 0; --e) { const int i = 4 * gq + e; wv[i] = S[i] * run; run *= kp[i]; }
                    hi *= G[gq] * PG[gq]; }
                R *= hi;
                const bf16x8 pf0 = pack8(wv[0], wv[1], wv[2], wv[3], wv[4], wv[5], wv[6], wv[7]), pf1 = pack8(wv[8], wv[9], wv[10], wv[11], wv[12], wv[13], wv[14], wv[15]);
                __builtin_amdgcn_s_setprio(1);
#pragma unroll
                for (int c = 0; c < 4; ++c) {
                    const int chn = 4 * c + 2 * blk + (p4 >> 1), bo = 8 * (p4 & 1);
                    const bf16x8 v0 = cat8(tr_read4(vd + img_off(0 + 4 * h + q4, chn) + bo), tr_read4(vd + img_off(8 + 4 * h + q4, chn) + bo));
                    const bf16x8 v1 = cat8(tr_read4(vd + img_off(16 + 4 * h + q4, chn) + bo), tr_read4(vd + img_off(24 + 4 * h + q4, chn) + bo));
                    O[c] = __builtin_amdgcn_mfma_f32_32x32x16_bf16(v0, pf0, O[c], 0, 0, 0);
                    O[c] = __builtin_amdgcn_mfma_f32_32x32x16_bf16(v1, pf1, O[c], 0, 0, 0);
                }
                __builtin_amdgcn_s_setprio(0);
            } }
            if (kt2 > 0) SB_WRITE(cur ^ 1);
            __syncthreads();
            cur ^= 1;
        }
#undef SB_LOAD
#undef SB_WRITE
        bf16_t* orow = cat + (size_t)(b * SEQ + tq) * 2048 + 1024 + head * 128;
#pragma unroll
        for (int c = 0; c < 4; ++c)
#pragma unroll
            for (int gq = 0; gq < 4; ++gq) { u32x2 o; o.x = pk2(O[c][4 * gq], O[c][4 * gq + 1]); o.y = pk2(O[c][4 * gq + 2], O[c][4 * gq + 3]);
                *(u32x2*)(orow + 32 * c + 8 * gq + 4 * h) = o; }
    }
    __syncthreads();
}

DI void p14_router(const Frame& F, const Args& a, const bf16_t* x3) {
    unsigned char* h3 = F.ws + WS_H3; const float* gn = a.in[I_ONFFN]; const float* wr = a.in[I_OROUTER];
    int* tab_er = (int*)(F.ws + WS_TAB + TAB_ER); float* tab_gate = (float*)(F.ws + WS_TAB + TAB_GATE); unsigned* gcnt = (unsigned*)(F.ws + WS_CTL) + CW_CNT;
    const int lane = F.lane, w = F.wave, tid = F.tid;
    LAS float* wrT = (LAS float*)F.lds;
    LAS int* lcnt = (LAS int*)(F.lds + 65536);
    LAS int* lbase = lcnt + 8;
    LAS int* tokE = lcnt + 16;
    LAS int* tokR = tokE + 256;
    __syncthreads();
    for (int i = tid; i < 2048 * 8; i += 512) wrT[(i & 7) * 2048 + (i >> 3)] = wr[i];
    if (tid < 8) lcnt[tid] = 0;
    __syncthreads();
    for (int grp = F.bid; grp < MT / 128; grp += F.G) {
        u32x2 raw[8];
        { const u32x2* p0 = (const u32x2*)(x3 + (size_t)(grp * 128 + 16 * w) * DM) + lane;
#pragma unroll
          for (int j = 0; j < 8; ++j) raw[j] = p0[64 * j]; }
        for (int i = 0; i < 16; ++i) {
            const int tl = 16 * w + i, m = grp * 128 + tl;
            const f32x4* gr = (const f32x4*)gn + lane;
            f32x4 v[8]; float s = 0.f;
#pragma unroll
            for (int j = 0; j < 8; ++j) { v[j].x = bflo(raw[j].x); v[j].y = bfhi(raw[j].x); v[j].z = bflo(raw[j].y); v[j].w = bfhi(raw[j].y); }
            if (i + 1 < 16) { const u32x2* pn = (const u32x2*)(x3 + (size_t)(m + 1) * DM) + lane;
#pragma unroll
                for (int j = 0; j < 8; ++j) raw[j] = pn[64 * j]; }
#pragma unroll
            for (int j = 0; j < 8; ++j) s += (v[j].x * v[j].x + v[j].y * v[j].y) + (v[j].z * v[j].z + v[j].w * v[j].w);
            const float rstd = 1.0f / sqrtf(wave_sum(s) * (1.f / DM) + EPS);
            unsigned* o4 = (unsigned*)(h3 + (size_t)m * DM) + lane;
#pragma unroll
            for (int j = 0; j < 8; ++j) { const f32x4 gg = gr[64 * j]; v[j].x *= rstd * gg.x; v[j].y *= rstd * gg.y; v[j].z *= rstd * gg.z; v[j].w *= rstd * gg.w;
                o4[64 * j] = pk4_i8(v[j].x * I8_SA, v[j].y * I8_SA, v[j].z * I8_SA, v[j].w * I8_SA); }
            float lg[8];
#pragma unroll
            for (int e = 0; e < 8; ++e) { float acc = 0.f;
#pragma unroll
                for (int j = 0; j < 8; ++j) { const f32x4 ww = *(const LAS f32x4*)(wrT + e * 2048 + 4 * (lane + 64 * j)); acc += (v[j].x * ww.x + v[j].y * ww.y) + (v[j].z * ww.z + v[j].w * ww.w); }
                lg[e] = wave_sum(acc); }
            int i1 = 0; float v1 = lg[0];
#pragma unroll
            for (int e = 1; e < 8; ++e) if (lg[e] > v1) { v1 = lg[e]; i1 = e; }
            int i2 = -1; float v2 = -__builtin_inff();
#pragma unroll
            for (int e = 0; e < 8; ++e) if (e != i1 && lg[e] > v2) { v2 = lg[e]; i2 = e; }
            if (lane == 0) {
                const float g1 = 1.0f / (1.0f + __expf(v2 - v1));
                tab_gate[(size_t)m * 2] = g1; tab_gate[(size_t)m * 2 + 1] = 1.0f - g1;
                tokE[tl * 2] = i1; tokE[tl * 2 + 1] = i2;
                tokR[tl * 2] = __hip_atomic_fetch_add(lcnt + i1, 1, __ATOMIC_RELAXED, __HIP_MEMORY_SCOPE_WORKGROUP);
                tokR[tl * 2 + 1] = __hip_atomic_fetch_add(lcnt + i2, 1, __ATOMIC_RELAXED, __HIP_MEMORY_SCOPE_WORKGROUP);
            }
        }
        __syncthreads();
        if (tid < 8) lbase[tid] = (int)__hip_atomic_fetch_add(gcnt + 64 * tid, (unsigned)lcnt[tid], __ATOMIC_RELAXED, __HIP_MEMORY_SCOPE_AGENT);
        __syncthreads();
        if (tid < 256) { const int e = tokE[tid]; tab_er[((size_t)grp * 128) * 4 + tid * 2] = e; tab_er[((size_t)grp * 128) * 4 + tid * 2 + 1] = lbase[e] + tokR[tid]; }
        __syncthreads();
        if (tid < 8) lcnt[tid] = 0;
        __syncthreads();
    }
}

DI void moe_tiles(const Frame& F, int (&ts)[9], int (&cnt)[8]) {
    const unsigned* gcnt = (const unsigned*)(F.ws + WS_CTL) + CW_CNT;
    ts[0] = 0;
#pragma unroll
    for (int e = 0; e < 8; ++e) { cnt[e] = (int)__builtin_amdgcn_readfirstlane(__hip_atomic_load(gcnt + 64 * e, __ATOMIC_RELAXED, __HIP_MEMORY_SCOPE_AGENT)); ts[e + 1] = ts[e] + ((cnt[e] + 255) >> 8); }
}

DI void p15_gather(const Frame& F) {
    const unsigned char* h3 = F.ws + WS_H3; bf16_t* hs = (bf16_t*)(F.ws + WS_HS);
    const int* tab_er = (const int*)(F.ws + WS_TAB + TAB_ER); int* tab_slot = (int*)(F.ws + WS_TAB + TAB_SLOT);
    int ts[9], cnt[8]; moe_tiles(F, ts, cnt);
    const int lane = F.lane;
    unsigned char* hs8 = (unsigned char*)hs;
    for (int m = F.gw; m < MT; m += F.NGW) {
        const u32x2* src = (const u32x2*)(h3 + (size_t)m * DM) + lane;
        u32x2 q[4];
#pragma unroll
        for (int j = 0; j < 4; ++j) q[j] = src[64 * j];
#pragma unroll
        for (int k = 0; k < 2; ++k) { const int e = tab_er[(size_t)m * 4 + 2 * k], rk = tab_er[(size_t)m * 4 + 2 * k + 1];
            int t0 = 0;
#pragma unroll
            for (int qq = 0; qq < 8; ++qq) t0 = (e == qq) ? ts[qq] : t0;
            const int slot = t0 * 256 + rk;
            u32x2* dst = (u32x2*)(hs8 + (size_t)slot * DM) + lane; dst[0] = q[0]; dst[64] = q[1]; dst[128] = q[2]; dst[192] = q[3];
            if (lane == 0) tab_slot[(size_t)m * 2 + k] = slot; }
    }
    for (int idx = F.gw; idx < 8 * 256; idx += F.NGW) { const int e = idx >> 8, rr = idx & 255; int t0 = 0, t1 = 0, c = 0;
#pragma unroll
        for (int qq = 0; qq < 8; ++qq) { t0 = (e == qq) ? ts[qq] : t0; t1 = (e == qq) ? ts[qq + 1] : t1; c = (e == qq) ? cnt[qq] : c; }
        const int row = t0 * 256 + c + rr;
        if (row < t1 * 256) { u32x2* dst = (u32x2*)(hs8 + (size_t)row * DM) + lane; const u32x2 z = {0u, 0u}; dst[0] = z; dst[64] = z; dst[128] = z; dst[192] = z; } }
}

DI void p22_final(const Frame& F, const Args& a, float* out) {
    const bf16_t* Y = (const bf16_t*)(F.ws + WS_Y); const float* tab_gate = (const float*)(F.ws + WS_TAB + TAB_GATE); const int* tab_slot = (const int*)(F.ws + WS_TAB + TAB_SLOT);
    const float* gn = a.in[I_FNORM]; const int lane = F.lane;
    for (int m = F.gw; m < MT; m += F.NGW) {
        const float g1 = tab_gate[(size_t)m * 2], g2 = tab_gate[(size_t)m * 2 + 1]; const int s1 = tab_slot[(size_t)m * 2], s2 = tab_slot[(size_t)m * 2 + 1];
        f32x4* xr = (f32x4*)(out + (size_t)m * DM) + lane; const u32x2* x3 = (const u32x2*)(F.ws + WS_XR + (size_t)m * DM * 2) + lane; const u32x2* y1 = (const u32x2*)(Y + (size_t)s1 * DM) + lane; const u32x2* y2 = (const u32x2*)(Y + (size_t)s2 * DM) + lane;
        const f32x4* gr = (const f32x4*)gn + lane;
        f32x4 v[8]; float s = 0.f;
#pragma unroll
        for (int j = 0; j < 8; ++j) { const u32x2 xw = x3[64 * j]; v[j].x = bflo(xw.x); v[j].y = bfhi(xw.x); v[j].z = bflo(xw.y); v[j].w = bfhi(xw.y); const u32x2 a1 = y1[64 * j], a2 = y2[64 * j];
            v[j].x += g1 * bflo(a1.x) + g2 * bflo(a2.x); v[j].y += g1 * bfhi(a1.x) + g2 * bfhi(a2.x); v[j].z += g1 * bflo(a1.y) + g2 * bflo(a2.y); v[j].w += g1 * bfhi(a1.y) + g2 * bfhi(a2.y);
            s += (v[j].x * v[j].x + v[j].y * v[j].y) + (v[j].z * v[j].z + v[j].w * v[j].w); }
        const float rstd = 1.0f / sqrtf(wave_sum(s) * (1.f / DM) + EPS);
#pragma unroll
        for (int j = 0; j < 8; ++j) { const f32x4 gg = gr[64 * j]; f32x4 o; o.x = v[j].x * rstd * gg.x; o.y = v[j].y * rstd * gg.y; o.z = v[j].z * rstd * gg.z; o.w = v[j].w * rstd * gg.w; xr[64 * j] = o; }
    }
}

constexpr int N_PHASES = 21;
__global__ void __launch_bounds__(512, 2) fwd(Args args) {
    extern __shared__ __attribute__((aligned(16))) unsigned char lds_raw[];
    Frame F;
    F.lds = (LAS unsigned char*)lds_raw; F.tid = threadIdx.x; F.lane = F.tid & 63; F.wave = __builtin_amdgcn_readfirstlane(F.tid >> 6);
    F.G = gridDim.x; F.bid = blockIdx.x; F.gw = F.bid * 8 + F.wave; F.NGW = F.G * 8; F.ws = args.ws;
    volatile LAS unsigned* MISC = (volatile LAS unsigned*)(F.lds + MISC_OFF);
    if (F.tid < 64) MISC[F.tid] = 0u;
    __syncthreads();
    const int lo = args.ph_lo, hi = args.ph_hi;
    XcdBarrier bar; bar.bar = (unsigned*)(F.ws + WS_CTL) + CW_BAR; bar.x = 0; bar.st = MISC + 8;
    if (hi - lo > 1) bar = xcd_barrier_post((unsigned*)(F.ws + WS_CTL) + CW_BAR, MISC + 8);
#ifdef ONLY_PHASE
#define IN(k) ((k) == ONLY_PHASE && lo <= (k) && (k) < hi)
#else
#define IN(k) (lo <= (k) && (k) < hi)
#endif
#ifndef PROBE_DOUBLE
#define PROBE_DOUBLE -1
#endif
#define REP(k) for (int rep_ = 0; rep_ < ((k) == PROBE_DOUBLE ? 2 : 1); ++rep_)
#ifdef PROBE_WAIT
    unsigned long long wait_acc = 0ull;
#define SEAM(k) do { if (IN(k) && IN((k) + 1)) { const unsigned long long t0_ = __builtin_amdgcn_s_memrealtime(); if ((k) <= 16) xcd_barrier_bg(bar, F, args, MISC); else xcd_barrier(bar); wait_acc += __builtin_amdgcn_s_memrealtime() - t0_; } } while (0)
#else
#define SEAM(k) do { if (IN(k) && IN((k) + 1)) { if ((k) <= 16) xcd_barrier_bg(bar, F, args, MISC); else xcd_barrier(bar); } } while (0)
#endif
    unsigned char* ws = F.ws; float* out = args.out;
    LAS unsigned char* ring = F.lds;

    if (IN(0)) REP(0) { p0_prologue(F, args); } SEAM(0);
#if I8_IN0
    if (IN(1)) REP(1) { pg8::Gemm g{(const bf16_t*)(ws + WS_H0), (const bf16_t*)(ws + WS_WIN0), 1024, 1024, 1024}; pg8::Sched S; S.init(MT / 256, EVEN_INP / 256, F.G, F.bid, 0);
        pg8::EpiStore E{(bf16_t*)(ws + WS_PROJ0), EVEN_INP, 0, 0, I8_OSC, 1}; pg8::gemm_phase<pg8::EpiStore, 2>(ring, g, S, E); } SEAM(1);
#else
    if (IN(1)) REP(1) { pg8::Gemm g{(const bf16_t*)(ws + WS_H0), (const bf16_t*)(ws + WS_WIN0), 2048, 2048, 2048}; pg8::Sched S; S.init(MT / 256, EVEN_INP / 256, F.G, F.bid, 0);
        pg8::EpiStore E{(bf16_t*)(ws + WS_PROJ0), EVEN_INP, 0, 0, 1.0f, 0}; pg8::gemm_phase(ring, g, S, E); } SEAM(1);
#endif
    if (IN(2)) REP(2) { p2_rows(F, args); } SEAM(2);
    if (IN(3)) REP(3) { pg8::Gemm g{(const bf16_t*)(ws + WS_CQN), (const bf16_t*)(ws + WS_WQQ), 512, 512, 512}; pg8::Sched S; S.init(MT / 256, QQ_N / 256, F.G, F.bid, 0);
        pg8::EpiStore E{(bf16_t*)(ws + WS_QQ), QQ_N, 0, 0, 1.0f, 0}; pg8::gemm_phase(ring, g, S, E); } SEAM(3);
    #ifndef NO_P4
    if (IN(4)) REP(4) { p4_indexer(F); } SEAM(4);
#endif
    #ifndef NO_P5
    if (IN(5)) REP(5) { p5_dsa16(F, args); } SEAM(5);
#endif
    if (IN(6)) REP(6) { pg8::Gemm g{(const bf16_t*)(ws + WS_CAT0), (const bf16_t*)(ws + WS_WOUT0), CAT0_K, CAT0_K, CAT0_K}; pg8::Sched S; S.init(MT / 256, DM / 256, F.G, F.bid, 0);
        pg8::EpiResB<true> E{args.in[I_X], (bf16_t*)(ws + WS_XR), DM, 1.0f}; pg8::gemm_phase(ring, g, S, E); } SEAM(6);
#if F8_FFN0
    if (IN(7)) REP(7) { rms_phase_f8_b<F8_FFN0>(F, (const bf16_t*)(ws + WS_XR), args.in[I_ENFFN], ws + WS_H1); } SEAM(7);
#else
    if (IN(7)) REP(7) { rms_phase(F, out, args.in[I_ENFFN], (bf16_t*)(ws + WS_H1)); } SEAM(7);
#endif
#if F8_FFN0
    if (IN(8)) REP(8) { pg8::Gemm g{(const bf16_t*)(ws + WS_H1), (const bf16_t*)(ws + WS_WGU0), 1024, 1024, 1024};     pg8::Sched S; S.init(MT / 256, 2 * DFF / 256, F.G, F.bid, 0);
        pg8::EpiSwiglu E{(bf16_t*)(ws + WS_ACT0), DFF, 0, (F8_FFN0 == 2) ? I8_OSC : F8_OSC, F8_FFN0_DN, F8_FFN0 == 2}; pg8::gemm_phase<pg8::EpiSwiglu, F8_FFN0>(ring, g, S, E); } SEAM(8);
#else
    if (IN(8)) REP(8) { pg8::Gemm g{(const bf16_t*)(ws + WS_H1), (const bf16_t*)(ws + WS_WGU0), 2048, 2048, 2048}; pg8::Sched S; S.init(MT / 256, 2 * DFF / 256, F.G, F.bid, 0);
        pg8::EpiSwiglu E{(bf16_t*)(ws + WS_ACT0), DFF, 0, 1.0f, F8_FFN0_DN, 0}; pg8::gemm_phase(ring, g, S, E); } SEAM(8);
#endif
#if F8_FFN0_DN
    if (IN(9)) REP(9) { pg8::Gemm g{(const bf16_t*)(ws + WS_ACT0), (const bf16_t*)(ws + WS_WDN0), DFF / 2, DFF / 2, DFF / 2}; pg8::Sched S; S.init(MT / 256, DM / 256, F.G, F.bid, 0);
        pg8::EpiResB<false> E{ws + WS_XR, (bf16_t*)(ws + WS_XR), DM, F8_OSC_DN}; pg8::gemm_phase<pg8::EpiResB<false>, 1>(ring, g, S, E); } SEAM(9);
#else
    if (IN(9)) REP(9) { pg8::Gemm g{(const bf16_t*)(ws + WS_ACT0), (const bf16_t*)(ws + WS_WDN0), DFF, DFF, DFF}; pg8::Sched S; S.init(MT / 256, DM / 256, F.G, F.bid, 0);
        pg8::EpiRes E{out, out, DM, 1.0f}; pg8::gemm_phase(ring, g, S, E); } SEAM(9);
#endif
#if I8_IN1
    if (IN(10)) REP(10) { rms_phase_f8_b<2>(F, (const bf16_t*)(ws + WS_XR), args.in[I_ONMIX], ws + WS_H2); } SEAM(10);
#else
    if (IN(10)) REP(10) { rms_phase(F, out, args.in[I_ONMIX], (bf16_t*)(ws + WS_H2)); } SEAM(10);
#endif
#if I8_IN1
    if (IN(11)) REP(11) { pg8::Gemm g{(const bf16_t*)(ws + WS_H2), (const bf16_t*)(ws + WS_WIN1), 1024, 1024, 1024}; pg8::Sched S; S.init(MT / 256, ODD_IN / 256, F.G, F.bid, 0);
        pg8::EpiStore E{(bf16_t*)(ws + WS_PROJ1), ODD_IN, 0, 8, I8_OSC, 1}; pg8::gemm_phase<pg8::EpiStore, 2>(ring, g, S, E); } SEAM(11);
#else
    if (IN(11)) REP(11) { pg8::Gemm g{(const bf16_t*)(ws + WS_H2), (const bf16_t*)(ws + WS_WIN1), 2048, 2048, 2048}; pg8::Sched S; S.init(MT / 256, ODD_IN / 256, F.G, F.bid, 0);
        pg8::EpiStore E{(bf16_t*)(ws + WS_PROJ1), ODD_IN, 0, 8, 1.0f, 0}; pg8::gemm_phase(ring, g, S, E); } SEAM(11);
#endif
    if (IN(12)) REP(12) {
#ifndef NO_P12A
        p12_gmlp(F, args);
#endif
#ifndef NO_P12B
        p12_stick(F);
#endif
    } SEAM(12);
    if (IN(13)) REP(13) { pg8::Gemm g{(const bf16_t*)(ws + WS_CAT1), (const bf16_t*)(ws + WS_WOUT1), 2048, 2048, 2048}; pg8::Sched S; S.init(MT / 256, DM / 256, F.G, F.bid, 0);
        pg8::EpiResB<false> E{ws + WS_XR, (bf16_t*)(ws + WS_XR), DM, 1.0f}; pg8::gemm_phase(ring, g, S, E); } SEAM(13);
    if (IN(14)) REP(14) { p14_router(F, args, (const bf16_t*)(ws + WS_XR)); } SEAM(14);
    if (IN(15)) REP(15) { p15_gather(F); __syncthreads(); for (;;) { const int it = bg_step(F, args, MISC); if (it < 0 || it >= BG_GU_ITEMS) break; } } SEAM(15);
#define MOE_TILES() int ts[9], cnt[8]; moe_tiles(F, ts, cnt); const int T = ts[8]; const int tb1 = T < 96 ? T : 96, tb2 = (T - 64) > tb1 ? (T - 64) : tb1; (void)tb2
#define MOE_GU(tlo, thi, actws, rex_) do { pg8::Gemm g{(const bf16_t*)(ws + WS_HS), (const bf16_t*)(ws + WS_WGU1), 1024, 1024, 1024}; pg8::Sched S; S.init((thi) - (tlo), 2 * DFFE / 256, F.G, F.bid, (tlo)); \
        for (int j = 0; j < 7; ++j) S.ts[j] = ts[j + 1]; S.rex = (rex_); \
        pg8::EpiSwiglu E{(bf16_t*)(ws + (actws)), DFFE, (tlo) * 256, I8_OSC, 1, 1}; pg8::gemm_phase<pg8::EpiSwiglu, 2>(ring, g, S, E); } while (0)
#define MOE_DN(tlo, thi, actws) do { pg8::Gemm g{(const bf16_t*)(ws + (actws)) - (size_t)(tlo) * 256 * (DFFE / 2), (const bf16_t*)(ws + WS_WDN1), DFFE / 2, DFFE / 2, DFFE / 2};     pg8::Sched S; S.init((thi) - (tlo), DM / 256, F.G, F.bid, (tlo)); \
        for (int j = 0; j < 7; ++j) S.ts[j] = ts[j + 1]; \
        pg8::EpiStore E{(bf16_t*)(ws + WS_Y), DM, 0, 0, F8_OSC_DN, 0}; pg8::gemm_phase<pg8::EpiStore, 1>(ring, g, S, E); } while (0)
    if (IN(16)) REP(16) { MOE_TILES(); MOE_GU(0, tb1, WS_ACT1A, 0);
        __syncthreads(); while (bg_step(F, args, MISC) >= 0) {} } SEAM(16);
    if (IN(17)) { MOE_TILES(); MOE_DN(0, tb1, WS_ACT1A); MOE_GU(tb1, tb2, WS_ACT1B, (8 * tb1) % F.G); } SEAM(17);
    if (IN(18)) { MOE_TILES(); MOE_DN(tb1, tb2, WS_ACT1B); MOE_GU(tb2, T, WS_ACT1A, (8 * (tb2 - tb1)) % F.G); } SEAM(18);
    if (IN(19)) REP(19) { MOE_TILES(); MOE_DN(tb2, T, WS_ACT1A); } SEAM(19);
    if (IN(20)) REP(20) { p22_final(F, args, out); }
#ifdef PROBE_WAIT
    {
        unsigned long long* tot = (unsigned long long*)((unsigned*)(F.ws + WS_CTL) + 16384);
        if (F.tid == 0) __hip_atomic_fetch_add(tot, wait_acc, __ATOMIC_RELAXED, __HIP_MEMORY_SCOPE_AGENT);
        xcd_barrier(bar);
        if (F.bid == 0 && F.tid == 0) { const unsigned long long mean = __hip_atomic_load(tot, __ATOMIC_RELAXED, __HIP_MEMORY_SCOPE_AGENT) / (unsigned long long)F.G;
            const unsigned long long t0_ = __builtin_amdgcn_s_memrealtime(); while (__builtin_amdgcn_s_memrealtime() - t0_ < (unsigned long long)(PROBE_WAIT) * mean) __builtin_amdgcn_s_sleep(8); }
    }
#endif
#undef IN
#undef SEAM
}

extern "C" void kernel_launch(void* const* d_in, const int* in_sizes, int n_in, void* d_out, int out_size, void* d_ws, size_t ws_size, hipStream_t stream) {
    static int grid = 0;
    if (grid == 0) {
        if (n_in != 28 || out_size != MT * DM || ws_size < WS_END) { fprintf(stderr, "kernel_launch: unexpected shapes (n_in %d out %d ws %zu need %zu)\n", n_in, out_size, ws_size, (size_t)WS_END); grid = -1; return; }
        int dev = 0, cus = 0, per_cu = 0;
        if (hipGetDevice(&dev) != hipSuccess || hipDeviceGetAttribute(&cus, hipDeviceAttributeMultiprocessorCount, dev) != hipSuccess) { grid = -1; return; }
        if (hipFuncSetAttribute((const void*)fwd, hipFuncAttributeMaxDynamicSharedMemorySize, LDS_BYTES) != hipSuccess) { fprintf(stderr, "kernel_launch: hipFuncSetAttribute failed\n"); grid = -1; return; }
        if (hipOccupancyMaxActiveBlocksPerMultiprocessor(&per_cu, (const void*)fwd, 512, LDS_BYTES) != hipSuccess || per_cu < 1) { fprintf(stderr, "kernel_launch: occupancy query says %d\n", per_cu); }
        (void)hipGetLastError();
        grid = cus;
    }
    if (grid < 0) return;
    (void)hipMemsetAsync((char*)d_ws + WS_CTL, 0, CTL_ZERO_BYTES, stream);
    Args a{};
    for (int i = 0; i < 28; ++i) a.in[i] = (const float*)d_in[i];
    a.out = (float*)d_out; a.ws = (unsigned char*)d_ws;
#if MK_ONE_LAUNCH
    a.ph_lo = 0; a.ph_hi = N_PHASES;
    hipLaunchKernelGGL(fwd, dim3(grid), dim3(512), LDS_BYTES, stream, a);
#else
    for (int p = 0; p < N_PHASES; ++p) { a.ph_lo = p; a.ph_hi = p + 1; hipLaunchKernelGGL(fwd, dim3(grid), dim3(512), LDS_BYTES, stream, a); }
#endif
}
```
